# Optimizing an MI355X kernel written in HIP

```python
import math
import jax, jax.numpy as jnp
from jax import lax
import numpy as np

D_MODEL = 1024
BATCH = 2
SEQ = 8192
DEPTH = 2

CHUNK = 64
HEAD_DIM = 64
A_HEADS = 8
A_WIDTH = A_HEADS * HEAD_DIM
A_LOOKBACK = 8
A_BAND = (A_LOOKBACK + 1) * CHUNK
A_MAX_REL = 256
A_REL_SIZE = A_MAX_REL + CHUNK
LRU_WIDTH = 512
LRU_BLOCKS = 8
LRU_BLOCK_DIM = LRU_WIDTH // LRU_BLOCKS
CONV_WIDTH = 4
LRU_C = 8.0
C_HEADS = 4
C_QK_WIDTH = C_HEADS * 2 * HEAD_DIM
C_V_WIDTH = C_HEADS * 2 * HEAD_DIM
Q_BLOCK = 128
ROPE_THETA = 10000.0
N_BRANCHES = 3
BRANCH_WIDTH = 512
IN_COLS = 3 * A_WIDTH + 2 * LRU_WIDTH + 2 * C_QK_WIDTH + C_V_WIDTH + N_BRANCHES * D_MODEL
PEER_HEADS = 8
PEER_N_KEYS = 128
PEER_N_EXPERTS = PEER_N_KEYS * PEER_N_KEYS
PEER_QUERY_DIM = 256
PEER_HALF = PEER_QUERY_DIM // 2
PEER_TOPK = 16
PEER_BLOCK = 128
DEEPNORM_ALPHA = (2 * DEPTH) ** 0.25
DEEPNORM_BETA = (8 * DEPTH) ** -0.25
LN_EPS = 1e-5
NEG_INF = -1e30

kernel_name = "hybrid_chunk_band_rglru_diffattn_peer"


def layer_norm(x, g, b):
    xf = x.astype(jnp.float32)
    mu = xf.mean(-1, keepdims=True)
    var = jnp.square(xf - mu).mean(-1, keepdims=True)
    return ((xf - mu) * lax.rsqrt(var + LN_EPS) * g.astype(jnp.float32) + b.astype(jnp.float32)).astype(x.dtype)


def rms_norm(x, g):
    xf = x.astype(jnp.float32)
    ms = jnp.square(xf).mean(-1, keepdims=True)
    return (xf * lax.rsqrt(ms + LN_EPS) * g.astype(jnp.float32)).astype(x.dtype)


def rope_tables(positions):
    inv_freq = jnp.power(ROPE_THETA, -jnp.arange(0, HEAD_DIM, 2, dtype=jnp.float32) / HEAD_DIM)
    ang = positions.astype(jnp.float32)[..., None] * inv_freq
    return jnp.cos(ang), jnp.sin(ang)


def apply_rope(t, cos, sin):
    extra = (1,) * (t.ndim - 3)
    c = cos.reshape(cos.shape[:2] + extra + cos.shape[2:]).astype(t.dtype)
    s = sin.reshape(sin.shape[:2] + extra + sin.shape[2:]).astype(t.dtype)
    half = HEAD_DIM // 2
    t1, t2 = t[..., :half], t[..., half:]
    return jnp.concatenate([t1 * c - t2 * s, t2 * c + t1 * s], axis=-1)


def chunk_band_attention(q, k, v, rel_bias):
    B, S, H, d = q.shape
    nc = S // CHUNK
    qc = q.reshape(B, nc, CHUNK, H, d)

    def band(t):
        tc = t.reshape(B, nc, CHUNK, H, d)
        tp = jnp.pad(tc, ((0, 0), (A_LOOKBACK, 0), (0, 0), (0, 0), (0, 0)))
        return jnp.concatenate([tp[:, j:j + nc] for j in range(A_LOOKBACK + 1)], axis=2)

    kb, vb = band(k), band(v)
    s = jnp.einsum('bcqhd,bckhd->bchqk', qc, kb).astype(jnp.float32) * (d ** -0.5)
    qi = jnp.arange(CHUNK)[:, None]
    kj = jnp.arange(A_BAND)[None, :]
    dist = qi + A_LOOKBACK * CHUNK - kj
    idx = jnp.clip(dist, -(CHUNK - 1), A_MAX_REL) + (CHUNK - 1)
    bias = rel_bias.astype(jnp.float32)[:, idx]
    valid = (jnp.arange(nc)[:, None] - A_LOOKBACK + kj // CHUNK) >= 0
    s = jnp.where(valid[None, :, None, None, :], s + bias[None, None], NEG_INF)
    p = jax.nn.softmax(s, axis=-1).astype(v.dtype)
    o = jnp.einsum('bchqk,bckhd->bcqhd', p, vb)
    return o.reshape(B, S, H * d)


def _linear_combine(left, right):
    a_l, b_l = left
    a_r, b_r = right
    return a_l * a_r, a_r * b_l + b_r


def rglru_block(bx, bg, conv_w, conv_b, w_r, b_r, w_i, b_i, lru_lambda):
    B, S, W = bx.shape
    xp = jnp.pad(bx, ((0, 0), (CONV_WIDTH - 1, 0), (0, 0)))
    xc = conv_b + xp[:, 0:S] * conv_w[0]
    for tap in range(1, CONV_WIDTH):
        xc = xc + xp[:, tap:tap + S] * conv_w[tap]
    xh = xc.reshape(B, S, LRU_BLOCKS, LRU_BLOCK_DIM)
    r = jax.nn.sigmoid(jnp.einsum('bsgi,gij->bsgj', xh, w_r) + b_r).reshape(B, S, W)
    i = jax.nn.sigmoid(jnp.einsum('bsgi,gij->bsgj', xh, w_i) + b_i).reshape(B, S, W)
    log_a = LRU_C * r.astype(jnp.float32) * jax.nn.log_sigmoid(lru_lambda.astype(jnp.float32))
    a = jnp.exp(log_a)
    u = jnp.sqrt(-jnp.expm1(2.0 * log_a)) * (i * xc).astype(jnp.float32)
    _, h = lax.associative_scan(_linear_combine, (a, u), axis=1)
    return h.astype(bx.dtype) * jax.nn.gelu(bg)


def diff_attention(q, k, v, lam, lam_init, subln_g):
    B, S, H, _, d = q.shape
    nb = S // Q_BLOCK
    qb = jnp.moveaxis(q.reshape(B, nb, Q_BLOCK, H, 2, d), 1, 0)
    key_chunk = jnp.arange(S) // CHUNK
    scale = d ** -0.5

    def one_block(args):
        q_blk, bi = args
        q_chunk = (bi * Q_BLOCK + jnp.arange(Q_BLOCK)) // CHUNK
        mask = key_chunk[None, :] <= q_chunk[:, None]
        s = jnp.einsum('bqhmd,bkhmd->bhmqk', q_blk, k).astype(jnp.float32) * scale
        s = jnp.where(mask, s, NEG_INF)
        p = jax.nn.softmax(s, axis=-1)
        att = (p[:, :, 0] - lam * p[:, :, 1]).astype(v.dtype)
        return jnp.einsum('bhqk,bkhe->bqhe', att, v)

    o = lax.map(one_block, (qb, jnp.arange(nb)))
    o = jnp.moveaxis(o, 0, 1).reshape(B, S, H, 2 * d)
    o = rms_norm(o, subln_g) * (1.0 - lam_init)
    return o.reshape(B, S, H * 2 * d)


def token_mixers(h, cos, sin, lam_init, w_in, gate_bias, rel_bias, conv_w, conv_b, w_r, b_r, w_i, b_i,
                 lru_lambda, diff_lambda, subln_g, w_branch, w_out):
    B, S, _ = h.shape
    z = h @ w_in
    sizes = (A_WIDTH, A_WIDTH, A_WIDTH, LRU_WIDTH, LRU_WIDTH, C_QK_WIDTH, C_QK_WIDTH, C_V_WIDTH,
             N_BRANCHES * D_MODEL)
    points = [int(p) for p in np.cumsum(sizes)[:-1]]
    aq, ak, av, bx, bg, cq, ck, cv, gl = jnp.split(z, points, axis=-1)
    ya = chunk_band_attention(aq.reshape(B, S, A_HEADS, HEAD_DIM), ak.reshape(B, S, A_HEADS, HEAD_DIM),
                              av.reshape(B, S, A_HEADS, HEAD_DIM), rel_bias)
    yb = rglru_block(bx, bg, conv_w, conv_b, w_r, b_r, w_i, b_i, lru_lambda)
    cq = apply_rope(cq.reshape(B, S, C_HEADS, 2, HEAD_DIM), cos, sin)
    ck = apply_rope(ck.reshape(B, S, C_HEADS, 2, HEAD_DIM), cos, sin)
    dl = diff_lambda.astype(jnp.float32)
    lam = jnp.exp(jnp.sum(dl[0] * dl[1])) - jnp.exp(jnp.sum(dl[2] * dl[3])) + lam_init
    yc = diff_attention(cq, ck, cv.reshape(B, S, C_HEADS, 2 * HEAD_DIM), lam, lam_init, subln_g)
    branches = jnp.stack([ya, yb, yc], axis=2)
    proj = jnp.einsum('bsnw,nwd->bsnd', branches, w_branch)
    gates = jax.nn.sigmoid(gl.reshape(B, S, N_BRANCHES, D_MODEL) + gate_bias)
    merged = jnp.sum(gates * proj, axis=2)
    return merged @ w_out


def peer_ffn(h, w_q, sub_keys, u, v):
    B, S, D = h.shape
    xt = h.reshape((B * S) // PEER_BLOCK, PEER_BLOCK, D)

    def one_block(xb):
        q = (xb @ w_q).reshape(PEER_BLOCK, PEER_HEADS, 2, PEER_HALF)
        s = jnp.einsum('thpd,hpnd->thpn', q, sub_keys).astype(jnp.float32)
        sv, si = lax.top_k(s, PEER_TOPK)
        cand = (sv[:, :, 0, :, None] + sv[:, :, 1, None, :]).reshape(PEER_BLOCK, PEER_HEADS, PEER_TOPK * PEER_TOPK)
        cidx = (si[:, :, 0, :, None] * PEER_N_KEYS + si[:, :, 1, None, :]).reshape(PEER_BLOCK, PEER_HEADS, PEER_TOPK * PEER_TOPK)
        fs, fi = lax.top_k(cand, PEER_TOPK)
        experts = jnp.take_along_axis(cidx, fi, axis=-1)
        g = jax.nn.softmax(fs, axis=-1).astype(xb.dtype)
        hid = jax.nn.gelu(jnp.einsum('td,thkd->thk', xb, u[experts]))
        return jnp.einsum('thk,thkd->td', g * hid, v[experts])

    return lax.map(one_block, xt).reshape(B, S, D)


def setup_inputs(seed: int = 0) -> dict:
    key = jax.random.key(seed)
    ks = jax.random.split(key, 24)
    f32 = jnp.float32
    L = DEPTH

    def nrm(k, shape, scale):
        return jax.random.normal(k, shape, f32) * scale

    x = nrm(ks[0], (BATCH, SEQ, D_MODEL), 1.0)
    offset = jax.random.randint(ks[1], (BATCH, 1), 0, 1 << 16, dtype=jnp.int32)
    positions = offset + jnp.arange(SEQ, dtype=jnp.int32)[None, :]
    w_in = nrm(ks[2], (L, D_MODEL, IN_COLS), D_MODEL ** -0.5)
    gate_bias = nrm(ks[3], (L, N_BRANCHES, D_MODEL), 0.1)
    rel_bias = nrm(ks[4], (L, A_HEADS, A_REL_SIZE), 0.3)
    conv_w = nrm(ks[5], (L, CONV_WIDTH, LRU_WIDTH), CONV_WIDTH ** -0.5)
    conv_b = nrm(ks[6], (L, LRU_WIDTH), 0.01)
    lru_w_r = nrm(ks[7], (L, LRU_BLOCKS, LRU_BLOCK_DIM, LRU_BLOCK_DIM), LRU_BLOCK_DIM ** -0.5)
    lru_b_r = nrm(ks[8], (L, LRU_BLOCKS, LRU_BLOCK_DIM), 0.01)
    lru_w_i = nrm(ks[9], (L, LRU_BLOCKS, LRU_BLOCK_DIM, LRU_BLOCK_DIM), LRU_BLOCK_DIM ** -0.5)
    lru_b_i = nrm(ks[10], (L, LRU_BLOCKS, LRU_BLOCK_DIM), 0.01)
    a_pow = jax.random.uniform(ks[11], (L, LRU_WIDTH), f32, 0.9, 0.999)
    a_base = a_pow ** (1.0 / LRU_C)
    lru_lambda = jnp.log(a_base) - jnp.log1p(-a_base)
    diff_lambda = nrm(ks[12], (L, 4, HEAD_DIM), 0.1)
    diff_subln_g = 1.0 + nrm(ks[13], (L, 2 * HEAD_DIM), 0.02)
    w_branch = nrm(ks[14], (L, N_BRANCHES, BRANCH_WIDTH, D_MODEL), DEEPNORM_BETA * BRANCH_WIDTH ** -0.5)
    w_out = nrm(ks[15], (L, D_MODEL, D_MODEL), DEEPNORM_BETA * D_MODEL ** -0.5)
    ln1_g = 1.0 + nrm(ks[16], (L, D_MODEL), 0.02)
    ln1_b = nrm(ks[17], (L, D_MODEL), 0.02)
    peer_w_q = nrm(ks[18], (L, D_MODEL, PEER_HEADS * PEER_QUERY_DIM), D_MODEL ** -0.5)
    peer_sub_keys = nrm(ks[19], (L, PEER_HEADS, 2, PEER_N_KEYS, PEER_HALF), PEER_HALF ** -0.5)
    peer_u = nrm(ks[20], (L, PEER_N_EXPERTS, D_MODEL), D_MODEL ** -0.5)
    peer_v = nrm(ks[21], (L, PEER_N_EXPERTS, D_MODEL), DEEPNORM_BETA)
    ln2_g = 1.0 + nrm(ks[22], (L, D_MODEL), 0.02)
    ln2_b = nrm(ks[23], (L, D_MODEL), 0.02)
    return {"x": x, "positions": positions, "w_in": w_in, "gate_bias": gate_bias, "rel_bias": rel_bias,
            "conv_w": conv_w, "conv_b": conv_b, "lru_w_r": lru_w_r, "lru_b_r": lru_b_r,
            "lru_w_i": lru_w_i, "lru_b_i": lru_b_i, "lru_lambda": lru_lambda, "diff_lambda": diff_lambda,
            "diff_subln_g": diff_subln_g, "w_branch": w_branch, "w_out": w_out, "ln1_g": ln1_g,
            "ln1_b": ln1_b, "peer_w_q": peer_w_q, "peer_sub_keys": peer_sub_keys, "peer_u": peer_u,
            "peer_v": peer_v, "ln2_g": ln2_g, "ln2_b": ln2_b}


def reference(x, positions, w_in, gate_bias, rel_bias, conv_w, conv_b, lru_w_r, lru_b_r, lru_w_i, lru_b_i,
              lru_lambda, diff_lambda, diff_subln_g, w_branch, w_out, ln1_g, ln1_b, peer_w_q, peer_sub_keys,
              peer_u, peer_v, ln2_g, ln2_b):
    cos, sin = rope_tables(positions)
    h = x
    for l in range(DEPTH):
        lam_init = 0.8 - 0.6 * math.exp(-0.3 * l)
        mix = token_mixers(h, cos, sin, lam_init, w_in[l], gate_bias[l], rel_bias[l], conv_w[l], conv_b[l],
                           lru_w_r[l], lru_b_r[l], lru_w_i[l], lru_b_i[l], lru_lambda[l], diff_lambda[l],
                           diff_subln_g[l], w_branch[l], w_out[l])
        h = layer_norm(DEEPNORM_ALPHA * h + mix, ln1_g[l], ln1_b[l])
        ff = peer_ffn(h, peer_w_q[l], peer_sub_keys[l], peer_u[l], peer_v[l])
        h = layer_norm(DEEPNORM_ALPHA * h + ff, ln2_g[l], ln2_b[l])
    return h
```

```cpp
#ifndef MK_N_LAUNCHES
#define MK_N_LAUNCHES 1
#endif
#ifndef MK_DEBUG
#define MK_DEBUG 0
#endif
#include <hip/hip_runtime.h>
#include <cstdio>
#include <cstdint>
namespace pg8 {
#define PG8_LAS __attribute__((address_space(3)))
typedef unsigned short bf16_t;
typedef short bf16x8 __attribute__((ext_vector_type(8)));
typedef float f32x4 __attribute__((ext_vector_type(4)));
typedef unsigned u32x4 __attribute__((ext_vector_type(4)));
constexpr int BM = 256, BK = 64, HALF = 128, HTB = HALF * BK * 2  , STAGE_BYTES = 8 * HTB, NXCD = 8, WGM = 8;

__host__ __device__ __forceinline__ int lds_byte(int r, int c) { const int st = (r >> 4) * 2 + (c >> 5), rr = r & 15, cc = c & 31, ob = rr * 64 + cc * 2; return st * 1024 + (ob ^ (((ob >> 9) & 1) << 5)); }
__host__ __device__ __forceinline__ void stage_rc(int b, int& R, int& C) { const int st = b / 1024, sb = b % 1024, swz = sb ^ (((sb >> 9) & 1) << 5); R = (st >> 1) * 16 + swz / 64; C = (st & 1) * 32 + (swz % 64) / 2; }
__host__ __device__ __forceinline__ int perm32(int rho) { const int n = rho >> 4, i = rho & 15; return 8 * (i >> 2) + 4 * n + (i & 3); }

struct Unit { int pm, pn; };
struct Gemm { const bf16_t* A; const bf16_t* Bt; int M, N, K; };

struct StaticOrder {
    int nM, nN, nwg, G, c;
    __host__ __device__ void init(int M, int N, int G_, int c_) { nM = M / BM; nN = N / BM; nwg = nM * nN; G = G_; c = c_; }
    __host__ __device__ bool next(int i, Unit& u) const {
        const long L = (long)i * G + c; if (L >= nwg) return false;
        int wgid = (int)L; { const int q = nwg / NXCD, r = nwg % NXCD, xcd = wgid % NXCD, off = wgid / NXCD; wgid = (xcd < r ? xcd * (q + 1) : r * (q + 1) + (xcd - r) * q) + off; }
        const int nig = WGM * nN, gid = wgid / nig, fm = gid * WGM, gsz = (nM - fm) < WGM ? (nM - fm) : WGM;
        u.pm = fm + ((wgid % nig) % gsz); u.pn = (wgid % nig) / gsz; return true;
    }
    __device__ __forceinline__ void a_ready(const Unit&) const {}
    __device__ __forceinline__ void done(const Unit&) const {}
};

typedef float f32x2c __attribute__((ext_vector_type(2))); typedef __bf16 bf16x2c __attribute__((ext_vector_type(2)));
__device__ __forceinline__ unsigned cvt_pk_bf16(float lo, float hi) { f32x2c v = {lo, hi}; bf16x2c b = __builtin_convertvector(v, bf16x2c); return __builtin_bit_cast(unsigned, b); }
typedef float f32x2 __attribute__((ext_vector_type(2)));
__device__ __forceinline__ f32x2 gelu_pk(f32x2 v) {
    const f32x2 av = __builtin_elementwise_abs(v), d = av * 0.2316418882f + 1.0f;
    f32x2 t; t.x = __builtin_amdgcn_rcpf(d.x); t.y = __builtin_amdgcn_rcpf(d.y);
    f32x2 q = t * 0.5307027145f + (-0.7265760135f); q = q * t + 0.7107068705f; q = q * t + (-0.142248368f); q = q * t + 0.127414796f; q = q * t;
    const f32x2 s = (v * v) * (-0.72134752044f);
    f32x2 e; e.x = __builtin_amdgcn_exp2f(s.x); e.y = __builtin_amdgcn_exp2f(s.y);
    const f32x2 m = v * (q * e), r = v - m;
    f32x2 o; o.x = v.x < 0.f ? m.x : r.x; o.y = v.y < 0.f ? m.y : r.y; return o;
}

template <int ACT  > struct EpiBf16 {
    static constexpr bool PERM = true, AFTER_DRAIN = false; static_assert(ACT == 0 || ACT == 1, "EpiBf16: ACT is 0 (none) or 1 (gelu_pk)");
    bf16_t* O; int ldc; const float* bias; int split_cols; size_t split_stride; float scale0;
    __device__ __forceinline__ void operator()(const f32x4 (&acc)[2][2][4][2], const Unit& u, int wr, int wc, int fr, int fq) const {
        const int row0 = u.pm * BM + wr * 64 + fr; int colt = u.pn * BM; bf16_t* base = O;
        float sc = 1.f; if (split_cols) { const int t = colt / split_cols; base += (size_t)t * split_stride; colt -= t * split_cols; if (t == 0) sc = scale0; }
        const int col0 = colt + wc * 32 + 8 * fq, bcol0 = u.pn * BM + wc * 32 + 8 * fq;
        f32x4 bv[2][2];
#pragma unroll
        for (int bj = 0; bj < 2; ++bj)
#pragma unroll
            for (int n = 0; n < 2; ++n) bv[bj][n] = bias ? *(const f32x4*)(bias + bcol0 + bj * HALF + 4 * n) : (f32x4){0.f, 0.f, 0.f, 0.f};
#pragma unroll
        for (int ai = 0; ai < 2; ++ai)
#pragma unroll
            for (int m = 0; m < 4; ++m) { bf16_t* rowp = base + (size_t)(row0 + ai * HALF + m * 16) * ldc + col0;
#pragma unroll
                for (int bj = 0; bj < 2; ++bj) { f32x4 v0 = acc[ai][bj][m][0] + bv[bj][0], v1 = acc[ai][bj][m][1] + bv[bj][1];
                    if (ACT == 1) { f32x2 a = gelu_pk((f32x2){v0[0], v0[1]}), b = gelu_pk((f32x2){v0[2], v0[3]}), c = gelu_pk((f32x2){v1[0], v1[1]}), d = gelu_pk((f32x2){v1[2], v1[3]});
                        v0 = (f32x4){a.x, a.y, b.x, b.y}; v1 = (f32x4){c.x, c.y, d.x, d.y}; }
                    v0 = v0 * sc; v1 = v1 * sc; u32x4 w; w.x = cvt_pk_bf16(v0[0], v0[1]); w.y = cvt_pk_bf16(v0[2], v0[3]); w.z = cvt_pk_bf16(v1[0], v1[1]); w.w = cvt_pk_bf16(v1[2], v1[3]);
                    *(u32x4*)(rowp + bj * HALF) = w; } }
    }
};


template <class Epi, class Sched, bool ALIGN_EPI = false, bool SP2 = false>
__device__ __forceinline__ void gemm_phase(PG8_LAS unsigned char* lds, const Gemm g_in, const Sched& S, const Epi& E) {
    Gemm g = g_in; asm volatile("" : "+s"(g.A), "+s"(g.Bt));
    int tid_ = threadIdx.x; asm volatile("" : "+v"(tid_));
    const int tid = tid_, wid = __builtin_amdgcn_readfirstlane(tid >> 6), lane = tid & 63, wr = wid >> 2, wc = wid & 3, fr = lane & 15, fq = lane >> 4;
    const int K = g.K, nt = K / BK;
    unsigned voffA[2], voffB[2];
#pragma unroll
    for (int i = 0; i < 2; ++i) { int R, C; stage_rc(tid * 16 + i * 8192, R, C); const int Rb = Epi::PERM ? ((R & ~31) + perm32(R & 31)) : R;
        voffA[i] = (unsigned)(R * K + C) * 2u; voffB[i] = (unsigned)(Rb * K + C) * 2u; }
    const size_t kstep = (size_t)(BK * 2);
    const size_t hstep = (size_t)HALF * K * 2;
    const size_t tstep = 2 * hstep;
    const unsigned ldsw = (unsigned)wid * 1024u;
    const int aoff = lds_byte(wr * 64 + fr, fq * 8), boff = lds_byte(wc * 32 + fr, fq * 8);
#define PG8_SA(b, h) (((b) * 2 + (h)) * HTB)
#define PG8_SB(b, h) ((4 + (b) * 2 + (h)) * HTB)
#define PG8_STAGE(bufoff, gbase, voff) do { _Pragma("unroll") for (int _i = 0; _i < 2; ++_i) \
        __builtin_amdgcn_global_load_lds((const unsigned*)((const char*)(gbase) + (voff)[_i]), (PG8_LAS unsigned*)(lds + (bufoff) + ldsw + _i * 8192), 16, 0, 0); } while (0)
#define PG8_LDA(dst, b, h) do { _Pragma("unroll") for (int m = 0; m < 4; ++m) _Pragma("unroll") for (int k = 0; k < 2; ++k) dst[m][k] = *(const PG8_LAS bf16x8*)(lds + PG8_SA(b, h) + aoff + m * 2048 + k * 1024); } while (0)
#define PG8_LDB(dst, b, h) do { _Pragma("unroll") for (int n = 0; n < 2; ++n) _Pragma("unroll") for (int k = 0; k < 2; ++k) dst[n][k] = *(const PG8_LAS bf16x8*)(lds + PG8_SB(b, h) + boff + n * 2048 + k * 1024); } while (0)
#define PG8_MMA(ai, bj, At, Bt) do { __builtin_amdgcn_s_setprio(1); _Pragma("unroll") for (int m = 0; m < 4; ++m) _Pragma("unroll") for (int n = 0; n < 2; ++n) _Pragma("unroll") for (int k = 0; k < 2; ++k) \
        acc[ai][bj][m][n] = __builtin_amdgcn_mfma_f32_16x16x32_bf16(Bt[n][k], At[m][k], acc[ai][bj][m][n], 0, 0, 0); __builtin_amdgcn_s_setprio(0); } while (0)
#define PG8_WAIT_V(n) asm volatile("s_waitcnt vmcnt(" #n ")" ::: "memory")
#define PG8_WAIT_L(n) asm volatile("s_waitcnt lgkmcnt(" #n ")" ::: "memory")
#define PG8_BAR __builtin_amdgcn_s_barrier()
#define PG8_SCHED __builtin_amdgcn_sched_barrier(0)
    Unit cur, nxt; int ui = 0;
    if (!S.next(0, cur)) return;
    f32x4 acc[2][2][4][2];
#pragma unroll
    for (int a = 0; a < 2; ++a)
#pragma unroll
        for (int b = 0; b < 2; ++b)
#pragma unroll
            for (int m = 0; m < 4; ++m)
#pragma unroll
                for (int n = 0; n < 2; ++n) acc[a][b][m][n] = (f32x4){0.f, 0.f, 0.f, 0.f};
    bf16x8 At[4][2], B0[2][2], B1[2][2];
    const char* cA = (const char*)g.A + (size_t)cur.pm * tstep; const char* cB = (const char*)g.Bt + (size_t)cur.pn * tstep;
    S.a_ready(cur);
    if constexpr (SP2) {
        PG8_STAGE(PG8_SB(0, 0), cB, voffB); PG8_STAGE(PG8_SB(0, 1), cB + hstep, voffB); PG8_STAGE(PG8_SA(0, 0), cA, voffA); PG8_STAGE(PG8_SA(0, 1), cA + hstep, voffA);
        if (wr == 1) PG8_BAR;
        PG8_WAIT_V(2); PG8_BAR;
        PG8_STAGE(PG8_SB(1, 0), cB + kstep, voffB); PG8_STAGE(PG8_SA(1, 0), cA + kstep, voffA); PG8_STAGE(PG8_SB(1, 1), cB + hstep + kstep, voffB);
        PG8_WAIT_V(6); PG8_BAR;
    } else {
        PG8_STAGE(PG8_SB(0, 0), cB, voffB); PG8_STAGE(PG8_SA(0, 0), cA, voffA); PG8_STAGE(PG8_SB(0, 1), cB + hstep, voffB); PG8_STAGE(PG8_SA(0, 1), cA + hstep, voffA);
        if (wr == 1) PG8_BAR;
        PG8_WAIT_V(4); PG8_BAR;
        PG8_STAGE(PG8_SB(1, 0), cB + kstep, voffB); PG8_STAGE(PG8_SA(1, 0), cA + kstep, voffA); PG8_STAGE(PG8_SB(1, 1), cB + hstep + kstep, voffB);
        PG8_WAIT_V(6); PG8_BAR;
    }
    for (;;) {
        const bool has_next = S.next(ui + 1, nxt);
        const char* nA = has_next ? (const char*)g.A + (size_t)nxt.pm * tstep : cA; const char* nB = has_next ? (const char*)g.Bt + (size_t)nxt.pn * tstep : cB;
        for (int t = 0; t < nt; t += 2) {
            const bool last = (t == nt - 2);
            const char* a1 = cA + (size_t)(t + 1) * kstep;
            const char* a2 = last ? nA : cA + (size_t)(t + 2) * kstep; const char* b2 = last ? nB : cB + (size_t)(t + 2) * kstep;
            const char* a3 = a2 + kstep; const char* b3 = b2 + kstep;
            if (last && has_next) S.a_ready(nxt);
            if constexpr (SP2) {
            PG8_LDB(B0, 0, 0); PG8_LDB(B1, 0, 1); PG8_SCHED; PG8_LDA(At, 0, 0); PG8_STAGE(PG8_SA(1, 1), a1 + hstep, voffA);
            PG8_WAIT_V(8); PG8_WAIT_L(0); PG8_BAR; PG8_MMA(0, 0, At, B0); PG8_MMA(0, 1, At, B1); PG8_BAR; PG8_SCHED;
            PG8_LDA(At, 0, 1); PG8_STAGE(PG8_SB(0, 0), b2, voffB); PG8_STAGE(PG8_SB(0, 1), b2 + hstep, voffB); PG8_STAGE(PG8_SA(0, 0), a2, voffA);
            PG8_WAIT_V(8); PG8_WAIT_L(0); PG8_BAR; PG8_MMA(1, 0, At, B0); PG8_MMA(1, 1, At, B1); PG8_BAR; PG8_SCHED;
            PG8_LDB(B0, 1, 0); PG8_LDB(B1, 1, 1); PG8_SCHED; PG8_LDA(At, 1, 0); PG8_STAGE(PG8_SA(0, 1), a2 + hstep, voffA);
            PG8_WAIT_V(8); PG8_WAIT_L(0); PG8_BAR; PG8_MMA(0, 0, At, B0); PG8_MMA(0, 1, At, B1); PG8_BAR; PG8_SCHED;
            PG8_LDA(At, 1, 1); PG8_STAGE(PG8_SB(1, 0), b3, voffB); PG8_STAGE(PG8_SB(1, 1), b3 + hstep, voffB); PG8_STAGE(PG8_SA(1, 0), a3, voffA);
            PG8_WAIT_V(8); PG8_WAIT_L(0); PG8_BAR; PG8_MMA(1, 0, At, B0); PG8_MMA(1, 1, At, B1); PG8_BAR; PG8_SCHED;
            } else {
            PG8_LDB(B0, 0, 0); PG8_SCHED; PG8_LDA(At, 0, 0); PG8_STAGE(PG8_SA(1, 1), a1 + hstep, voffA);
            PG8_WAIT_L(8); PG8_BAR; PG8_WAIT_L(0); PG8_MMA(0, 0, At, B0); PG8_BAR; PG8_SCHED;
            PG8_LDB(B1, 0, 1); PG8_STAGE(PG8_SB(0, 0), b2, voffB);
            PG8_BAR; PG8_WAIT_L(0); PG8_MMA(0, 1, At, B1); PG8_BAR;
            PG8_LDA(At, 0, 1); PG8_STAGE(PG8_SA(0, 0), a2, voffA);
            PG8_BAR; PG8_WAIT_L(0); PG8_MMA(1, 0, At, B0); PG8_BAR; PG8_SCHED;
            PG8_STAGE(PG8_SB(0, 1), b2 + hstep, voffB);
            PG8_WAIT_V(6); PG8_BAR; PG8_MMA(1, 1, At, B1); PG8_BAR;
            PG8_LDB(B0, 1, 0); PG8_SCHED; PG8_LDA(At, 1, 0); PG8_STAGE(PG8_SA(0, 1), a2 + hstep, voffA);
            PG8_WAIT_L(8); PG8_BAR; PG8_WAIT_L(0); PG8_MMA(0, 0, At, B0); PG8_BAR; PG8_SCHED;
            PG8_LDB(B1, 1, 1); PG8_STAGE(PG8_SB(1, 0), b3, voffB);
            PG8_BAR; PG8_WAIT_L(0); PG8_MMA(0, 1, At, B1); PG8_BAR;
            PG8_LDA(At, 1, 1); PG8_STAGE(PG8_SA(1, 0), a3, voffA);
            PG8_BAR; PG8_WAIT_L(0); PG8_MMA(1, 0, At, B0); PG8_BAR; PG8_SCHED;
            PG8_STAGE(PG8_SB(1, 1), b3 + hstep, voffB);
            PG8_WAIT_V(6); PG8_BAR; PG8_MMA(1, 1, At, B1); PG8_BAR;
            }
        }
        if constexpr (ALIGN_EPI) { if (wr == 0) PG8_BAR; }
        if constexpr (!Epi::AFTER_DRAIN) { E(acc, cur, wr, wc, fr, fq); S.done(cur); }
        if (!has_next) break;
#pragma unroll
        for (int a = 0; a < 2; ++a)
#pragma unroll
            for (int b = 0; b < 2; ++b)
#pragma unroll
                for (int m = 0; m < 4; ++m)
#pragma unroll
                    for (int n = 0; n < 2; ++n) acc[a][b][m][n] = (f32x4){0.f, 0.f, 0.f, 0.f};
        cur = nxt; cA = nA; cB = nB; ++ui;
        if constexpr (ALIGN_EPI) { if (wr == 1) PG8_BAR; }
    }
    PG8_WAIT_V(0);
    if constexpr (!ALIGN_EPI) { if (wr == 0) PG8_BAR; }
    PG8_BAR;
    if constexpr (Epi::AFTER_DRAIN) { E.fused(acc, cur, wr, wc, fr, fq, lds, wid, lane); S.done(cur); }
#undef PG8_SA
#undef PG8_SB
#undef PG8_STAGE
#undef PG8_LDA
#undef PG8_LDB
#undef PG8_MMA
#undef PG8_WAIT_V
#undef PG8_WAIT_L
#undef PG8_BAR
#undef PG8_SCHED
}
}

#ifndef PG8_SP2
#define PG8_SP2 true
#endif
#ifndef PG8_ALIGN
#define PG8_ALIGN true
#endif
namespace pg8 {
constexpr float C2S = 0.125f * 1.4426950408889634f;
__device__ __forceinline__ float sigm(float x) { return __builtin_amdgcn_rcpf(1.0f + __builtin_amdgcn_exp2f(-1.4426950408889634f * x)); }
__device__ __forceinline__ void st8(bf16_t* p, f32x4 v0, f32x4 v1) { u32x4 w; w.x = cvt_pk_bf16(v0[0], v0[1]); w.y = cvt_pk_bf16(v0[2], v0[3]); w.z = cvt_pk_bf16(v1[0], v1[1]); w.w = cvt_pk_bf16(v1[2], v1[3]); *(u32x4*)p = w; }

struct EpiIn {
    static constexpr bool PERM = true, AFTER_DRAIN = false;
    bf16_t *AQK, *BXG, *CQK, *CV, *GATES; const float* gbias; const float* rc; const float* rs;
    __device__ __forceinline__ void operator()(const f32x4 (&acc)[2][2][4][2], const Unit& u, int wr, int wc, int fr, int fq) const {
        const int pn = u.pn;
        bf16_t* base; int ldc, colt, mode;
        if (pn < 2)       { base = AQK; ldc = 1024; colt = pn * 256; mode = 1; }
        else if (pn < 4)  { base = AQK; ldc = 1024; colt = 512 + (pn - 2) * 256; mode = 0; }
        else if (pn < 10) { base = BXG; ldc = 1024; colt = (pn - 6) * 256; mode = 0; }
        else if (pn < 12) { base = CQK; ldc = 1024; colt = (pn - 10) * 256; mode = 3; }
        else if (pn < 14) { base = CQK; ldc = 1024; colt = 512 + (pn - 12) * 256; mode = 2; }
        else if (pn < 16) { base = CV; ldc = 512; colt = (pn - 14) * 256; mode = 0; }
        else              { base = GATES; ldc = 3072; colt = (pn - 16) * 256; mode = 4; }
        const int row0 = u.pm * BM + wr * 64 + fr, cl = wc * 32 + 8 * fq;
        const float sc = (mode & 1) ? C2S : 1.f;
        if (mode == 4) {
            f32x4 bv[2][2];
#pragma unroll
            for (int bj = 0; bj < 2; ++bj)
#pragma unroll
                for (int n = 0; n < 2; ++n) bv[bj][n] = *(const f32x4*)(gbias + colt + bj * HALF + cl + 4 * n);
#pragma unroll
            for (int ai = 0; ai < 2; ++ai)
#pragma unroll
                for (int m = 0; m < 4; ++m) { bf16_t* rowp = base + (size_t)(row0 + ai * HALF + m * 16) * ldc + colt + cl;
#pragma unroll
                    for (int bj = 0; bj < 2; ++bj) { f32x4 v0 = acc[ai][bj][m][0] + bv[bj][0], v1 = acc[ai][bj][m][1] + bv[bj][1];
#pragma unroll
                        for (int e = 0; e < 4; ++e) { v0[e] = sigm(v0[e]); v1[e] = sigm(v1[e]); }
                        st8(rowp + bj * HALF, v0, v1); }
                    asm volatile("" ::: "memory"); }
        } else if (mode >= 2) {
            const int i0 = (wc & 1) * 16 + 4 * fq;
#pragma unroll
            for (int ai = 0; ai < 2; ++ai)
#pragma unroll
                for (int m = 0; m < 4; ++m) { const int row = row0 + ai * HALF + m * 16; bf16_t* rowp = base + (size_t)row * ldc + colt + cl;
                    const f32x4 cs = *(const f32x4*)(rc + (size_t)row * 32 + i0), sn = *(const f32x4*)(rs + (size_t)row * 32 + i0);
#pragma unroll
                    for (int bj = 0; bj < 2; ++bj) { const f32x4 a0 = acc[ai][bj][m][0], a1 = acc[ai][bj][m][1]; f32x4 v0, v1;
                        v0[0] = (a0[0] * cs[0] - a0[1] * sn[0]) * sc; v0[1] = (a0[1] * cs[0] + a0[0] * sn[0]) * sc;
                        v0[2] = (a0[2] * cs[1] - a0[3] * sn[1]) * sc; v0[3] = (a0[3] * cs[1] + a0[2] * sn[1]) * sc;
                        v1[0] = (a1[0] * cs[2] - a1[1] * sn[2]) * sc; v1[1] = (a1[1] * cs[2] + a1[0] * sn[2]) * sc;
                        v1[2] = (a1[2] * cs[3] - a1[3] * sn[3]) * sc; v1[3] = (a1[3] * cs[3] + a1[2] * sn[3]) * sc;
                        st8(rowp + bj * HALF, v0, v1); }
                    asm volatile("" ::: "memory"); }
        } else {
#pragma unroll
            for (int ai = 0; ai < 2; ++ai)
#pragma unroll
                for (int m = 0; m < 4; ++m) { bf16_t* rowp = base + (size_t)(row0 + ai * HALF + m * 16) * ldc + colt + cl;
#pragma unroll
                    for (int bj = 0; bj < 2; ++bj) st8(rowp + bj * HALF, acc[ai][bj][m][0] * sc, acc[ai][bj][m][1] * sc); }
        }
    }
};
struct InOrder {
    StaticOrder S;
    __device__ void init(int G, int c) { S.init(16384, 26 * 256, G, c); }
    __device__ bool next(int i, Unit& u) const { if (!S.next(i, u)) return false; if (u.pn >= 4) u.pn += 2; return true; }
    __device__ __forceinline__ void a_ready(const Unit&) const {}
    __device__ __forceinline__ void done(const Unit&) const {}
};
template <int NB> struct EpiMerge {
    static constexpr bool PERM = true, AFTER_DRAIN = false;
    const bf16_t* gates; float* mf; bf16_t* merged;
    __device__ __forceinline__ void operator()(const f32x4 (&acc)[2][2][4][2], const Unit& u, int wr, int wc, int fr, int fq) const {
        const int row0 = u.pm * BM + wr * 64 + fr, col0 = u.pn * BM + wc * 32 + 8 * fq;
#pragma unroll
        for (int ai = 0; ai < 2; ++ai)
#pragma unroll
            for (int m = 0; m < 4; ++m) { const size_t row = (size_t)(row0 + ai * HALF + m * 16);
#pragma unroll
                for (int bj = 0; bj < 2; ++bj) { const int col = col0 + bj * HALF;
                    const u32x4 gw = *(const u32x4*)(gates + row * 3072 + NB * 1024 + col);
                    f32x4 g0, g1;
                    g0[0] = __uint_as_float(gw.x << 16); g0[1] = __uint_as_float(gw.x & 0xffff0000u); g0[2] = __uint_as_float(gw.y << 16); g0[3] = __uint_as_float(gw.y & 0xffff0000u);
                    g1[0] = __uint_as_float(gw.z << 16); g1[1] = __uint_as_float(gw.z & 0xffff0000u); g1[2] = __uint_as_float(gw.w << 16); g1[3] = __uint_as_float(gw.w & 0xffff0000u);
                    f32x4 v0 = acc[ai][bj][m][0] * g0, v1 = acc[ai][bj][m][1] * g1;
                    float* mp = mf + row * 1024 + col;
                    if (NB > 0) { v0 += *(const f32x4*)mp; v1 += *(const f32x4*)(mp + 4); }
                    if (NB < 2) { *(f32x4*)mp = v0; *(f32x4*)(mp + 4) = v1; }
                    else st8(merged + row * 1024 + col, v0, v1); }
                asm volatile("" ::: "memory"); }
    }
};
struct EpiOut {
    static constexpr bool PERM = true, AFTER_DRAIN = false;
    const float* resid; float* yf; float alpha;
    __device__ __forceinline__ void operator()(const f32x4 (&acc)[2][2][4][2], const Unit& u, int wr, int wc, int fr, int fq) const {
        const int row0 = u.pm * BM + wr * 64 + fr, col0 = u.pn * BM + wc * 32 + 8 * fq;
#pragma unroll
        for (int ai = 0; ai < 2; ++ai)
#pragma unroll
            for (int m = 0; m < 4; ++m) { const size_t row = (size_t)(row0 + ai * HALF + m * 16);
#pragma unroll
                for (int bj = 0; bj < 2; ++bj) { const size_t o = row * 1024 + col0 + bj * HALF;
                    const f32x4 r0 = *(const f32x4*)(resid + o), r1 = *(const f32x4*)(resid + o + 4);
                    *(f32x4*)(yf + o) = r0 * alpha + acc[ai][bj][m][0]; *(f32x4*)(yf + o + 4) = r1 * alpha + acc[ai][bj][m][1]; }
                asm volatile("" ::: "memory"); }
    }
};
}
#include <hip/hip_bf16.h>
#include <cmath>
namespace attn_body {
using bf16=__hip_bfloat16;
using bf16x8=__attribute__((ext_vector_type(8)))short;
using s16x4=__attribute__((ext_vector_type(4)))short;
using f32x16=__attribute__((ext_vector_type(16)))float;
using u32x4=__attribute__((ext_vector_type(4)))unsigned;
constexpr int BATCH=2,NHEAD=16,SEQ=8192,D=64;
constexpr int QP=1024,KP=1024,VP=512,OP=1024;
constexpr int NW=8,QBLK=32,QB=QBLK*NW,KVBLK=64,NQB=SEQ/QB;
constexpr int ATTN_UNIT_ROWS=QB;
__device__ __forceinline__ int crow(int r,int hi){return (r&3)+8*(r>>2)+4*hi;}
#define SBAR() __builtin_amdgcn_sched_barrier(0)
__device__ __forceinline__ void cmask(f32x16&p0,f32x16&p1,int jb,int qrel,int hi){
  const float NEG=-INFINITY; (void)hi;
  if(jb>(qrel>>6)){
  #pragma unroll
  for(int r=0;r<16;++r){p0[r]=NEG;p1[r]=NEG;} }
}

constexpr int NSLOT=3, SLOTB=8192;
constexpr int LDS_K=0, LDS_V=NSLOT*SLOTB, LDS_WS=2*NSLOT*SLOTB, LDS_OST=LDS_WS+NW*64*4, LDS_BYTES=LDS_OST+NW*4096;
constexpr float C2=0.125f*1.4426950408889634f;
__device__ __forceinline__ void glds16(const void*gsrc,unsigned lds_dst){unsigned keep;
  asm volatile("s_mov_b32 %0, m0\n\ts_mov_b32 m0, %2\n\ts_nop 0\n\tglobal_load_lds_dwordx4 %1, off\n\ts_mov_b32 m0, %0":"=&s"(keep):"v"(gsrc),"s"(lds_dst):"memory");}
__device__ __forceinline__ float max3f(float a,float b,float c){float r;asm("v_max3_f32 %0, %1, %2, %3":"=v"(r):"v"(a),"v"(b),"v"(c));return r;}
__device__ __forceinline__ float max2f(float a,float b){float r;asm("v_max_f32_e32 %0, %1, %2":"=v"(r):"v"(a),"v"(b));return r;}
__device__ __forceinline__ float fadd_s(float a,float b){float r;asm("v_add_f32_e32 %0, %1, %2":"=v"(r):"v"(a),"v"(b));return r;}
__device__ __forceinline__ float fsub_s(float a,float b){float r;asm("v_sub_f32_e32 %0, %1, %2":"=v"(r):"v"(a),"v"(b));return r;}
typedef float f32x2_t __attribute__((ext_vector_type(2))); typedef __bf16 bf16x2_t __attribute__((ext_vector_type(2)));
__device__ __forceinline__ unsigned cvtpk_s(float lo,float hi){f32x2_t v={lo,hi};bf16x2_t b=__builtin_convertvector(v,bf16x2_t);return __builtin_bit_cast(unsigned,b);}
#define WAIT_BAR(N) asm volatile("s_waitcnt vmcnt(" #N ") lgkmcnt(0)\n\ts_barrier":::"memory")

__device__ __forceinline__ void qkt(f32x16&p0,f32x16&p1,const char*Kslot,const bf16x8*qr,const f32x16&negm,int r32,int hi){
  const char*kb=Kslot+hi*1024+r32*16;
  #pragma unroll
  for(int d0=0;d0<4;++d0){
    const bf16x8 b0=*reinterpret_cast<const bf16x8*>(kb+d0*2048);
    const bf16x8 b1=*reinterpret_cast<const bf16x8*>(kb+d0*2048+512);
    if(d0==0){p0=__builtin_amdgcn_mfma_f32_32x32x16_bf16(b0,qr[0],negm,0,0,0);p1=__builtin_amdgcn_mfma_f32_32x32x16_bf16(b1,qr[0],negm,0,0,0);}
    else{p0=__builtin_amdgcn_mfma_f32_32x32x16_bf16(b0,qr[d0],p0,0,0,0);p1=__builtin_amdgcn_mfma_f32_32x32x16_bf16(b1,qr[d0],p1,0,0,0);}}
}
typedef __attribute__((address_space(3))) const char* lds_cptr;
typedef short v4i16_t __attribute__((ext_vector_type(4)));
__device__ __forceinline__ void kload8(bf16x8*kf,lds_cptr kp){
  kf[0]=*(const __attribute__((address_space(3))) bf16x8*)(kp);      kf[1]=*(const __attribute__((address_space(3))) bf16x8*)(kp+512);
  kf[2]=*(const __attribute__((address_space(3))) bf16x8*)(kp+2048); kf[3]=*(const __attribute__((address_space(3))) bf16x8*)(kp+2560);
  kf[4]=*(const __attribute__((address_space(3))) bf16x8*)(kp+4096); kf[5]=*(const __attribute__((address_space(3))) bf16x8*)(kp+4608);
  kf[6]=*(const __attribute__((address_space(3))) bf16x8*)(kp+6144); kf[7]=*(const __attribute__((address_space(3))) bf16x8*)(kp+6656);
}
__device__ __forceinline__ void kload2(bf16x8*kf,lds_cptr kp,int j){ kf[2*j]=*(const __attribute__((address_space(3))) bf16x8*)(kp+j*2048); kf[2*j+1]=*(const __attribute__((address_space(3))) bf16x8*)(kp+j*2048+512); }
__device__ __forceinline__ s16x4 vtr(lds_cptr p){ return __builtin_bit_cast(s16x4,__builtin_amdgcn_ds_read_tr16_b64_v4i16((__attribute__((address_space(3))) v4i16_t*)p)); }
__device__ __forceinline__ float rowmax(const f32x16&p0,const f32x16&p1){
  float a=max3f(p0[0],p0[1],p1[0]),b=max3f(p0[2],p0[3],p1[1]);a=max3f(a,p1[2],p1[3]);
  #pragma unroll
  for(int r=4;r<16;r+=4){a=max3f(a,p0[r],p0[r+1]);b=max3f(b,p0[r+2],p0[r+3]);a=max3f(a,p1[r],p1[r+1]);b=max3f(b,p1[r+2],p1[r+3]);}
  const float m=max2f(a,b);
  auto rr=__builtin_amdgcn_permlane32_swap(__float_as_uint(m),__float_as_uint(m),false,false);
  return max2f(__uint_as_float(rr[0]),__uint_as_float(rr[1]));
}
__device__ __forceinline__ void pv(f32x16*o,int vb,bf16x8 pa0,bf16x8 pa1,bf16x8 pa2,bf16x8 pa3){
  #pragma unroll
  for(int d0=0;d0<2;++d0){s16x4 lo[4],hi[4];
    #pragma unroll
    for(int ks=0;ks<4;++ks){
      asm volatile("ds_read_b64_tr_b16 %0,%1 offset:%c2":"=&v"(lo[ks]):"v"(vb),"i"(d0*4096+ks*1024):"memory");
      asm volatile("ds_read_b64_tr_b16 %0,%1 offset:%c2":"=&v"(hi[ks]):"v"(vb),"i"(d0*4096+ks*1024+512):"memory");}
    asm volatile("s_waitcnt lgkmcnt(0)":::"memory");SBAR();
    #define PK(k) (bf16x8){lo[k][0],lo[k][1],lo[k][2],lo[k][3],hi[k][0],hi[k][1],hi[k][2],hi[k][3]}
    o[d0]=__builtin_amdgcn_mfma_f32_32x32x16_bf16(pa0,PK(0),o[d0],0,0,0);
    o[d0]=__builtin_amdgcn_mfma_f32_32x32x16_bf16(pa1,PK(1),o[d0],0,0,0);
    o[d0]=__builtin_amdgcn_mfma_f32_32x32x16_bf16(pa2,PK(2),o[d0],0,0,0);
    o[d0]=__builtin_amdgcn_mfma_f32_32x32x16_bf16(pa3,PK(3),o[d0],0,0,0);
    #undef PK
  }
}

#ifndef ATTN_STORE16
#define ATTN_STORE16(p,v) (*(u32x4*)(p)=(v))
#endif
template<int THRL> __device__ __forceinline__ void attn_unit(int b,int h,int qb,const bf16*Q,const bf16*__restrict__ K,const bf16*__restrict__ V,bf16*O,char*shm){
  const int qcol=(h>>1)*64, kcol=512+(h>>1)*64, vcol=((h>>2)*2+(h&1))*64, ocol=h*64;
  int tid_=threadIdx.x; asm volatile("":"+v"(tid_)); const int tid=tid_,lane=tid&63,r32=lane&31,hi=lane>>5; const int wid=__builtin_amdgcn_readfirstlane(tid>>6);
  const long rowbase=(long)b*SEQ; const int q0=qb*QB;
  const bf16*Qw=Q+(rowbase+q0+wid*QBLK)*QP+qcol;
  const bf16*Kh=K+rowbase*KP+kcol,*Vh=V+rowbase*VP+vcol;
  const unsigned lds0=(unsigned)(uintptr_t)shm;
  float*wsf=(float*)(shm+LDS_WS)+wid*64;
  const bf16*ksrc=Kh+(long)lane*KP+wid*8;
  const bf16*vsrc=Vh+(long)(16*(wid&3)+(lane>>2))*VP+(wid>>2)*32+(lane&3)*8;
  const unsigned kdst=lds0+LDS_K+wid*1024, vdst=lds0+LDS_V+wid*1024;
  #define DMA_K(t,slot) glds16(ksrc+(long)(t)*KVBLK*KP,(unsigned)__builtin_amdgcn_readfirstlane(kdst+(slot)))
  #define DMA_V(t,slot) glds16(vsrc+(long)(t)*KVBLK*VP,(unsigned)__builtin_amdgcn_readfirstlane(vdst+(slot)))
  const int vb0=(int)(lds0+LDS_V)+((lane>>4)&1)*32+(lane&3)*8+(4*hi+((lane&15)>>2))*64;
  const char*Kbase=shm+LDS_K; bf16x8 kf[8];
  const lds_cptr shm3=(lds_cptr)shm; const lds_cptr kp0=shm3+LDS_K+hi*1024+r32*16; const lds_cptr vp0=shm3+LDS_V+((lane>>4)&1)*32+(lane&3)*8+(4*hi+((lane&15)>>2))*64;
  const int NT=(q0+QB)/KVBLK;
  DMA_K(0,0);DMA_V(0,0);DMA_K(1,SLOTB);
  bf16x8 qr[4];
  #pragma unroll
  for(int d0=0;d0<4;++d0)qr[d0]=*reinterpret_cast<const bf16x8*>(&Qw[(long)r32*QP+d0*16+hi*8]);
  float mhat=0.f,l_reg=0.f;f32x16 o[2];o[0]=f32x16{};o[1]=f32x16{};f32x16 negm=f32x16{};asm volatile("":"+v"(negm));
  const int qrel=wid*QBLK+r32;
  #define CMASK(P0,P1,t) do{int jb_=(t)-(NT-4); if(jb_>=0)cmask(P0,P1,jb_,qrel,hi);}while(0)
  bool resc=false;
  #define START(P0,P1) do{ const float rm=rowmax(P0,P1); resc=false; \
    { const float dl=rm; mhat=fadd_s(mhat,dl); \
      _Pragma("unroll") for(int r=0;r<16;++r){P0[r]=fsub_s(P0[r],dl);P1[r]=fsub_s(P1[r],dl);} \
      _Pragma("unroll") for(int r=0;r<16;++r)negm[r]=-mhat; asm volatile("":"+v"(negm)); } \
    _Pragma("unroll") for(int r=0;r<16;++r)P0[r]=__builtin_amdgcn_exp2f(P0[r]); }while(0)
  #define RESC() do{ if(resc){ asm volatile("s_waitcnt lgkmcnt(0)":::"memory"); \
      _Pragma("unroll") for(int d_=0;d_<2;++d_) _Pragma("unroll") for(int r=0;r<16;++r)o[d_][r]*=wsf[crow(r,hi)]; } }while(0)
  f32x16 pA0,pA1,pB0,pB1;
  int sl_prev=0,sl_cur=0,sl_next=SLOTB;
  #define ROT() do{sl_prev=sl_cur;sl_cur=sl_next;sl_next=(sl_next==(NSLOT-1)*SLOTB)?0:sl_next+SLOTB;}while(0)
  DMA_K(2,2*SLOTB);
  WAIT_BAR(3);
  qkt(pA0,pA1,Kbase,qr,negm,r32,hi);asm volatile("s_nop 15\n\ts_nop 7":"+v"(pA0),"+v"(pA1));CMASK(pA0,pA1,0);
  START(pA0,pA1);
  _Pragma("unroll") for(int r=0;r<16;++r)pA1[r]=__builtin_amdgcn_exp2f(pA1[r]);
  WAIT_BAR(0);
  DMA_K(3,0);DMA_V(1,SLOTB);
  ROT();
  kload8(kf,kp0+sl_cur);
  WAIT_BAR(2);
  s16x4 vlo[8],vhi[8]; u32x4 pw0,pw1,pw2,pw3;
  #define PKW(P,B) cvtpk_s(P[B],P[B+1])
  #define PAF(k) __builtin_bit_cast(bf16x8,pw##k)
  #define VFR(i) (bf16x8){vlo[i][0],vlo[i][1],vlo[i][2],vlo[i][3],vhi[i][0],vhi[i][1],vhi[i][2],vhi[i][3]}
  #define PIN(x) asm volatile("":"+v"(x))
  #define MX3(a,b,c) __builtin_fmaxf(__builtin_fmaxf((a),(b)),(c))
  #define GAPA(MF,A0,A1,A2,A3,W0,W1,PW) do{ MF; sacc+=A0; sacc+=A1; sacc+=A2; sacc+=A3; PIN(sacc); W0; W1; PIN(PW); SBAR(); }while(0)
  #define EX(v) __builtin_amdgcn_exp2f(v)
  #define GAPB(MF,X,B) do{ MF; X[B]=EX(X[B]); X[B+1]=EX(X[B+1]); X[B+2]=EX(X[B+2]); X[B+3]=EX(X[B+3]); PIN(X); SBAR(); }while(0)
  #define VRD(i) do{ vlo[i]=vtr(vp_+(((i)>>2)*4096+((i)&3)*1024)); vhi[i]=vtr(vp_+(((i)>>2)*4096+((i)&3)*1024+512)); }while(0)
  #define KRD(G,j) do{ if(G){ kload2(kf,kp0+sl_next,j); SBAR(); } }while(0)
  #define STEP(C0,C1,P0,P1,t,GK,GV,GL) do{ SBAR(); \
    const lds_cptr vp_=vp0+sl_prev; \
    VRD(0); SBAR(); float sacc=(P0[0]+P0[1]); \
    GAPA(C0=__builtin_amdgcn_mfma_f32_32x32x16_bf16(kf[0],qr[0],negm,0,0,0), P0[2],P0[3],P0[4],P0[5],     pw0[0]=PKW(P0,0), pw0[1]=PKW(P0,2), pw0); \
    VRD(4); SBAR(); GAPA(C1=__builtin_amdgcn_mfma_f32_32x32x16_bf16(kf[1],qr[0],negm,0,0,0), P0[6],P0[7],P0[8],P0[9],     pw0[2]=PKW(P0,4), pw0[3]=PKW(P0,6), pw0); \
    VRD(1); SBAR(); GAPA(C0=__builtin_amdgcn_mfma_f32_32x32x16_bf16(kf[2],qr[1],C0,0,0,0),   P0[10],P0[11],P0[12],P0[13], pw1[0]=PKW(P0,8), pw1[1]=PKW(P0,10), pw1); \
    VRD(5); SBAR(); GAPA(C1=__builtin_amdgcn_mfma_f32_32x32x16_bf16(kf[3],qr[1],C1,0,0,0),   P0[14],P0[15],P1[0],P1[1],   pw1[2]=PKW(P0,12),pw1[3]=PKW(P0,14), pw1); \
    VRD(2); SBAR(); GAPA(C0=__builtin_amdgcn_mfma_f32_32x32x16_bf16(kf[4],qr[2],C0,0,0,0),   P1[2],P1[3],P1[4],P1[5],     pw2[0]=PKW(P1,0), pw2[1]=PKW(P1,2), pw2); \
    VRD(6); SBAR(); GAPA(C1=__builtin_amdgcn_mfma_f32_32x32x16_bf16(kf[5],qr[2],C1,0,0,0),   P1[6],P1[7],P1[8],P1[9],     pw2[2]=PKW(P1,4), pw2[3]=PKW(P1,6), pw2); \
    VRD(3); SBAR(); GAPA(C0=__builtin_amdgcn_mfma_f32_32x32x16_bf16(kf[6],qr[3],C0,0,0,0),   P1[10],P1[11],P1[12],P1[13], pw3[0]=PKW(P1,8), pw3[1]=PKW(P1,10), pw3); \
    VRD(7); SBAR(); GAPA(C1=__builtin_amdgcn_mfma_f32_32x32x16_bf16(kf[7],qr[3],C1,0,0,0),   P1[14],P1[15],0.f,0.f,       pw3[2]=PKW(P1,12),pw3[3]=PKW(P1,14), pw3); \
    l_reg+=sacc; \
    if(GK){DMA_K((t)+3,sl_cur);} if(GV){DMA_V((t)+1,sl_next);} \
    CMASK(C0,C1,t); \
    { float a=MX3(C0[0],C0[1],C1[0]),b=MX3(C0[2],C0[3],C1[1]); a=MX3(a,C1[2],C1[3]); \
      _Pragma("unroll") for(int r=4;r<16;r+=4){a=MX3(a,C0[r],C0[r+1]);b=MX3(b,C0[r+2],C0[r+3]);a=MX3(a,C1[r],C1[r+1]);b=MX3(b,C1[r+2],C1[r+3]);} \
      float rm=__builtin_fmaxf(a,b); { auto rr=__builtin_amdgcn_permlane32_swap(__float_as_uint(rm),__float_as_uint(rm),false,false); rm=__builtin_fmaxf(__uint_as_float(rr[0]),__uint_as_float(rr[1])); } \
      resc=false; \
      if(__builtin_expect(__any(rm>(float)THRL),0)){ const float dl=__builtin_fmaxf(rm,0.f); mhat+=dl; \
        _Pragma("unroll") for(int r=0;r<16;++r){C0[r]-=dl;C1[r]-=dl;} \
        _Pragma("unroll") for(int r=0;r<16;++r)negm[r]=-mhat; asm volatile("":"+v"(negm)); \
        const float f=__builtin_amdgcn_exp2f(-dl); l_reg*=f; if(hi==0)wsf[r32]=f; resc=true; } } \
    SBAR(); \
    GAPB(o[0]=__builtin_amdgcn_mfma_f32_32x32x16_bf16(PAF(0),VFR(0),o[0],0,0,0), C0,0); \
    GAPB(o[1]=__builtin_amdgcn_mfma_f32_32x32x16_bf16(PAF(0),VFR(4),o[1],0,0,0), C0,4); \
    KRD(GL,0); GAPB(o[0]=__builtin_amdgcn_mfma_f32_32x32x16_bf16(PAF(1),VFR(1),o[0],0,0,0), C0,8); \
    KRD(GL,1); GAPB(o[1]=__builtin_amdgcn_mfma_f32_32x32x16_bf16(PAF(1),VFR(5),o[1],0,0,0), C0,12); \
    KRD(GL,2); GAPB(o[0]=__builtin_amdgcn_mfma_f32_32x32x16_bf16(PAF(2),VFR(2),o[0],0,0,0), C1,0); \
    KRD(GL,3); GAPB(o[1]=__builtin_amdgcn_mfma_f32_32x32x16_bf16(PAF(2),VFR(6),o[1],0,0,0), C1,4); \
    GAPB(o[0]=__builtin_amdgcn_mfma_f32_32x32x16_bf16(PAF(3),VFR(3),o[0],0,0,0), C1,8); \
    GAPB(o[1]=__builtin_amdgcn_mfma_f32_32x32x16_bf16(PAF(3),VFR(7),o[1],0,0,0), C1,12); \
    }while(0)
  int t=1;
  #undef CMASK
  #define CMASK(P0,P1,t) do{}while(0)
  for(;t+5<NT;t+=2){
    STEP(pB0,pB1,pA0,pA1,t,true,true,true);     WAIT_BAR(2); RESC(); ROT();
    STEP(pA0,pA1,pB0,pB1,t+1,true,true,true);   WAIT_BAR(2); RESC(); ROT();
  }
  #undef CMASK
  #define CMASK(P0,P1,t) do{int jb_=(t)-(NT-4); if(jb_>=0)cmask(P0,P1,jb_,qrel,hi);}while(0)
  #define ENDW(tt) do{ if((tt)+3<NT){WAIT_BAR(2);} else if((tt)+2<NT){WAIT_BAR(1);} else {WAIT_BAR(0);} }while(0)
  for(;t+1<NT;t+=2){
    STEP(pB0,pB1,pA0,pA1,t,(t+3<NT),(t+1<NT),(t+1<NT));       ENDW(t);   RESC(); ROT();
    STEP(pA0,pA1,pB0,pB1,t+1,(t+4<NT),(t+2<NT),(t+2<NT));     ENDW(t+1); RESC(); ROT();
  }
  STEP(pB0,pB1,pA0,pA1,NT-1,false,false,false); RESC();
  { float sacc=pB0[0]+pB0[1]; _Pragma("unroll") for(int r=2;r<16;++r)sacc+=pB0[r]; _Pragma("unroll") for(int r=0;r<16;++r)sacc+=pB1[r]; l_reg+=sacc;
    pw0=(u32x4){PKW(pB0,0),PKW(pB0,2),PKW(pB0,4),PKW(pB0,6)};pw1=(u32x4){PKW(pB0,8),PKW(pB0,10),PKW(pB0,12),PKW(pB0,14)};pw2=(u32x4){PKW(pB1,0),PKW(pB1,2),PKW(pB1,4),PKW(pB1,6)};pw3=(u32x4){PKW(pB1,8),PKW(pB1,10),PKW(pB1,12),PKW(pB1,14)};
    SBAR(); pv(o,vb0+sl_cur,PAF(0),PAF(1),PAF(2),PAF(3)); }
  #undef PKW
  #undef PAF
  #undef VFR
  #undef PIN
  #undef MX3
  #undef GAPA
  #undef GAPB
  #undef EX
  #undef VRD
  #undef KRD
  #undef STEP
  #undef ENDW
  {auto rr=__builtin_amdgcn_permlane32_swap(__float_as_uint(l_reg),__float_as_uint(l_reg),false,false);l_reg=__uint_as_float(rr[0])+__uint_as_float(rr[1]);}
  if(hi==0)wsf[32+r32]=l_reg;asm volatile("s_waitcnt lgkmcnt(0)":::"memory");
  float rli[16];
  #pragma unroll
  for(int r=0;r<16;++r)rli[r]=__builtin_amdgcn_rcpf(wsf[32+crow(r,hi)]);
  bf16*Ow=O+(rowbase+q0+wid*QBLK)*OP+ocol;
  { bf16*stg=(bf16*)(shm+LDS_OST)+wid*2048;
    #pragma unroll
    for(int r=0;r<16;++r){const int orow=crow(r,hi);
      #pragma unroll
      for(int d0=0;d0<2;++d0)stg[orow*64+d0*32+r32]=__float2bfloat16(o[d0][r]*rli[r]);}
    asm volatile("s_waitcnt lgkmcnt(0)":::"memory");
    #pragma unroll
    for(int i=0;i<4;++i){const int row=i*8+(lane>>3),ch=lane&7; const u32x4 v=*(const u32x4*)(stg+row*64+ch*8); ATTN_STORE16(Ow+(long)row*OP+ch*8,v);} }
  asm volatile("s_waitcnt lgkmcnt(0)\n\ts_barrier":::"memory");
  #undef DMA_K
  #undef DMA_V
  #undef CMASK
  #undef START
  #undef RESC
  #undef ROT
}
constexpr int ATTN_LDS_BYTES=LDS_BYTES;
struct AttnTensors { const bf16* Q; const bf16* K; const bf16* V; bf16* O; };
struct AttnUnit { int bh; int qb; };
struct StaticOrder {
  int vcu;
  __device__ __forceinline__ explicit StaticOrder(int grid,int block):vcu((block%8)*(grid/8)+block/8){}
  __device__ __forceinline__ bool next(int i,AttnUnit&u)const{ if(i>=4)return false; const int s=vcu&7; u.bh=vcu>>3; u.qb=(i==0)?s:(i==1)?15-s:(i==2)?16+s:31-s; return true; }
  __device__ __forceinline__ void a_ready(const AttnUnit&)const{}
  __device__ __forceinline__ void done(const AttnUnit&)const{}
};
template<class Sched,int THRL=8> __device__ __forceinline__ void attn_phase(char*lds,const AttnTensors&T,const Sched&S){
  AttnUnit u;
  for(int i=0;S.next(i,u);++i){ S.a_ready(u); attn_unit<THRL>(u.bh/NHEAD,u.bh%NHEAD,u.qb,T.Q,T.K,T.V,T.O,lds); S.done(u); }
}
#undef SBAR
#undef WAIT_BAR
}
#define GAS __attribute__((address_space(1)))
#define LAS __attribute__((address_space(3)))
typedef unsigned short bf16;
typedef unsigned v4u __attribute__((ext_vector_type(4)));
typedef float f32x4 __attribute__((ext_vector_type(4)));
typedef short bf16x8 __attribute__((ext_vector_type(8)));
typedef GAS unsigned gu32;
typedef GAS unsigned long long gu64;
#define RLX_AGENT __ATOMIC_RELAXED, __HIP_MEMORY_SCOPE_AGENT
#define LDS_WAIT() asm volatile("s_waitcnt lgkmcnt(0)" ::: "memory")
#define VM_WAIT() asm volatile("s_waitcnt vmcnt(0)" ::: "memory")
__device__ __forceinline__ unsigned long long rt() { return __builtin_amdgcn_s_memrealtime(); }
__device__ __forceinline__ unsigned f2bf(float f) { unsigned u = __builtin_bit_cast(unsigned, f); return (u + 0x7fffu + ((u >> 16) & 1u)) >> 16; }
__device__ __forceinline__ unsigned pk2(float lo, float hi) { return f2bf(lo) | (f2bf(hi) << 16); }

#define XB_TMO      128
#define XB_XCNT(j)  (256  + 64 * (j))
#define XB_XSUB(j)  (1280 + 64 * (j))
#define XB_XGEN(j)  (2304 + 64 * (j))
#define XB_TOP      3328
#define XB_TOPGEN   3392
#define XCD_BAR_WORDS 3456
#define XB_SPIN_CAP (1u << 18)

__device__ __forceinline__ unsigned xb_ld(unsigned* p)              { return __hip_atomic_load(p, __ATOMIC_RELAXED, __HIP_MEMORY_SCOPE_AGENT); }
__device__ __forceinline__ unsigned xb_add(unsigned* p, unsigned v) { return __hip_atomic_fetch_add(p, v, __ATOMIC_RELAXED, __HIP_MEMORY_SCOPE_AGENT); }
__device__ __forceinline__ unsigned xb_xcc_id() { return (unsigned)__builtin_amdgcn_s_getreg((3 << 11) | 20) & 0xFu; }
#define XB_SPIN(cond, bar) do { unsigned _sp = 0; while (cond) { __builtin_amdgcn_s_sleep(1); \
    if ((++_sp & 255u) == 0u) { if (xb_ld(&(bar)[XB_TMO])) break; if (_sp > XB_SPIN_CAP) { atomicAdd(&(bar)[XB_TMO], 1u); break; } } } } while (0)

struct XcdBarrier {
    unsigned* bar; unsigned x;
    volatile LAS unsigned* st;
};

__device__ __forceinline__ XcdBarrier xcd_barrier_post(unsigned* bar, volatile LAS unsigned* st) {
    XcdBarrier b; b.bar = bar; b.x = xb_xcc_id(); b.st = st;
    if (threadIdx.x == 0) (void)xb_add(&bar[XB_XCNT(b.x)], 1u);
    return b;
}
__device__ __forceinline__ void xcd_barrier_complete(unsigned* bar, unsigned x, unsigned& nloc, unsigned& nx) {
    const unsigned G = gridDim.x * gridDim.y * gridDim.z;
    unsigned sum, cnt, mine, sp = 0u;
    for (;;) {
        sum = 0u; cnt = 0u; mine = 0u;
#pragma unroll
        for (unsigned j = 0; j < 16; ++j) { const unsigned c = xb_ld(&bar[XB_XCNT(j)]); sum += c; cnt += (c > 0u) ? 1u : 0u; mine = (j == x) ? c : mine; }
        if (sum == G) break;
        __builtin_amdgcn_s_sleep(1);
        if ((++sp & 255u) == 0u) { if (xb_ld(&bar[XB_TMO])) break; if (sp > XB_SPIN_CAP) { atomicAdd(&bar[XB_TMO], 1u); break; } }
    }
    nloc = mine > 0u ? mine : 1u; nx = cnt > 0u ? cnt : 1u;
}

__device__ __forceinline__ void xcd_barrier(const XcdBarrier& b) {
    asm volatile("s_waitcnt vmcnt(0)" ::: "memory");
    __syncthreads();
    if (threadIdx.x == 0) {
        unsigned* bar = b.bar;
        __builtin_amdgcn_s_waitcnt(0);
        unsigned nloc = b.st[0], nx = b.st[1];
        if (nloc == 0u) { xcd_barrier_complete(bar, b.x, nloc, nx); b.st[0] = nloc; b.st[1] = nx; }
        const unsigned old = xb_add(&bar[XB_XSUB(b.x)], 1u);
        const unsigned gen = old / nloc;
        if (old + 1u == (gen + 1u) * nloc) {
            __builtin_amdgcn_fence(__ATOMIC_RELEASE, "agent");
            asm volatile("s_waitcnt vmcnt(0)" ::: "memory");
            const unsigned og = xb_add(&bar[XB_TOP], 1u);
            const unsigned tg = og / nx;
            if (og + 1u == (tg + 1u) * nx) xb_add(&bar[XB_TOPGEN], 1u);
            else XB_SPIN(xb_ld(&bar[XB_TOPGEN]) == tg, bar);
            __builtin_amdgcn_fence(__ATOMIC_ACQUIRE, "agent");
            xb_add(&bar[XB_XGEN(b.x)], 1u);
            asm volatile("s_waitcnt vmcnt(0)" ::: "memory");
        } else {
            XB_SPIN(xb_ld(&bar[XB_XGEN(b.x)]) == gen, bar);
            __builtin_amdgcn_fence(__ATOMIC_ACQUIRE, "agent");
            asm volatile("s_waitcnt vmcnt(0)" ::: "memory");
        }
    }
    __syncthreads();
}
constexpr int NWAVES = 8;
constexpr int BATCH = 2, SEQ = 8192, D = 1024, M = BATCH * SEQ, DEPTH = 2, INC = 7168;
constexpr float LN_EPS = 1e-5f, ALPHA = 1.4142135623730951f, LOG2E = 1.4426950408889634f;
constexpr size_t MiB = 1u << 20;
constexpr size_t WS_CTL = 0, CTL_ZERO_BYTES = 1 * MiB;
constexpr size_t WS_WIN = 2 * MiB;
constexpr size_t WS_WBR = 30 * MiB;
constexpr size_t WS_WOUT = 36 * MiB;
constexpr size_t WS_WQ = 40 * MiB;
constexpr size_t WS_SUBK = 48 * MiB;
constexpr size_t WS_ROPEC = 49 * MiB, WS_ROPES = 51 * MiB;
constexpr size_t WS_LRUW = 53 * MiB;
constexpr size_t WS_MISC = 54 * MiB;
constexpr size_t WS_U = 56 * MiB, WS_V = 88 * MiB;
constexpr size_t WS_HB = 120 * MiB;
constexpr size_t WS_HL = WS_HB, WS_PP = 152 * MiB;
constexpr size_t WS_AQK = 184 * MiB;
constexpr size_t WS_AVT = 216 * MiB;
constexpr size_t WS_CQK = 232 * MiB;
constexpr size_t WS_CV = 264 * MiB;
constexpr size_t WS_BXG = 280 * MiB;
constexpr size_t WS_GATES = 312 * MiB;
constexpr size_t WS_YA = 408 * MiB, WS_YB = 424 * MiB, WS_YC = 440 * MiB;
constexpr size_t WS_CO = 456 * MiB;
constexpr size_t WS_END = 488 * MiB;
constexpr size_t WS_MERGEF = 184 * MiB;
constexpr size_t WS_MERGED = 248 * MiB;
constexpr size_t WS_YF = 312 * MiB;
constexpr size_t WS_PQ = 184 * MiB;
constexpr size_t WS_EIDX = 248 * MiB, WS_EG = 256 * MiB;
constexpr size_t WS_DBGH1 = 376 * MiB;
constexpr int CW_BAR = 4096;

constexpr int RING_OFF = 0, RING_BYTES = 131072;
constexpr int LDSCTL_OFF = RING_BYTES, MISC_OFF = LDSCTL_OFF + 320;
constexpr int LDS_BYTES = 147456;

typedef unsigned short bf16;
__device__ __forceinline__ float bf2f(unsigned short b) { return __uint_as_float((unsigned)b << 16); }
__device__ __forceinline__ float gelu_tanh(float x) {
    const float t = 1.5957691216057308f * (x + 0.044715f * x * x * x);
    return x * __builtin_amdgcn_rcpf(1.0f + __builtin_amdgcn_exp2f(-LOG2E * t));
}
__device__ __forceinline__ float wave_sum(float v) {
#pragma unroll
    for (int o = 1; o < 64; o <<= 1) v += __shfl_xor(v, o);
    return v;
}
typedef __bf16 bf16x2v __attribute__((ext_vector_type(2)));
__device__ __forceinline__ float dot2bf(unsigned a, unsigned b, float acc) { return __builtin_amdgcn_fdot2_f32_bf16(__builtin_bit_cast(bf16x2v, a), __builtin_bit_cast(bf16x2v, b), acc, false); }
typedef float f32x16 __attribute__((ext_vector_type(16)));
typedef unsigned u32x2e __attribute__((ext_vector_type(2)));
typedef int i32x4e __attribute__((ext_vector_type(4)));
#define MFMA32(a, b, c) __builtin_amdgcn_mfma_f32_32x32x16_bf16(a, b, c, 0, 0, 0)
#define MFMA16(a, b, c) __builtin_amdgcn_mfma_f32_16x16x32_bf16(a, b, c, 0, 0, 0)

__device__ __forceinline__ void p0_transpose_item(const float* W, int K, int N, bf16* WT, int perm_lo, int perm_hi, LAS float* scr, int item, int lane) {
    const int nblk = N / 32, kb = item / nblk, nb = item % nblk, k0 = 64 * kb, n0 = 32 * nb;
#pragma unroll 8
    for (int i = 0; i < 32; ++i) { const int kk = 2 * i + (lane >> 5); scr[kk * 33 + (lane & 31)] = W[(size_t)(k0 + kk) * N + n0 + (lane & 31)]; }
    LDS_WAIT(); asm volatile("" ::: "memory");
    const int c = lane & 7;
#pragma unroll
    for (int j = 0; j < 4; ++j) { const int n = (lane >> 3) + 8 * j; const LAS float* s = scr + (8 * c) * 33 + n;
        v4u o; o.x = pk2(s[0 * 33], s[1 * 33]); o.y = pk2(s[2 * 33], s[3 * 33]); o.z = pk2(s[4 * 33], s[5 * 33]); o.w = pk2(s[6 * 33], s[7 * 33]);
        int dn = n0 + n; if (dn >= perm_lo && dn < perm_hi) dn = (dn & ~63) + 2 * (dn & 31) + ((dn >> 5) & 1);
        *(GAS v4u*)(WT + (size_t)dn * K + k0 + 8 * c) = o; }
    LDS_WAIT(); asm volatile("" ::: "memory");
}
__device__ __forceinline__ void cvt_stream(const float* src, bf16* dst, size_t n8, size_t gt, size_t ngt) {
    for (size_t i = gt; i < n8; i += ngt) { const f32x4 a = *(const GAS f32x4*)(src + 8 * i), b = *(const GAS f32x4*)(src + 8 * i + 4);
        v4u o; o.x = pk2(a.x, a.y); o.y = pk2(a.z, a.w); o.z = pk2(b.x, b.y); o.w = pk2(b.z, b.w); *(GAS v4u*)(dst + 8 * i) = o; }
}
__device__ __forceinline__ void b1_unit(int l, int unit, LAS unsigned char* lds, const bf16* BXG, const bf16* LRUW, const float* conv_w, const float* conv_b,
                                        const float* b_r, const float* b_i, const float* lam, float* HL, float* PP, int tid, int wid, int lane) {
    const int b = unit >> 9, c = (unit >> 2) & 127, qt = unit & 3;
    LAS float* XC = (LAS float*)lds;
    LAS float* IG = (LAS float*)(lds + 32768);
    LAS bf16* XB = (LAS bf16*)(lds + 65536);
    {
        const int ch = tid & 127, tq = tid >> 7, gc = qt * 128 + ch, s0 = c * 64 + tq * 16;
        const float w0 = conv_w[(l * 4 + 0) * 512 + gc], w1 = conv_w[(l * 4 + 1) * 512 + gc], w2 = conv_w[(l * 4 + 2) * 512 + gc], w3 = conv_w[(l * 4 + 3) * 512 + gc], cb = conv_b[l * 512 + gc];
        const bf16* bx = BXG + (size_t)b * SEQ * 1024 + gc;
        float xm3 = (s0 >= 3) ? bf2f(bx[(size_t)(s0 - 3) * 1024]) : 0.f, xm2 = (s0 >= 2) ? bf2f(bx[(size_t)(s0 - 2) * 1024]) : 0.f, xm1 = (s0 >= 1) ? bf2f(bx[(size_t)(s0 - 1) * 1024]) : 0.f;
#pragma unroll 4
        for (int t = 0; t < 16; ++t) { const float x0 = bf2f(bx[(size_t)(s0 + t) * 1024]); const float xc = cb + xm3 * w0 + xm2 * w1 + xm1 * w2 + x0 * w3;
            XC[(tq * 16 + t) * 128 + ch] = xc; XB[(tq * 16 + t) * 136 + ch] = (bf16)f2bf(xc); xm3 = xm2; xm2 = xm1; xm1 = x0; }
    }
    __syncthreads();
    const int blk = wid & 1, gate = (wid >> 1) & 1, th = wid >> 2, g = qt * 2 + blk, fr = lane & 15, fq = lane >> 4;
    f32x4 acc[2][4];
#pragma unroll
    for (int mt = 0; mt < 2; ++mt)
#pragma unroll
        for (int nt = 0; nt < 4; ++nt) acc[mt][nt] = (f32x4){0.f, 0.f, 0.f, 0.f};
    {
        const bf16* wb = LRUW + (size_t)(((l * 2 + gate) * 8 + g) * 64) * 64;
#pragma unroll
        for (int ks = 0; ks < 2; ++ks) { bf16x8 af[2], bfr[4];
#pragma unroll
            for (int mt = 0; mt < 2; ++mt) af[mt] = *(const LAS bf16x8*)(XB + (th * 32 + mt * 16 + fr) * 136 + blk * 64 + ks * 32 + 8 * fq);
#pragma unroll
            for (int nt = 0; nt < 4; ++nt) bfr[nt] = *(const GAS bf16x8*)(wb + (nt * 16 + fr) * 64 + ks * 32 + 8 * fq);
#pragma unroll
            for (int mt = 0; mt < 2; ++mt)
#pragma unroll
                for (int nt = 0; nt < 4; ++nt) acc[mt][nt] = MFMA16(af[mt], bfr[nt], acc[mt][nt]); }
    }
    const float* bias = (gate ? b_i : b_r) + (l * 8 + g) * 64;
#pragma unroll
    for (int nt = 0; nt < 4; ++nt) { const float bj = bias[nt * 16 + fr];
#pragma unroll
        for (int mt = 0; mt < 2; ++mt)
#pragma unroll
            for (int e = 0; e < 4; ++e) acc[mt][nt][e] = pg8::sigm(acc[mt][nt][e] + bj); }
    if (gate == 1) {
#pragma unroll
        for (int nt = 0; nt < 4; ++nt)
#pragma unroll
            for (int mt = 0; mt < 2; ++mt)
#pragma unroll
                for (int e = 0; e < 4; ++e) IG[(th * 32 + mt * 16 + 4 * fq + e) * 128 + blk * 64 + nt * 16 + fr] = acc[mt][nt][e];
    }
    __syncthreads();
    if (gate == 0) {
#pragma unroll
        for (int nt = 0; nt < 4; ++nt) { const float lm = lam[l * 512 + g * 64 + nt * 16 + fr];
            const float ls8 = -8.0f * log1pf(expf(-lm));
#pragma unroll
            for (int mt = 0; mt < 2; ++mt)
#pragma unroll
                for (int e = 0; e < 4; ++e) { const int o = (th * 32 + mt * 16 + 4 * fq + e) * 128 + blk * 64 + nt * 16 + fr;
                    const float la = acc[mt][nt][e] * ls8, a = expf(la), mult = sqrtf(-expm1f(2.0f * la));
                    const float u = mult * (IG[o] * XC[o]); IG[o] = a; XC[o] = u; } }
    }
    __syncthreads();
    if (tid < 128) { float h = 0.f, p = 1.f; const size_t o0 = ((size_t)b * SEQ + c * 64) * 512 + qt * 128 + tid;
#pragma unroll 8
        for (int t = 0; t < 64; ++t) { const float a = IG[t * 128 + tid], u = XC[t * 128 + tid]; h = a * h + u; p *= a; HL[o0 + (size_t)t * 512] = h; PP[o0 + (size_t)t * 512] = p; } }
    __syncthreads();
}
__device__ __forceinline__ void b3_unit(int unit, const float* HL, const float* PP, const bf16* BXG, bf16* YB, int tid) {
    const int b = unit >> 7, c = unit & 127; float hin = 0.f;
    const size_t base = (size_t)b * SEQ * 512 + tid;
#pragma unroll 4
    for (int cc = 0; cc < c; ++cc) { const size_t o = base + (size_t)(cc * 64 + 63) * 512; hin = PP[o] * hin + HL[o]; }
#pragma unroll 4
    for (int t = 0; t < 64; ++t) { const size_t row = (size_t)b * SEQ + c * 64 + t; const float h = HL[row * 512 + tid] + PP[row * 512 + tid] * hin;
        YB[row * 512 + tid] = (bf16)f2bf(h * gelu_tanh(bf2f(BXG[row * 1024 + 512 + tid]))); }
}
__device__ __forceinline__ void band_unit(int unit, const bf16* AQK, const bf16* AVT, const float* relb, bf16* YA, int head, int lane) {
    const int b = unit >> 7, c = unit & 127, r32 = lane & 31, hi = lane >> 5;
    const int kap = (r32 & ~12) | ((r32 & 4) << 1) | ((r32 & 8) >> 1);
    const int j0 = c >= 8 ? c - 8 : 0;
    const float* rb = relb + head * 320;
    for (int qh = 0; qh < 2; ++qh) {
        const size_t qrow = (size_t)b * SEQ + c * 64 + qh * 32 + r32; const int qpos = c * 64 + qh * 32 + r32;
        bf16x8 qf[4];
#pragma unroll
        for (int ks = 0; ks < 4; ++ks) qf[ks] = *(const GAS bf16x8*)(AQK + qrow * 1024 + head * 64 + ks * 16 + hi * 8);
        f32x16 o0 = {}, o1 = {}; float mrun = -1e30f, lsum = 0.f;
        for (int j = j0; j <= c; ++j) {
            f32x16 s0 = {}, s1 = {};
            { const bf16* kp = AQK + ((size_t)b * SEQ + j * 64 + kap) * 1024 + 512 + head * 64 + hi * 8;
#pragma unroll
              for (int ks = 0; ks < 4; ++ks) { const bf16x8 k0 = *(const GAS bf16x8*)(kp + ks * 16), k1 = *(const GAS bf16x8*)(kp + 32 * 1024 + ks * 16);
                  s0 = MFMA32(k0, qf[ks], s0); s1 = MFMA32(k1, qf[ks], s1); } }
            float mx = -1e30f;
#pragma unroll
            for (int r = 0; r < 16; ++r) { const int kpos = j * 64 + (r & 3) + 4 * ((r >> 2) & 1) + 8 * hi + 16 * (r >> 3);
                int d0 = qpos - kpos, d1 = d0 - 32; d0 = d0 < -63 ? -63 : (d0 > 256 ? 256 : d0); d1 = d1 < -63 ? -63 : (d1 > 256 ? 256 : d1);
                s0[r] += rb[d0 + 63] * LOG2E; s1[r] += rb[d1 + 63] * LOG2E; mx = fmaxf(mx, fmaxf(s0[r], s1[r])); }
            mx = fmaxf(mx, __shfl_xor(mx, 32));
            const float mnew = fmaxf(mrun, mx), al = __builtin_amdgcn_exp2f(mrun - mnew); mrun = mnew;
            float ps = 0.f;
#pragma unroll
            for (int r = 0; r < 16; ++r) { s0[r] = __builtin_amdgcn_exp2f(s0[r] - mnew); s1[r] = __builtin_amdgcn_exp2f(s1[r] - mnew); ps += s0[r] + s1[r]; }
            lsum = lsum * al + ps;
#pragma unroll
            for (int r = 0; r < 16; ++r) { o0[r] *= al; o1[r] *= al; }
            const bf16* vp = AVT + ((size_t)(head * 64 + r32)) * M + (size_t)b * SEQ + j * 64 + 8 * hi;
#pragma unroll
            for (int kb = 0; kb < 2; ++kb)
#pragma unroll
                for (int s2 = 0; s2 < 2; ++s2) { const f32x16& sv = kb ? s1 : s0; pg8::u32x4 pw;
                    pw.x = pg8::cvt_pk_bf16(sv[8 * s2 + 0], sv[8 * s2 + 1]); pw.y = pg8::cvt_pk_bf16(sv[8 * s2 + 2], sv[8 * s2 + 3]);
                    pw.z = pg8::cvt_pk_bf16(sv[8 * s2 + 4], sv[8 * s2 + 5]); pw.w = pg8::cvt_pk_bf16(sv[8 * s2 + 6], sv[8 * s2 + 7]);
                    const bf16x8 pf = __builtin_bit_cast(bf16x8, pw);
                    const bf16x8 v0 = *(const GAS bf16x8*)(vp + kb * 32 + s2 * 16), v1 = *(const GAS bf16x8*)(vp + (size_t)32 * M + kb * 32 + s2 * 16);
                    o0 = MFMA32(v0, pf, o0); o1 = MFMA32(v1, pf, o1); }
        }
        lsum += __shfl_xor(lsum, 32);
        const float rl = 1.0f / lsum;
        bf16* yp = YA + qrow * 512 + head * 64 + 4 * hi;
#pragma unroll
        for (int g4 = 0; g4 < 4; ++g4) {
            u32x2e w0, w1; w0.x = pg8::cvt_pk_bf16(o0[4 * g4] * rl, o0[4 * g4 + 1] * rl); w0.y = pg8::cvt_pk_bf16(o0[4 * g4 + 2] * rl, o0[4 * g4 + 3] * rl);
            w1.x = pg8::cvt_pk_bf16(o1[4 * g4] * rl, o1[4 * g4 + 1] * rl); w1.y = pg8::cvt_pk_bf16(o1[4 * g4 + 2] * rl, o1[4 * g4 + 3] * rl);
            *(GAS u32x2e*)(yp + 8 * g4) = w0; *(GAS u32x2e*)(yp + 32 + 8 * g4) = w1; }
    }
}
__device__ __forceinline__ void comb_row(size_t row, const bf16* CO, const float* subg, float lamv, float oml, bf16* YC, int lane) {
    const pg8::u32x4 a = *(const GAS pg8::u32x4*)(CO + row * 1024 + 16 * lane), bq = *(const GAS pg8::u32x4*)(CO + row * 1024 + 16 * lane + 8);
    float v[16]; const unsigned w[8] = {a.x, a.y, a.z, a.w, bq.x, bq.y, bq.z, bq.w};
#pragma unroll
    for (int i = 0; i < 8; ++i) { v[2 * i] = __uint_as_float(w[i] << 16); v[2 * i + 1] = __uint_as_float(w[i] & 0xffff0000u); }
    float ss = 0.f;
#pragma unroll
    for (int i = 0; i < 16; ++i) { const float o2 = __shfl_xor(v[i], 8); v[i] = v[i] - lamv * o2; ss += v[i] * v[i]; }
    ss += __shfl_xor(ss, 1); ss += __shfl_xor(ss, 2); ss += __shfl_xor(ss, 4);
    const float rs = 1.0f / sqrtf(ss * (1.0f / 128.0f) + LN_EPS) * oml;
    if ((lane & 8) == 0) { const int h = lane >> 4, e0 = (lane & 7) * 16;
        unsigned ow[8];
#pragma unroll
        for (int i = 0; i < 8; ++i) ow[i] = pk2(v[2 * i] * rs * subg[e0 + 2 * i], v[2 * i + 1] * rs * subg[e0 + 2 * i + 1]);
        bf16* yp = YC + row * 512 + h * 128 + e0;
        *(GAS pg8::u32x4*)yp = (pg8::u32x4){ow[0], ow[1], ow[2], ow[3]}; *(GAS pg8::u32x4*)(yp + 8) = (pg8::u32x4){ow[4], ow[5], ow[6], ow[7]}; }
}
__device__ __forceinline__ void ln_row(const float* yrow, const float* g, const float* bta, float* hf, bf16* hb, float* dbg, int lane) {
    const GAS f32x4* xr = (const GAS f32x4*)yrow + lane;
    f32x4 v[4]; float s = 0.f;
#pragma unroll
    for (int j = 0; j < 4; ++j) { v[j] = xr[64 * j]; s += (v[j].x + v[j].y) + (v[j].z + v[j].w); }
    const float mean = wave_sum(s) * (1.f / D); float s2 = 0.f;
#pragma unroll
    for (int j = 0; j < 4; ++j) { v[j] = v[j] - mean; s2 += (v[j].x * v[j].x + v[j].y * v[j].y) + (v[j].z * v[j].z + v[j].w * v[j].w); }
    const float rstd = 1.f / sqrtf(wave_sum(s2) * (1.f / D) + LN_EPS);
#pragma unroll
    for (int j = 0; j < 4; ++j) { const f32x4 gg = *(const GAS f32x4*)(g + 4 * lane + 256 * j), bb = *(const GAS f32x4*)(bta + 4 * lane + 256 * j);
        const f32x4 o = v[j] * rstd * gg + bb;
        *((GAS f32x4*)hf + lane + 64 * j) = o; if (dbg) *((GAS f32x4*)dbg + lane + 64 * j) = o;
        *((GAS unsigned long long*)hb + lane + 64 * j) = (unsigned long long)pk2(o.x, o.y) | ((unsigned long long)pk2(o.z, o.w) << 32); }
}
__device__ __forceinline__ unsigned ordkey(float f) { unsigned u = __float_as_uint(f); return u ^ ((unsigned)((int)u >> 31) | 0x80000000u); }
__device__ __forceinline__ float ordval(unsigned k) { return __uint_as_float(k ^ ((k & 0x80000000u) ? 0x80000000u : 0xffffffffu)); }
#define INS16(L, x) do { _Pragma("unroll") for (int i_ = 0; i_ < 16; ++i_) { const unsigned h_ = L[i_] > x ? L[i_] : x; x = L[i_] > x ? x : L[i_]; L[i_] = h_; } } while (0)
__device__ __forceinline__ void topk_unit(int unit, const bf16* PQ, const bf16* SUBK, int* EIDX, float* EG, LAS unsigned* wl  , int lane) {
    const int tt = unit >> 3, hh = unit & 7, r32 = lane & 31, hi = lane >> 5;
    const size_t trow = (size_t)tt * 32 + r32;
    unsigned S[2][16];
#pragma unroll
    for (int p = 0; p < 2; ++p) {
        bf16x8 qf[8];
#pragma unroll
        for (int ks = 0; ks < 8; ++ks) qf[ks] = *(const GAS bf16x8*)(PQ + trow * 2048 + (hh * 2 + p) * 128 + ks * 16 + hi * 8);
        unsigned L[16];
#pragma unroll
        for (int i = 0; i < 16; ++i) L[i] = 0u;
        const bf16* kb = SUBK + (size_t)((hh * 2 + p) * 128 + r32) * 128 + hi * 8;
#pragma unroll
        for (int rt = 0; rt < 4; ++rt) { f32x16 acc = {}; const bf16* kr = kb + (size_t)rt * 32 * 128; asm volatile("" : "+v"(kr));
#pragma unroll
            for (int ks = 0; ks < 8; ++ks) { const bf16x8 kf = *(const GAS bf16x8*)(kr + ks * 16); acc = MFMA32(kf, qf[ks], acc); }
#pragma unroll
            for (int r = 0; r < 16; ++r) { const int n = rt * 32 + (r & 3) + 8 * (r >> 2) + 4 * hi; unsigned x = (ordkey(acc[r]) & ~127u) | (unsigned)n; INS16(L, x); }
            asm volatile("" ::: "memory"); }
        unsigned Mx[16];
#pragma unroll
        for (int i = 0; i < 16; ++i) { const unsigned o = (unsigned)__shfl_xor((int)L[15 - i], 32); Mx[i] = L[i] > o ? L[i] : o; }
#pragma unroll
        for (int st = 8; st >= 1; st >>= 1)
#pragma unroll
            for (int i = 0; i < 16; ++i) if ((i & st) == 0) { const unsigned a = Mx[i], b2 = Mx[i + st]; Mx[i] = a > b2 ? a : b2; Mx[i + st] = a > b2 ? b2 : a; }
#pragma unroll
        for (int i = 0; i < 16; ++i) { S[p][i] = Mx[i]; wl[(p * 16 + i) * 64 + lane] = Mx[i]; }
    }
    unsigned F[16];
#pragma unroll
    for (int i = 0; i < 16; ++i) F[i] = 0u;
#pragma unroll
    for (int i = 0; i < 16; ++i)
#pragma unroll
        for (int j = 0; j < 16; ++j) if ((i + 1) * (j + 1) <= 16) { const float sm = ordval(S[0][i] & ~127u) + ordval(S[1][j] & ~127u); unsigned x = (ordkey(sm) & ~255u) | (unsigned)(i * 16 + j); INS16(F, x); }
    LDS_WAIT();
    float fs[16]; int ex[16]; float mx = -1e30f;
#pragma unroll
    for (int k = 0; k < 16; ++k) { const int i = (F[k] >> 4) & 15, j = F[k] & 15; const unsigned k0 = wl[i * 64 + lane], k1 = wl[(16 + j) * 64 + lane];
        fs[k] = ordval(k0 & ~127u) + ordval(k1 & ~127u); ex[k] = (int)((k0 & 127u) * 128u + (k1 & 127u)); mx = fmaxf(mx, fs[k]); }
    float sum = 0.f;
#pragma unroll
    for (int k = 0; k < 16; ++k) { fs[k] = __builtin_amdgcn_exp2f((fs[k] - mx) * LOG2E); sum += fs[k]; }
    const float rs = 1.0f / sum;
    if (hi == 0) { int* ep = EIDX + (trow * 8 + hh) * 16; float* gp = EG + (trow * 8 + hh) * 16;
#pragma unroll
        for (int q4 = 0; q4 < 4; ++q4) { *(GAS i32x4e*)(ep + 4 * q4) = (i32x4e){ex[4 * q4], ex[4 * q4 + 1], ex[4 * q4 + 2], ex[4 * q4 + 3]};
            *(GAS f32x4*)(gp + 4 * q4) = (f32x4){fs[4 * q4] * rs, fs[4 * q4 + 1] * rs, fs[4 * q4 + 2] * rs, fs[4 * q4 + 3] * rs}; } }
    LDS_WAIT();
}
__device__ __forceinline__ void peer_row(size_t t, const float* hin, const int* EIDX, const float* EG, const bf16* U, const bf16* V, const float* g2, const float* b2, float* hf, bf16* hb, int lane) {
    f32x4 xv[4];
#pragma unroll
    for (int j = 0; j < 4; ++j) xv[j] = *(const GAS f32x4*)(hin + t * 1024 + 16 * lane + 4 * j);
    unsigned xp[8];
#pragma unroll
    for (int j = 0; j < 4; ++j) { xp[2 * j] = pk2(xv[j].x, xv[j].y); xp[2 * j + 1] = pk2(xv[j].z, xv[j].w); }
    float o[16];
#pragma unroll
    for (int i = 0; i < 16; ++i) o[i] = 0.f;
    const int ei0 = EIDX[t * 128 + lane], ei1 = EIDX[t * 128 + 64 + lane]; const float eg0 = EG[t * 128 + lane], eg1 = EG[t * 128 + 64 + lane];
    const int b5 = lane >> 5, b4 = (lane >> 4) & 1, b3 = (lane >> 3) & 1, eloc = b5 * 4 + b4 * 2 + b3;
    for (int grp = 0; grp < 16; ++grp) {
        const int src = grp < 8 ? ei0 : ei1; const float gsrc = grp < 8 ? eg0 : eg1; const int l0 = (grp & 7) * 8;
        int idx[8]; pg8::u32x4 ua[8], ub[8], va[8], vb[8];
#pragma unroll
        for (int e = 0; e < 8; ++e) { idx[e] = __builtin_amdgcn_readlane(src, l0 + e); const bf16* up = U + (size_t)idx[e] * 1024 + 16 * lane; ua[e] = *(const GAS pg8::u32x4*)up; ub[e] = *(const GAS pg8::u32x4*)(up + 8); }
#pragma unroll
        for (int e = 0; e < 8; ++e) { const bf16* vp = V + (size_t)idx[e] * 1024 + 16 * lane; va[e] = *(const GAS pg8::u32x4*)vp; vb[e] = *(const GAS pg8::u32x4*)(vp + 8); }
        float p[8];
#pragma unroll
        for (int e = 0; e < 8; ++e) { float a = dot2bf(ua[e].x, xp[0], 0.f); a = dot2bf(ua[e].y, xp[1], a); a = dot2bf(ua[e].z, xp[2], a); a = dot2bf(ua[e].w, xp[3], a);
            a = dot2bf(ub[e].x, xp[4], a); a = dot2bf(ub[e].y, xp[5], a); a = dot2bf(ub[e].z, xp[6], a); a = dot2bf(ub[e].w, xp[7], a); p[e] = a; }
        float q[4], r2[2], s;
#pragma unroll
        for (int i = 0; i < 4; ++i) { const float keep = b5 ? p[i + 4] : p[i], send = b5 ? p[i] : p[i + 4]; q[i] = keep + __shfl_xor(send, 32); }
#pragma unroll
        for (int i = 0; i < 2; ++i) { const float keep = b4 ? q[i + 2] : q[i], send = b4 ? q[i] : q[i + 2]; r2[i] = keep + __shfl_xor(send, 16); }
        { const float keep = b3 ? r2[1] : r2[0], send = b3 ? r2[0] : r2[1]; s = keep + __shfl_xor(send, 8); }
        s += __shfl_xor(s, 4); s += __shfl_xor(s, 2); s += __shfl_xor(s, 1);
        const float w = gelu_tanh(s) * __shfl(gsrc, l0 + eloc);
#pragma unroll
        for (int e = 0; e < 8; ++e) { const float we = __builtin_bit_cast(float, __builtin_amdgcn_readlane(__builtin_bit_cast(int, w), e * 8));
            const unsigned vw[8] = {va[e].x, va[e].y, va[e].z, va[e].w, vb[e].x, vb[e].y, vb[e].z, vb[e].w};
#pragma unroll
            for (int i = 0; i < 8; ++i) { o[2 * i] += we * __uint_as_float(vw[i] << 16); o[2 * i + 1] += we * __uint_as_float(vw[i] & 0xffff0000u); } }
    }
    float y[16]; float sm = 0.f;
#pragma unroll
    for (int j = 0; j < 4; ++j) { y[4 * j] = ALPHA * xv[j].x + o[4 * j]; y[4 * j + 1] = ALPHA * xv[j].y + o[4 * j + 1]; y[4 * j + 2] = ALPHA * xv[j].z + o[4 * j + 2]; y[4 * j + 3] = ALPHA * xv[j].w + o[4 * j + 3]; }
#pragma unroll
    for (int i = 0; i < 16; ++i) sm += y[i];
    const float mean = wave_sum(sm) * (1.f / D); float s2 = 0.f;
#pragma unroll
    for (int i = 0; i < 16; ++i) { y[i] -= mean; s2 += y[i] * y[i]; }
    const float rstd = 1.f / sqrtf(wave_sum(s2) * (1.f / D) + LN_EPS);
    unsigned ow[8];
#pragma unroll
    for (int j = 0; j < 4; ++j) { const f32x4 gg = *(const GAS f32x4*)(g2 + 16 * lane + 4 * j), bb = *(const GAS f32x4*)(b2 + 16 * lane + 4 * j);
        f32x4 ov; ov.x = y[4 * j] * rstd * gg.x + bb.x; ov.y = y[4 * j + 1] * rstd * gg.y + bb.y; ov.z = y[4 * j + 2] * rstd * gg.z + bb.z; ov.w = y[4 * j + 3] * rstd * gg.w + bb.w;
        *(GAS f32x4*)(hf + t * 1024 + 16 * lane + 4 * j) = ov; ow[2 * j] = pk2(ov.x, ov.y); ow[2 * j + 1] = pk2(ov.z, ov.w); }
    *(GAS pg8::u32x4*)(hb + t * 1024 + 16 * lane) = (pg8::u32x4){ow[0], ow[1], ow[2], ow[3]}; *(GAS pg8::u32x4*)(hb + t * 1024 + 16 * lane + 8) = (pg8::u32x4){ow[4], ow[5], ow[6], ow[7]};
}
#if MK_DEBUG
struct Args;
#define DBG_WORDS 64
__device__ __forceinline__ unsigned dh(unsigned x) { x ^= x >> 16; x *= 0x7feb352dU; x ^= x >> 15; x *= 0x846ca68bU; x ^= x >> 16; return x; }
__device__ __forceinline__ void dbg_rec(unsigned* slot, float got, float want, float fl) {
    float e = fabsf(got - want) / (fabsf(want) + fl); if (!(e == e) || e > 1e30f) e = 1e30f; atomicMax(slot, __float_as_uint(e));
}
__device__ __forceinline__ float dbf(const bf16* p, size_t i) { return bf2f(p[i]); }
__device__ __forceinline__ float rbf(float x) { return bf2f((bf16)f2bf(x)); }
__device__ __forceinline__ float dsig(float x) { return 1.0f / (1.0f + expf(-x)); }
__device__ __forceinline__ float dgelu(float x) { return 0.5f * x * (1.0f + tanhf(0.7978845608028654f * (x + 0.044715f * x * x * x))); }
struct DArgs { const void* in[24]; float* out; unsigned char* ws; float invf[32]; int p, pad; };
#define DW(T, off) ((T*)(a.ws + (off)))
__global__ void __launch_bounds__(256) dbg_kernel(DArgs a) {
    __shared__ float sh[1024 + 256 + 64];
    const int p = a.p, l = p == 0 ? 0 : (p - 1) / 10, q = p == 0 ? 100 : (p - 1) % 10, tid = threadIdx.x;
    unsigned* slot = DW(unsigned, WS_MISC) + 16 + p;
    const unsigned sid = blockIdx.x * 256 + tid; unsigned r = dh(sid * 2654435761u + 77u * p + 1u);
#define RND(n) ((r = dh(r + 0x9e3779b9u)) % (unsigned)(n))
    const bf16* WINl = DW(bf16, WS_WIN) + (size_t)l * INC * 1024;
    if (q == 100) {
        { const int ll = RND(2), n = RND(INC), k = RND(1024); int dn = n; if (n >= 2560 && n < 3584) dn = (n & ~63) + 2 * (n & 31) + ((n >> 5) & 1);
          dbg_rec(slot, dbf(DW(bf16, WS_WIN), ((size_t)ll * INC + dn) * 1024 + k), rbf(((const float*)a.in[2])[((size_t)ll * 1024 + k) * INC + n]), 1e-3f); }
        { const int qq = RND(6), n = RND(1024), k = RND(512); dbg_rec(slot, dbf(DW(bf16, WS_WBR), ((size_t)qq * 1024 + n) * 512 + k), rbf(((const float*)a.in[14])[((size_t)qq * 512 + k) * 1024 + n]), 1e-3f); }
        { const int ll = RND(2), n = RND(1024), k = RND(1024); dbg_rec(slot, dbf(DW(bf16, WS_WOUT), ((size_t)ll * 1024 + n) * 1024 + k), rbf(((const float*)a.in[15])[((size_t)ll * 1024 + k) * 1024 + n]), 1e-3f); }
        { const int ll = RND(2), n = RND(2048), k = RND(1024); dbg_rec(slot, dbf(DW(bf16, WS_WQ), ((size_t)ll * 2048 + n) * 1024 + k), rbf(((const float*)a.in[18])[((size_t)ll * 1024 + k) * 2048 + n]), 1e-3f); }
        { const size_t i = RND(524288); dbg_rec(slot, dbf(DW(bf16, WS_SUBK), i), rbf(((const float*)a.in[19])[i]), 1e-3f); }
        { const size_t i = (size_t)RND(16384) * 1024 + RND(1024); dbg_rec(slot, dbf(DW(bf16, WS_U), i), rbf(((const float*)a.in[20])[i]), 1e-4f); dbg_rec(slot, dbf(DW(bf16, WS_V), i), rbf(((const float*)a.in[21])[i]), 1e-3f);
          dbg_rec(slot, dbf(DW(bf16, WS_HB), i), rbf(((const float*)a.in[0])[i]), 1e-3f); }
        { const int row = RND(M), fi = RND(32); const float ang = (float)((const int*)a.in[1])[row] * a.invf[fi]; const double rev = (double)ang * 0.15915494309189535; const float fr = (float)(rev - rint(rev)) * 6.283185307179586f;
          dbg_rec(slot, DW(float, WS_ROPEC)[row * 32 + fi], cosf(fr), 0.05f); dbg_rec(slot, DW(float, WS_ROPES)[row * 32 + fi], sinf(fr), 0.05f); }
        { const int i = RND(131072); const int k = i & 63, j = (i >> 6) & 63, g = (i >> 12) & 7, gate = (i >> 15) & 1, ll = i >> 16;
          dbg_rec(slot, dbf(DW(bf16, WS_LRUW), i), rbf(((const float*)a.in[gate ? 9 : 7])[((size_t)(ll * 8 + g) * 64 + k) * 64 + j]), 1e-3f); }
    } else if (q == 0) {
        const int row = RND(M); int c = RND(INC) & ~1;
        const bf16* hb = DW(bf16, WS_HB) + (size_t)row * 1024; float z0 = 0.f, z1 = 0.f;
        for (int k = 0; k < 1024; ++k) { const float h = bf2f(hb[k]); z0 += h * dbf(WINl, (size_t)c * 1024 + k); z1 += h * dbf(WINl, (size_t)(c + 1) * 1024 + k); }
        float g0, g1; const float C2S = 0.125f * LOG2E;
        if (c < 512) { g0 = dbf(DW(bf16, WS_AQK), (size_t)row * 1024 + c); g1 = dbf(DW(bf16, WS_AQK), (size_t)row * 1024 + c + 1); z0 *= C2S; z1 *= C2S; }
        else if (c < 1024) { g0 = dbf(DW(bf16, WS_AQK), (size_t)row * 1024 + c); g1 = dbf(DW(bf16, WS_AQK), (size_t)row * 1024 + c + 1); }
        else if (c < 1536) { g0 = dbf(DW(bf16, WS_AVT), (size_t)(c - 1024) * M + row); g1 = dbf(DW(bf16, WS_AVT), (size_t)(c - 1023) * M + row); }
        else if (c < 2560) { g0 = dbf(DW(bf16, WS_BXG), (size_t)row * 1024 + c - 1536); g1 = dbf(DW(bf16, WS_BXG), (size_t)row * 1024 + c - 1535); }
        else if (c < 3584) { const int i = (c & 63) >> 1; const float cs = DW(float, WS_ROPEC)[row * 32 + i], sn = DW(float, WS_ROPES)[row * 32 + i]; const float sc = c < 3072 ? C2S : 1.f;
            const float o0 = (z0 * cs - z1 * sn) * sc, o1 = (z1 * cs + z0 * sn) * sc; z0 = o0; z1 = o1;
            g0 = dbf(DW(bf16, WS_CQK), (size_t)row * 1024 + c - 2560); g1 = dbf(DW(bf16, WS_CQK), (size_t)row * 1024 + c - 2559); }
        else if (c < 4096) { g0 = dbf(DW(bf16, WS_CV), (size_t)row * 512 + c - 3584); g1 = dbf(DW(bf16, WS_CV), (size_t)row * 512 + c - 3583); }
        else { const float* gb = (const float*)a.in[3] + l * 3072; z0 = dsig(z0 + gb[c - 4096]); z1 = dsig(z1 + gb[c - 4095]); g0 = dbf(DW(bf16, WS_GATES), (size_t)row * 3072 + c - 4096); g1 = dbf(DW(bf16, WS_GATES), (size_t)row * 3072 + c - 4095); }
        { const int sec = c < 512 ? 0 : c < 1024 ? 1 : c < 1536 ? 2 : c < 2560 ? 3 : c < 3072 ? 4 : c < 3584 ? 5 : c < 4096 ? 6 : 7; unsigned* s2 = DW(unsigned, WS_MISC) + 40 + sec; if (l == 0) { dbg_rec(s2, g0, z0, 0.05f); dbg_rec(s2, g1, z1, 0.05f); if (sec == 7) { unsigned* s3 = DW(unsigned, WS_MISC) + 48 + (c - 4096) / 256; dbg_rec(s3, g0, z0, 0.05f); dbg_rec(s3, g1, z1, 0.05f); } } }
        dbg_rec(slot, g0, z0, 0.05f); dbg_rec(slot, g1, z1, 0.05f);
    } else if (q == 1) {
        if (blockIdx.x < 16) {
        const int row = RND(M), ch = RND(512), b = row >> 13, s = row & 8191, t0 = s & ~63, g = ch >> 6, j = ch & 63;
        const bf16* bxg = DW(bf16, WS_BXG); const float* cw = (const float*)a.in[5] + l * 2048; const float* cb = (const float*)a.in[6] + l * 512;
        const bf16* wr = DW(bf16, WS_LRUW) + (size_t)(((l * 2 + 0) * 8 + g) * 64 + j) * 64; const bf16* wi = DW(bf16, WS_LRUW) + (size_t)(((l * 2 + 1) * 8 + g) * 64 + j) * 64;
        const float lm = ((const float*)a.in[11])[l * 512 + ch], ls8 = -8.0f * log1pf(expf(-lm));
        float h = 0.f, pp = 1.f;
        for (int t = t0; t <= s; ++t) { float ar = ((const float*)a.in[8])[(l * 8 + g) * 64 + j], ai = ((const float*)a.in[10])[(l * 8 + g) * 64 + j], xcm = 0.f;
            for (int k = 0; k < 64; ++k) { const int c2 = g * 64 + k; float xc = cb[c2];
                for (int tap = 0; tap < 4; ++tap) { const int tt = t - 3 + tap; if (tt >= 0) xc += dbf(bxg, ((size_t)b * SEQ + tt) * 1024 + c2) * cw[tap * 512 + c2]; }
                if (k == j) xcm = xc; const float xb = rbf(xc); ar += xb * bf2f(wr[k]); ai += xb * bf2f(wi[k]); }
            const float rg = dsig(ar), ig = dsig(ai), la = rg * ls8, av = expf(la), u = sqrtf(-expm1f(2.f * la)) * (ig * xcm); h = av * h + u; pp *= av; }
        dbg_rec(slot, DW(float, WS_HL)[(size_t)row * 512 + ch], h, 0.02f); dbg_rec(slot, DW(float, WS_PP)[(size_t)row * 512 + ch], pp, 0.02f); }
    } else if (q == 2) {
        if (blockIdx.x < 8) {
            const int row = RND(M), head = RND(8), d = RND(64), b = row >> 13, s = row & 8191, c = s >> 6, j0 = c >= 8 ? c - 8 : 0;
            const bf16* aqk = DW(bf16, WS_AQK); const bf16* avt = DW(bf16, WS_AVT); const float* rb = (const float*)a.in[4] + (l * 8 + head) * 320;
            float mx = -1e30f;
            for (int pass = 0; pass < 2; ++pass) { float den = 0.f, num = 0.f;
                for (int kp = j0 * 64; kp < (c + 1) * 64; ++kp) { float sc = 0.f; for (int k = 0; k < 64; ++k) sc += dbf(aqk, (size_t)row * 1024 + head * 64 + k) * dbf(aqk, ((size_t)b * SEQ + kp) * 1024 + 512 + head * 64 + k);
                    int dist = s - kp; dist = dist < -63 ? -63 : (dist > 256 ? 256 : dist); sc = sc / LOG2E + rb[dist + 63];
                    if (pass == 0) mx = fmaxf(mx, sc); else { const float e = expf(sc - mx); den += e; num += e * dbf(avt, (size_t)(head * 64 + d) * M + (size_t)b * SEQ + kp); } }
                if (pass == 1) dbg_rec(slot, dbf(DW(bf16, WS_YA), (size_t)row * 512 + head * 64 + d), num / den, 0.03f); }
        } else if (blockIdx.x < 24) {
            const int row = RND(M - 1) + 1, ch = RND(512), b = row >> 13, s = row & 8191, g = ch >> 6, j = ch & 63;
            if (s > 0) { const bf16* bxg = DW(bf16, WS_BXG); const float gp = dgelu(dbf(bxg, (size_t)(row - 1) * 1024 + 512 + ch)), gc = dgelu(dbf(bxg, (size_t)row * 1024 + 512 + ch));
              if (fabsf(gp) > 0.2f) { const float* cw = (const float*)a.in[5] + l * 2048; const float* cb = (const float*)a.in[6] + l * 512;
                const bf16* wr = DW(bf16, WS_LRUW) + (size_t)(((l * 2 + 0) * 8 + g) * 64 + j) * 64; const bf16* wi = DW(bf16, WS_LRUW) + (size_t)(((l * 2 + 1) * 8 + g) * 64 + j) * 64;
                const float lm = ((const float*)a.in[11])[l * 512 + ch], ls8 = -8.0f * log1pf(expf(-lm));
                float ar = ((const float*)a.in[8])[(l * 8 + g) * 64 + j], ai = ((const float*)a.in[10])[(l * 8 + g) * 64 + j], xcm = 0.f;
                for (int k = 0; k < 64; ++k) { const int c2 = g * 64 + k; float xc = cb[c2];
                    for (int tap = 0; tap < 4; ++tap) { const int tt = s - 3 + tap; if (tt >= 0) xc += dbf(bxg, ((size_t)b * SEQ + tt) * 1024 + c2) * cw[tap * 512 + c2]; }
                    if (k == j) xcm = xc; const float xb = rbf(xc); ar += xb * bf2f(wr[k]); ai += xb * bf2f(wi[k]); }
                const float la = dsig(ar) * ls8, av = expf(la), u = sqrtf(-expm1f(2.f * la)) * (dsig(ai) * xcm);
                const float hp = dbf(DW(bf16, WS_YB), (size_t)(row - 1) * 512 + ch) / gp;
                dbg_rec(slot, dbf(DW(bf16, WS_YB), (size_t)row * 512 + ch), (av * hp + u) * gc, 0.05f); } }
        } else if (blockIdx.x < 32) {
            const int row = RND(M), vj = RND(16), d = RND(64), b = row >> 13, s = row & 8191, kend = ((s >> 6) + 1) * 64;
            const int qcol = (vj >> 1) * 64, kcol = 512 + (vj >> 1) * 64, vcol = ((vj >> 2) * 2 + (vj & 1)) * 64;
            const bf16* cqk = DW(bf16, WS_CQK); const bf16* cv = DW(bf16, WS_CV);
            float mx = -1e30f;
            for (int pass = 0; pass < 2; ++pass) { float den = 0.f, num = 0.f;
                for (int kp = 0; kp < kend; ++kp) { float sc = 0.f; for (int k = 0; k < 64; ++k) sc += dbf(cqk, (size_t)row * 1024 + qcol + k) * dbf(cqk, ((size_t)b * SEQ + kp) * 1024 + kcol + k);
                    sc = sc / LOG2E;
                    if (pass == 0) mx = fmaxf(mx, sc); else { const float e = expf(sc - mx); den += e; num += e * dbf(cv, ((size_t)b * SEQ + kp) * 512 + vcol + d); } }
                if (pass == 1) dbg_rec(slot, dbf(DW(bf16, WS_CO), (size_t)row * 1024 + vj * 64 + d), num / den, 0.01f); }
        }
    } else if (q == 3) {
        const int row = RND(M), h = RND(4), e = RND(128); const bf16* co = DW(bf16, WS_CO) + (size_t)row * 1024; const float lamv = DW(float, WS_MISC)[l], oml = DW(float, WS_MISC)[2 + l];
        float ss = 0.f, oe = 0.f;
        for (int i = 0; i < 128; ++i) { const int vh = i >> 6, dd = i & 63; const float o = bf2f(co[(h * 4 + vh) * 64 + dd]) - lamv * bf2f(co[(h * 4 + 2 + vh) * 64 + dd]); ss += o * o; if (i == e) oe = o; }
        dbg_rec(slot, dbf(DW(bf16, WS_YC), (size_t)row * 512 + h * 128 + e), oe / sqrtf(ss / 128.f + LN_EPS) * ((const float*)a.in[13])[l * 128 + e] * oml, 0.02f);
        if (sid == 0) { const float* dl = (const float*)a.in[12] + l * 256; float s1 = 0.f, s2 = 0.f; for (int i = 0; i < 64; ++i) { s1 += dl[i] * dl[64 + i]; s2 += dl[128 + i] * dl[192 + i]; }
            const float li = 0.8f - 0.6f * expf(-0.3f * l); dbg_rec(slot, lamv, expf(s1) - expf(s2) + li, 1e-3f); dbg_rec(slot, oml, 1.f - li, 1e-3f); }
    } else if (q == 4) {
        const int row = RND(M), col = RND(1024); float tot = 0.f;
        for (int n = 0; n < 3; ++n) { const bf16* y = DW(bf16, n == 0 ? WS_YA : (n == 1 ? WS_YB : WS_YC)) + (size_t)row * 512; const bf16* w = DW(bf16, WS_WBR) + ((size_t)(l * 3 + n) * 1024 + col) * 512; float acc = 0.f;
            for (int k = 0; k < 512; ++k) acc += bf2f(y[k]) * bf2f(w[k]); tot += acc * dbf(DW(bf16, WS_GATES), (size_t)row * 3072 + n * 1024 + col); }
        dbg_rec(slot, dbf(DW(bf16, WS_MERGED), (size_t)row * 1024 + col), tot, 0.02f);
    } else if (q == 5) {
        const int row = RND(M), col = RND(1024); const bf16* mg = DW(bf16, WS_MERGED) + (size_t)row * 1024; const bf16* w = DW(bf16, WS_WOUT) + ((size_t)l * 1024 + col) * 1024; float acc = 0.f;
        for (int k = 0; k < 1024; ++k) acc += bf2f(mg[k]) * bf2f(w[k]);
        const float res = (l == 0 ? (const float*)a.in[0] : (const float*)a.out)[(size_t)row * 1024 + col];
        dbg_rec(slot, DW(float, WS_YF)[(size_t)row * 1024 + col], ALPHA * res + acc, 0.05f);
    } else if (q == 6) {
        const int row = RND(M), col = RND(1024); const float* y = DW(float, WS_YF) + (size_t)row * 1024; float mu = 0.f, var = 0.f;
        for (int k = 0; k < 1024; ++k) mu += y[k]; mu /= 1024.f; for (int k = 0; k < 1024; ++k) var += (y[k] - mu) * (y[k] - mu); var /= 1024.f;
        const float want = (y[col] - mu) / sqrtf(var + LN_EPS) * ((const float*)a.in[16])[l * 1024 + col] + ((const float*)a.in[17])[l * 1024 + col];
        dbg_rec(slot, a.out[(size_t)row * 1024 + col], want, 0.02f); dbg_rec(slot, dbf(DW(bf16, WS_HB), (size_t)row * 1024 + col), want, 0.05f);
    } else if (q == 7) {
        const int row = RND(M), col = RND(2048); const bf16* hb = DW(bf16, WS_HB) + (size_t)row * 1024; const bf16* w = DW(bf16, WS_WQ) + ((size_t)l * 2048 + col) * 1024; float acc = 0.f;
        for (int k = 0; k < 1024; ++k) acc += bf2f(hb[k]) * bf2f(w[k]);
        dbg_rec(slot, dbf(DW(bf16, WS_PQ), (size_t)row * 2048 + col), acc, 0.05f);
    } else if (q == 8) {
        unsigned rr = dh(blockIdx.x * 2654435761u + 977u * p + 5u); const int row = rr % M, hh = (rr >> 20) & 7;
        const bf16* pq = DW(bf16, WS_PQ) + (size_t)row * 2048 + hh * 256; const bf16* sk = DW(bf16, WS_SUBK) + (size_t)(l * 16 + hh * 2) * 128 * 128;
        { const int pp = tid >> 7, n = tid & 127; float acc = 0.f; for (int k = 0; k < 128; ++k) acc += bf2f(pq[pp * 128 + k]) * bf2f(sk[((size_t)pp * 128 + n) * 128 + k]); sh[tid] = acc; }
        __syncthreads();
        const int* ei = DW(int, WS_EIDX) + ((size_t)row * 8 + hh) * 16; const float* eg = DW(float, WS_EG) + ((size_t)row * 8 + hh) * 16;
        float fmin = 1e30f, fmax = -1e30f, gs = 0.f; for (int k = 0; k < 16; ++k) { const int e = ei[k]; const float f = sh[(e >> 7) & 127] + sh[128 + (e & 127)]; fmin = fminf(fmin, f); fmax = fmaxf(fmax, f); gs += eg[k]; }
        int cnt = 0; for (int i = tid; i < 16384; i += 256) cnt += (sh[i >> 7] + sh[128 + (i & 127)] > fmin + 2e-3f) ? 1 : 0;
        sh[512 + tid] = (float)cnt; __syncthreads();
        if (tid == 0) { float tot = 0.f; for (int i = 0; i < 256; ++i) tot += sh[512 + i]; dbg_rec(slot, tot > 15.5f ? 1.f : 0.f, 0.f, 1.f);
            dbg_rec(slot, gs, 1.f, 0.f); float den = 0.f; for (int k = 0; k < 16; ++k) { const int e = ei[k]; den += expf(sh[(e >> 7) & 127] + sh[128 + (e & 127)] - fmax); }
            for (int k = 0; k < 16; ++k) { const int e = ei[k]; dbg_rec(slot, eg[k], expf(sh[(e >> 7) & 127] + sh[128 + (e & 127)] - fmax) / den, 0.01f); }
            for (int k = 0; k < 16; ++k) for (int k2 = 0; k2 < k; ++k2) if (ei[k] == ei[k2]) dbg_rec(slot, 1.f, 0.f, 1.f); }
    } else if (q == 9) {
        unsigned rr = dh(blockIdx.x * 2654435761u + 31u * p + 9u); const int row = rr % M;
        const float* h1 = DW(float, WS_DBGH1) + (size_t)row * 1024; const int* ei = DW(int, WS_EIDX) + (size_t)row * 128; const float* eg = DW(float, WS_EG) + (size_t)row * 128;
        float y[4] = {0.f, 0.f, 0.f, 0.f};
        for (int e = 0; e < 128; ++e) { const size_t ex = (size_t)ei[e]; float part = 0.f; for (int k = tid; k < 1024; k += 256) part += rbf(h1[k]) * dbf(DW(bf16, WS_U), ex * 1024 + k);
            sh[tid] = part; __syncthreads(); if (tid < 64) { float s2 = sh[tid] + sh[tid + 64] + sh[tid + 128] + sh[tid + 192]; s2 = wave_sum(s2); if (tid == 0) sh[1024] = s2; } __syncthreads();
            const float w = eg[e] * dgelu(sh[1024]); for (int i = 0; i < 4; ++i) y[i] += w * dbf(DW(bf16, WS_V), ex * 1024 + tid + 256 * i); __syncthreads(); }
        float ps = 0.f; for (int i = 0; i < 4; ++i) { y[i] += ALPHA * h1[tid + 256 * i]; ps += y[i]; }
        sh[tid] = ps; __syncthreads(); if (tid == 0) { float t2 = 0.f; for (int i = 0; i < 256; ++i) t2 += sh[i]; sh[1025] = t2 / 1024.f; } __syncthreads(); const float mu = sh[1025];
        ps = 0.f; for (int i = 0; i < 4; ++i) ps += (y[i] - mu) * (y[i] - mu);
        __syncthreads(); sh[tid] = ps; __syncthreads(); if (tid == 0) { float t2 = 0.f; for (int i = 0; i < 256; ++i) t2 += sh[i]; sh[1026] = 1.f / sqrtf(t2 / 1024.f + LN_EPS); } __syncthreads();
        for (int i = 0; i < 4; ++i) { const int col = tid + 256 * i; dbg_rec(slot, a.out[(size_t)row * 1024 + col], (y[i] - mu) * sh[1026] * ((const float*)a.in[22])[l * 1024 + col] + ((const float*)a.in[23])[l * 1024 + col], 0.03f); }
    }
#undef RND
}
__global__ void dbg_scan(DArgs a) { const size_t i = (size_t)blockIdx.x * 256 + threadIdx.x; unsigned bad = 0; for (size_t j = i; j < (size_t)M * D; j += (size_t)gridDim.x * 256) { const float v = a.out[j]; if (!(v == v) || fabsf(v) > 1e30f) bad = 1; } if (bad) atomicMax(DW(unsigned, WS_MISC) + 15, 1u); }
__global__ void dbg_encode(DArgs a, float tol) {
    const unsigned* w = DW(unsigned, WS_MISC) + 16; int k = 0;
    for (int p = 0; p < 21; ++p) if (__uint_as_float(w[p]) > tol) { k = p + 1; break; }
    if (k == 2) { for (int s2 = 0; s2 < 8; ++s2) if (__uint_as_float(w[24 + s2]) > tol) { k = 50 + s2; break; } }
    if (k == 57) { int nf = 0, first = -1; for (int s3 = 0; s3 < 12; ++s3) if (__uint_as_float(w[32 + s3]) > tol) { ++nf; if (first < 0) first = s3; } k = 60 + first + 13 * (nf > 1 ? 1 : 0) + 13 * (nf == 12 ? 1 : 0); }
    if (k == 0 && DW(unsigned, WS_MISC)[15]) k = 40;
    if (k == 0) return;
    const float c = sqrtf((float)k);
    for (size_t j = (size_t)blockIdx.x * 256 + threadIdx.x; j < (size_t)M * D; j += (size_t)gridDim.x * 256) a.out[j] = c;
}
static void dbg_check(int p, const void* const* in, float* out, unsigned char* ws, const float* invf, hipStream_t stream) {
    DArgs d{}; for (int i = 0; i < 24; ++i) d.in[i] = in[i]; d.out = out; d.ws = ws; for (int i = 0; i < 32; ++i) d.invf[i] = invf[i]; d.p = p;
    hipLaunchKernelGGL(dbg_kernel, dim3(64), dim3(256), 0, stream, d);
}
static void dbg_final(const void* const* in, float* out, unsigned char* ws, hipStream_t stream) {
    DArgs d{}; for (int i = 0; i < 24; ++i) d.in[i] = in[i]; d.out = out; d.ws = ws; d.p = 0;
    hipLaunchKernelGGL(dbg_scan, dim3(1024), dim3(256), 0, stream, d);
    hipLaunchKernelGGL(dbg_encode, dim3(1024), dim3(256), 0, stream, d, 0.08f);
}
#endif
struct Args { const void* in[24]; float* out; unsigned char* ws; float invf[32]; int ph_lo, ph_hi, dbg, pad; };
constexpr int NPH = 1 + DEPTH * 10;

__global__ void __launch_bounds__(NWAVES * 64, 2) mk_fwd(Args args) {
    extern __shared__ __attribute__((aligned(16))) unsigned char lds[];
    LAS unsigned char* L = (LAS unsigned char*)lds;
    volatile LAS unsigned* MISC = (volatile LAS unsigned*)(L + MISC_OFF);
#define PH_IDS int tid = threadIdx.x; asm volatile("" : "+v"(tid)); const int lane = tid & 63, wave = __builtin_amdgcn_readfirstlane(tid >> 6); (void)lane; (void)wave;
    const int G = gridDim.x, bx = blockIdx.x, vcu = (G % 8 == 0) ? (bx % 8) * (G / 8) + bx / 8 : bx;
    gu32* ctl = (gu32*)(args.ws + WS_CTL);
    for (int u = threadIdx.x; u < (LDS_BYTES - LDSCTL_OFF) / 4; u += NWAVES * 64) ((LAS unsigned*)(L + LDSCTL_OFF))[u] = 0u;
    __syncthreads();
    XcdBarrier bar = xcd_barrier_post((unsigned*)(ctl + CW_BAR), MISC + 8);
    const int lo = args.ph_lo, hi = args.ph_hi;
#ifndef MK_ONLYQ
#define MK_ONLYQ -1
#endif
#define IN(k) (lo <= (k) && (k) < hi)
#define INQ(q) ((MK_ONLYQ < 0 || MK_ONLYQ == (q)) && IN(pb + (q)))
#define SEAM(k) do { if (IN(k) && IN((k) + 1)) xcd_barrier(bar); } while (0)
#define GT ((size_t)vcu * 512 + tid)
#define NGT ((size_t)G * 512)
#define GW (vcu * NWAVES + wave)
#define NGW (G * NWAVES)
#define WSP(T, off) ((T*)(args.ws + (off)))
#define x_in ((const float*)args.in[0])
#define WIN WSP(bf16, WS_WIN)
#define WBR WSP(bf16, WS_WBR)
#define WOUT WSP(bf16, WS_WOUT)
#define WQ WSP(bf16, WS_WQ)
#define SUBK WSP(bf16, WS_SUBK)
#define ROPEC WSP(float, WS_ROPEC)
#define ROPES WSP(float, WS_ROPES)
#define LRUW WSP(bf16, WS_LRUW)
#define MISCW WSP(float, WS_MISC)
#define UB WSP(bf16, WS_U)
#define VB WSP(bf16, WS_V)
#define HB WSP(bf16, WS_HB)
#define HL WSP(float, WS_HL)
#define PP WSP(float, WS_PP)
#define AQK WSP(bf16, WS_AQK)
#define AVT WSP(bf16, WS_AVT)
#define CQK WSP(bf16, WS_CQK)
#define CV WSP(bf16, WS_CV)
#define BXG WSP(bf16, WS_BXG)
#define GATES WSP(bf16, WS_GATES)
#define YA WSP(bf16, WS_YA)
#define YB WSP(bf16, WS_YB)
#define YC WSP(bf16, WS_YC)
#define CO WSP(bf16, WS_CO)
#define MERGEF WSP(float, WS_MERGEF)
#define MERGED WSP(bf16, WS_MERGED)
#define YF WSP(float, WS_YF)
#define PQ WSP(bf16, WS_PQ)
#define EIDX WSP(int, WS_EIDX)
#define EG WSP(float, WS_EG)
#define HF (args.out)
#define DBGH1 (args.dbg ? WSP(float, WS_DBGH1) : (float*)nullptr)

    if ((MK_ONLYQ < 0 || MK_ONLYQ == 100) && IN(0)) { PH_IDS
        LAS float* scr = (LAS float*)(L + RING_OFF + wave * 16384);
        constexpr int I_IN = 16 * 224, I_BR = 8 * 32, I_OUT = 16 * 32, I_Q = 16 * 64;
        constexpr int NITEMS = 2 * I_IN + 6 * I_BR + 2 * I_OUT + 2 * I_Q;
        for (int it = GW; it < NITEMS; it += NGW) {
            int r = it;
            if (r < 2 * I_IN) { const int l = r / I_IN; p0_transpose_item((const float*)args.in[2] + (size_t)l * 1024 * INC, 1024, INC, WIN + (size_t)l * INC * 1024, 2560, 3584, scr, r % I_IN, lane); continue; } r -= 2 * I_IN;
            if (r < 6 * I_BR) { const int q = r / I_BR; p0_transpose_item((const float*)args.in[14] + (size_t)q * 512 * 1024, 512, 1024, WBR + (size_t)q * 1024 * 512, 0, 0, scr, r % I_BR, lane); continue; } r -= 6 * I_BR;
            if (r < 2 * I_OUT) { const int l = r / I_OUT; p0_transpose_item((const float*)args.in[15] + (size_t)l * 1024 * 1024, 1024, 1024, WOUT + (size_t)l * 1024 * 1024, 0, 0, scr, r % I_OUT, lane); continue; } r -= 2 * I_OUT;
            { const int l = r / I_Q; p0_transpose_item((const float*)args.in[18] + (size_t)l * 1024 * 2048, 1024, 2048, WQ + (size_t)l * 2048 * 1024, 0, 0, scr, r % I_Q, lane); }
        }
        cvt_stream((const float*)args.in[19], SUBK, (size_t)2 * 8 * 2 * 128 * 128 / 8, GT, NGT);
        cvt_stream(x_in, HB, (size_t)M * D / 8, GT, NGT);
        cvt_stream((const float*)args.in[20], UB, (size_t)16384 * 1024 / 8, GT, NGT);
        cvt_stream((const float*)args.in[21], VB, (size_t)16384 * 1024 / 8, GT, NGT);
        for (size_t i = GT; i < (size_t)2 * 2 * 8 * 4096; i += NGT) { const int k = i & 63, j = (i >> 6) & 63, g = (i >> 12) & 7, gate = (i >> 15) & 1, l = (int)(i >> 16);
            const float* w = (const float*)args.in[gate ? 9 : 7]; LRUW[i] = (bf16)f2bf(w[((size_t)(l * 8 + g) * 64 + k) * 64 + j]); }
        for (size_t i = GT; i < (size_t)M * 32; i += NGT) { const int row = (int)(i >> 5), fi = (int)(i & 31);
            const float ang = (float)((const int*)args.in[1])[row] * args.invf[fi];
            const double rev = (double)ang * 0.15915494309189535; const float fr = (float)(rev - __builtin_rint(rev));
            ROPEC[i] = __builtin_amdgcn_cosf(fr); ROPES[i] = __builtin_amdgcn_sinf(fr); }
        if (bx == 0 && tid < 2) { const float* dl = (const float*)args.in[12] + tid * 256; float s1 = 0.f, s2 = 0.f;
            for (int i = 0; i < 64; ++i) { s1 += dl[i] * dl[64 + i]; s2 += dl[128 + i] * dl[192 + i]; }
            const float li = tid == 0 ? 0.2f : 0.35550906759096926f;
            MISCW[tid] = expf(s1) - expf(s2) + li; MISCW[2 + tid] = 1.0f - li; }
    }
    SEAM(0);
    for (int l = 0; l < DEPTH; ++l) {
        const int pb = 1 + 10 * l;
        if (INQ(0)) { PH_IDS
            { pg8::Gemm g{HB, WIN + (size_t)l * INC * 1024, M, INC, 1024}; pg8::InOrder S; S.init(G, bx);
              pg8::EpiIn E{AQK, BXG, CQK, CV, GATES, (const float*)args.in[3] + l * 3072, ROPEC, ROPES};
              pg8::gemm_phase<pg8::EpiIn, pg8::InOrder, PG8_ALIGN, PG8_SP2>(L + RING_OFF, g, S, E); }
            { pg8::Gemm g{WIN + (size_t)l * INC * 1024 + (size_t)1024 * 1024, HB, 512, M, 1024}; pg8::StaticOrder S; S.init(512, M, G, bx);
              pg8::EpiBf16<0> E{AVT, M, nullptr, 0, 0, 1.f};
              pg8::gemm_phase<pg8::EpiBf16<0>, pg8::StaticOrder, PG8_ALIGN, PG8_SP2>(L + RING_OFF, g, S, E); }
        }
        SEAM(pb + 0);
        if (INQ(1)) { PH_IDS
            for (int u = vcu; u < 1024; u += G)
                b1_unit(l, u, L, BXG, LRUW, (const float*)args.in[5], (const float*)args.in[6], (const float*)args.in[8], (const float*)args.in[10], (const float*)args.in[11], HL, PP, tid, wave, lane);
            if (l > 0) { cvt_stream((const float*)args.in[20] + (size_t)l * 16384 * 1024, UB, (size_t)16384 * 1024 / 8, GT, NGT);
                         cvt_stream((const float*)args.in[21] + (size_t)l * 16384 * 1024, VB, (size_t)16384 * 1024 / 8, GT, NGT); }
        }
        SEAM(pb + 1);
        if (INQ(2)) { PH_IDS
            for (int u = vcu; u < 256; u += G) band_unit(u, AQK, AVT, (const float*)args.in[4] + l * 8 * 320, YA, wave, lane);
            for (int u = vcu; u < 256; u += G) b3_unit(u, HL, PP, BXG, YB, tid);
            __syncthreads();
            const attn_body::AttnTensors AT{(const attn_body::bf16*)CQK, (const attn_body::bf16*)CQK, (const attn_body::bf16*)CV, (attn_body::bf16*)CO};
            const attn_body::StaticOrder S(G, bx);
            attn_body::attn_phase<attn_body::StaticOrder>((char*)lds + RING_OFF, AT, S);
        }
        SEAM(pb + 2);
        if (INQ(3)) { PH_IDS
            const float lamv = MISCW[l], oml = MISCW[2 + l];
            for (int m = GW; m < M; m += NGW) comb_row((size_t)m, CO, (const float*)args.in[13] + l * 128, lamv, oml, YC, lane);
        }
        SEAM(pb + 3);
        if (INQ(4)) { PH_IDS
            const bf16* wbr = WBR + (size_t)l * 3 * 1024 * 512;
            { pg8::Gemm g{YA, wbr, M, 1024, 512}; pg8::StaticOrder S; S.init(M, 1024, G, bx); pg8::EpiMerge<0> E{GATES, MERGEF, MERGED};
              pg8::gemm_phase<pg8::EpiMerge<0>, pg8::StaticOrder, false, PG8_SP2>(L + RING_OFF, g, S, E); }
            { pg8::Gemm g{YB, wbr + (size_t)1024 * 512, M, 1024, 512}; pg8::StaticOrder S; S.init(M, 1024, G, bx); pg8::EpiMerge<1> E{GATES, MERGEF, MERGED};
              pg8::gemm_phase<pg8::EpiMerge<1>, pg8::StaticOrder, false, PG8_SP2>(L + RING_OFF, g, S, E); }
            { pg8::Gemm g{YC, wbr + (size_t)2 * 1024 * 512, M, 1024, 512}; pg8::StaticOrder S; S.init(M, 1024, G, bx); pg8::EpiMerge<2> E{GATES, MERGEF, MERGED};
              pg8::gemm_phase<pg8::EpiMerge<2>, pg8::StaticOrder, false, PG8_SP2>(L + RING_OFF, g, S, E); }
        }
        SEAM(pb + 4);
        if (INQ(5)) { PH_IDS
            pg8::Gemm g{MERGED, WOUT + (size_t)l * 1024 * 1024, M, 1024, 1024}; pg8::StaticOrder S; S.init(M, 1024, G, bx);
            pg8::EpiOut E{l == 0 ? x_in : HF, YF, ALPHA};
            pg8::gemm_phase<pg8::EpiOut, pg8::StaticOrder, false, PG8_SP2>(L + RING_OFF, g, S, E);
        }
        SEAM(pb + 5);
        if (INQ(6)) { PH_IDS
            for (int m = GW; m < M; m += NGW) ln_row(YF + (size_t)m * D, (const float*)args.in[16] + l * D, (const float*)args.in[17] + l * D, HF + (size_t)m * D, HB + (size_t)m * D, args.dbg ? DBGH1 + (size_t)m * D : (float*)nullptr, lane);
        }
        SEAM(pb + 6);
        if (INQ(7)) { PH_IDS
            pg8::Gemm g{HB, WQ + (size_t)l * 2048 * 1024, M, 2048, 1024}; pg8::StaticOrder S; S.init(M, 2048, G, bx);
            pg8::EpiBf16<0> E{PQ, 2048, nullptr, 0, 0, 1.f};
            pg8::gemm_phase<pg8::EpiBf16<0>, pg8::StaticOrder, PG8_ALIGN, PG8_SP2>(L + RING_OFF, g, S, E);
        }
        SEAM(pb + 7);
        if (INQ(8)) { PH_IDS
            LAS unsigned* wl = (LAS unsigned*)(L + RING_OFF + wave * 8192);
            for (int u = GW; u < 4096; u += NGW) topk_unit(u, PQ, SUBK + (size_t)l * 8 * 2 * 128 * 128, EIDX, EG, wl, lane);
        }
        SEAM(pb + 8);
        if (INQ(9)) { PH_IDS
            for (int m = GW; m < M; m += NGW) peer_row((size_t)m, HF, EIDX, EG, UB, VB, (const float*)args.in[22] + l * D, (const float*)args.in[23] + l * D, HF, HB, lane);
        }
        SEAM(pb + 9);
    }
#undef IN
#undef INQ
#undef SEAM
}

extern "C" void kernel_launch(void* const* d_in, const int* in_sizes, int n_in, void* d_out, int out_size, void* d_ws, size_t ws_size, hipStream_t stream) {
    static int grid = 0;
    if (grid == 0) {
        if (n_in != 24 || out_size != M * D || ws_size < WS_END) { fprintf(stderr, "kernel_launch: unexpected shapes (n_in %d out %d ws %zu)\n", n_in, out_size, ws_size); grid = -1; return; }
        int dev = 0, cus = 0;
        if (hipGetDevice(&dev) != hipSuccess || hipDeviceGetAttribute(&cus, hipDeviceAttributeMultiprocessorCount, dev) != hipSuccess) { grid = -1; return; }
        if (hipFuncSetAttribute((const void*)mk_fwd, hipFuncAttributeMaxDynamicSharedMemorySize, LDS_BYTES) != hipSuccess) { grid = -1; return; }
        (void)hipGetLastError();
        grid = cus;
        if (grid != 256) { fprintf(stderr, "kernel_launch: built for 256 CUs, found %d\n", cus); grid = -1; return; }
    }
    if (grid < 0) return;
    if (hipMemsetAsync((char*)d_ws + WS_CTL, 0, CTL_ZERO_BYTES, stream) != hipSuccess) return;
#if MK_DEBUG
    (void)hipMemsetAsync((char*)d_ws + WS_MISC + 60, 0, 196, stream);
#endif
    Args a{};
    for (int i = 0; i < 24; ++i) a.in[i] = d_in[i];
    a.out = (float*)d_out; a.ws = (unsigned char*)d_ws;
    for (int i = 0; i < 32; ++i) a.invf[i] = (float)pow(10000.0, -(double)(2 * i) / 64.0);
    a.dbg = MK_DEBUG;
#if MK_N_LAUNCHES == 1
    a.ph_lo = 0; a.ph_hi = NPH;
    hipLaunchKernelGGL(mk_fwd, dim3(grid), dim3(NWAVES * 64), LDS_BYTES, stream, a);
#else
    for (int p = 0; p < NPH; ++p) { a.ph_lo = p; a.ph_hi = p + 1;
        hipLaunchKernelGGL(mk_fwd, dim3(grid), dim3(NWAVES * 64), LDS_BYTES, stream, a);
#if MK_DEBUG
        dbg_check(p, a.in, a.out, a.ws, a.invf, stream);
#endif
    }
#if MK_DEBUG
    dbg_final(a.in, a.out, a.ws, stream);
#endif
#endif
}
```

```cpp
#ifndef MK_N_LAUNCHES
#define MK_N_LAUNCHES 1
#endif
#ifndef MK_DEBUG
#define MK_DEBUG 0
#endif
#ifndef MK_STAMP
#define MK_STAMP 0
#endif
#ifndef MK_STAMP_A
#define MK_STAMP_A 0
#endif
#ifndef MK_STAMP_B
#define MK_STAMP_B 0
#endif
#ifndef MK_DUP
#define MK_DUP 0
#endif
#include <hip/hip_runtime.h>
#include <cstdio>
#include <cstdint>
namespace pg8 {
#define PG8_LAS __attribute__((address_space(3)))
typedef unsigned short bf16_t;
typedef short bf16x8 __attribute__((ext_vector_type(8)));
typedef float f32x4 __attribute__((ext_vector_type(4)));
typedef unsigned u32x4 __attribute__((ext_vector_type(4)));
constexpr int BM = 256, BK = 64, HALF = 128, HTB = HALF * BK * 2  , STAGE_BYTES = 8 * HTB, NXCD = 8, WGM = 8;

__host__ __device__ __forceinline__ int lds_byte(int r, int c) { const int st = (r >> 4) * 2 + (c >> 5), rr = r & 15, cc = c & 31, ob = rr * 64 + cc * 2; return st * 1024 + (ob ^ (((ob >> 9) & 1) << 5)); }
__host__ __device__ __forceinline__ void stage_rc(int b, int& R, int& C) { const int st = b / 1024, sb = b % 1024, swz = sb ^ (((sb >> 9) & 1) << 5); R = (st >> 1) * 16 + swz / 64; C = (st & 1) * 32 + (swz % 64) / 2; }
__host__ __device__ __forceinline__ int perm32(int rho) { const int n = rho >> 4, i = rho & 15; return 8 * (i >> 2) + 4 * n + (i & 3); }

struct Unit { int pm, pn; };
struct Gemm { const bf16_t* A; const bf16_t* Bt; int M, N, K; };

struct StaticOrder {
    int nM, nN, nwg, G, c;
    __host__ __device__ void init(int M, int N, int G_, int c_) { nM = M / BM; nN = N / BM; nwg = nM * nN; G = G_; c = c_; }
    __host__ __device__ bool next(int i, Unit& u) const {
        const long L = (long)i * G + c; if (L >= nwg) return false;
        int wgid = (int)L; { const int q = nwg / NXCD, r = nwg % NXCD, xcd = wgid % NXCD, off = wgid / NXCD; wgid = (xcd < r ? xcd * (q + 1) : r * (q + 1) + (xcd - r) * q) + off; }
        const int nig = WGM * nN, gid = wgid / nig, fm = gid * WGM, gsz = (nM - fm) < WGM ? (nM - fm) : WGM;
        u.pm = fm + ((wgid % nig) % gsz); u.pn = (wgid % nig) / gsz; return true;
    }
    __device__ __forceinline__ void a_ready(const Unit&) const {}
    __device__ __forceinline__ void done(const Unit&) const {}
};

typedef float f32x2c __attribute__((ext_vector_type(2))); typedef __bf16 bf16x2c __attribute__((ext_vector_type(2)));
__device__ __forceinline__ unsigned cvt_pk_bf16(float lo, float hi) { f32x2c v = {lo, hi}; bf16x2c b = __builtin_convertvector(v, bf16x2c); return __builtin_bit_cast(unsigned, b); }
typedef float f32x2 __attribute__((ext_vector_type(2)));
__device__ __forceinline__ f32x2 gelu_pk(f32x2 v) {
    const f32x2 av = __builtin_elementwise_abs(v), d = av * 0.2316418882f + 1.0f;
    f32x2 t; t.x = __builtin_amdgcn_rcpf(d.x); t.y = __builtin_amdgcn_rcpf(d.y);
    f32x2 q = t * 0.5307027145f + (-0.7265760135f); q = q * t + 0.7107068705f; q = q * t + (-0.142248368f); q = q * t + 0.127414796f; q = q * t;
    const f32x2 s = (v * v) * (-0.72134752044f);
    f32x2 e; e.x = __builtin_amdgcn_exp2f(s.x); e.y = __builtin_amdgcn_exp2f(s.y);
    const f32x2 m = v * (q * e), r = v - m;
    f32x2 o; o.x = v.x < 0.f ? m.x : r.x; o.y = v.y < 0.f ? m.y : r.y; return o;
}

template <int ACT  > struct EpiBf16 {
    static constexpr bool PERM = true, AFTER_DRAIN = false; static_assert(ACT == 0 || ACT == 1, "EpiBf16: ACT is 0 (none) or 1 (gelu_pk)");
    bf16_t* O; int ldc; const float* bias; int split_cols; size_t split_stride; float scale0;
    __device__ __forceinline__ void operator()(const f32x4 (&acc)[2][2][4][2], const Unit& u, int wr, int wc, int fr, int fq) const {
        const int row0 = u.pm * BM + wr * 64 + fr; int colt = u.pn * BM; bf16_t* base = O;
        float sc = 1.f; if (split_cols) { const int t = colt / split_cols; base += (size_t)t * split_stride; colt -= t * split_cols; if (t == 0) sc = scale0; }
        const int col0 = colt + wc * 32 + 8 * fq, bcol0 = u.pn * BM + wc * 32 + 8 * fq;
        f32x4 bv[2][2];
#pragma unroll
        for (int bj = 0; bj < 2; ++bj)
#pragma unroll
            for (int n = 0; n < 2; ++n) bv[bj][n] = bias ? *(const f32x4*)(bias + bcol0 + bj * HALF + 4 * n) : (f32x4){0.f, 0.f, 0.f, 0.f};
#pragma unroll
        for (int ai = 0; ai < 2; ++ai)
#pragma unroll
            for (int m = 0; m < 4; ++m) { bf16_t* rowp = base + (size_t)(row0 + ai * HALF + m * 16) * ldc + col0;
#pragma unroll
                for (int bj = 0; bj < 2; ++bj) { f32x4 v0 = acc[ai][bj][m][0] + bv[bj][0], v1 = acc[ai][bj][m][1] + bv[bj][1];
                    if (ACT == 1) { f32x2 a = gelu_pk((f32x2){v0[0], v0[1]}), b = gelu_pk((f32x2){v0[2], v0[3]}), c = gelu_pk((f32x2){v1[0], v1[1]}), d = gelu_pk((f32x2){v1[2], v1[3]});
                        v0 = (f32x4){a.x, a.y, b.x, b.y}; v1 = (f32x4){c.x, c.y, d.x, d.y}; }
                    v0 = v0 * sc; v1 = v1 * sc; u32x4 w; w.x = cvt_pk_bf16(v0[0], v0[1]); w.y = cvt_pk_bf16(v0[2], v0[3]); w.z = cvt_pk_bf16(v1[0], v1[1]); w.w = cvt_pk_bf16(v1[2], v1[3]);
                    *(u32x4*)(rowp + bj * HALF) = w; } }
    }
};


template <class Epi, class Sched, bool ALIGN_EPI = false, bool SP2 = false>
__device__ __forceinline__ void gemm_phase(PG8_LAS unsigned char* lds, const Gemm g_in, const Sched& S, const Epi& E) {
    Gemm g = g_in; asm volatile("" : "+s"(g.A), "+s"(g.Bt));
    int tid_ = threadIdx.x; asm volatile("" : "+v"(tid_));
    const int tid = tid_, wid = __builtin_amdgcn_readfirstlane(tid >> 6), lane = tid & 63, wr = wid >> 2, wc = wid & 3, fr = lane & 15, fq = lane >> 4;
    const int K = g.K, nt = K / BK;
    unsigned voffA[2], voffB[2];
#pragma unroll
    for (int i = 0; i < 2; ++i) { int R, C; stage_rc(tid * 16 + i * 8192, R, C); const int Rb = Epi::PERM ? ((R & ~31) + perm32(R & 31)) : R;
        voffA[i] = (unsigned)(R * K + C) * 2u; voffB[i] = (unsigned)(Rb * K + C) * 2u; }
    const size_t kstep = (size_t)(BK * 2);
    const size_t hstep = (size_t)HALF * K * 2;
    const size_t tstep = 2 * hstep;
    const unsigned ldsw = (unsigned)wid * 1024u;
    const int aoff = lds_byte(wr * 64 + fr, fq * 8), boff = lds_byte(wc * 32 + fr, fq * 8);
#define PG8_SA(b, h) (((b) * 2 + (h)) * HTB)
#define PG8_SB(b, h) ((4 + (b) * 2 + (h)) * HTB)
#define PG8_STAGE(bufoff, gbase, voff) do { _Pragma("unroll") for (int _i = 0; _i < 2; ++_i) \
        __builtin_amdgcn_global_load_lds((const unsigned*)((const char*)(gbase) + (voff)[_i]), (PG8_LAS unsigned*)(lds + (bufoff) + ldsw + _i * 8192), 16, 0, 0); } while (0)
#define PG8_LDA(dst, b, h) do { _Pragma("unroll") for (int m = 0; m < 4; ++m) _Pragma("unroll") for (int k = 0; k < 2; ++k) dst[m][k] = *(const PG8_LAS bf16x8*)(lds + PG8_SA(b, h) + aoff + m * 2048 + k * 1024); } while (0)
#define PG8_LDB(dst, b, h) do { _Pragma("unroll") for (int n = 0; n < 2; ++n) _Pragma("unroll") for (int k = 0; k < 2; ++k) dst[n][k] = *(const PG8_LAS bf16x8*)(lds + PG8_SB(b, h) + boff + n * 2048 + k * 1024); } while (0)
#define PG8_MMA(ai, bj, At, Bt) do { __builtin_amdgcn_s_setprio(1); _Pragma("unroll") for (int m = 0; m < 4; ++m) _Pragma("unroll") for (int n = 0; n < 2; ++n) _Pragma("unroll") for (int k = 0; k < 2; ++k) \
        acc[ai][bj][m][n] = __builtin_amdgcn_mfma_f32_16x16x32_bf16(Bt[n][k], At[m][k], acc[ai][bj][m][n], 0, 0, 0); __builtin_amdgcn_s_setprio(0); } while (0)
#define PG8_WAIT_V(n) asm volatile("s_waitcnt vmcnt(" #n ")" ::: "memory")
#define PG8_WAIT_L(n) asm volatile("s_waitcnt lgkmcnt(" #n ")" ::: "memory")
#define PG8_BAR __builtin_amdgcn_s_barrier()
#define PG8_SCHED __builtin_amdgcn_sched_barrier(0)
    Unit cur, nxt; int ui = 0;
    if (!S.next(0, cur)) return;
    f32x4 acc[2][2][4][2];
#pragma unroll
    for (int a = 0; a < 2; ++a)
#pragma unroll
        for (int b = 0; b < 2; ++b)
#pragma unroll
            for (int m = 0; m < 4; ++m)
#pragma unroll
                for (int n = 0; n < 2; ++n) acc[a][b][m][n] = (f32x4){0.f, 0.f, 0.f, 0.f};
    bf16x8 At[4][2], B0[2][2], B1[2][2];
    const char* cA = (const char*)g.A + (size_t)cur.pm * tstep; const char* cB = (const char*)g.Bt + (size_t)cur.pn * tstep;
    S.a_ready(cur);
    if constexpr (SP2) {
        PG8_STAGE(PG8_SB(0, 0), cB, voffB); PG8_STAGE(PG8_SB(0, 1), cB + hstep, voffB); PG8_STAGE(PG8_SA(0, 0), cA, voffA); PG8_STAGE(PG8_SA(0, 1), cA + hstep, voffA);
        if (wr == 1) PG8_BAR;
        PG8_WAIT_V(2); PG8_BAR;
        PG8_STAGE(PG8_SB(1, 0), cB + kstep, voffB); PG8_STAGE(PG8_SA(1, 0), cA + kstep, voffA); PG8_STAGE(PG8_SB(1, 1), cB + hstep + kstep, voffB);
        PG8_WAIT_V(6); PG8_BAR;
    } else {
        PG8_STAGE(PG8_SB(0, 0), cB, voffB); PG8_STAGE(PG8_SA(0, 0), cA, voffA); PG8_STAGE(PG8_SB(0, 1), cB + hstep, voffB); PG8_STAGE(PG8_SA(0, 1), cA + hstep, voffA);
        if (wr == 1) PG8_BAR;
        PG8_WAIT_V(4); PG8_BAR;
        PG8_STAGE(PG8_SB(1, 0), cB + kstep, voffB); PG8_STAGE(PG8_SA(1, 0), cA + kstep, voffA); PG8_STAGE(PG8_SB(1, 1), cB + hstep + kstep, voffB);
        PG8_WAIT_V(6); PG8_BAR;
    }
    for (;;) {
        const bool has_next = S.next(ui + 1, nxt);
        const char* nA = has_next ? (const char*)g.A + (size_t)nxt.pm * tstep : cA; const char* nB = has_next ? (const char*)g.Bt + (size_t)nxt.pn * tstep : cB;
        for (int t = 0; t < nt; t += 2) {
            const bool last = (t == nt - 2);
            const char* a1 = cA + (size_t)(t + 1) * kstep;
            const char* a2 = last ? nA : cA + (size_t)(t + 2) * kstep; const char* b2 = last ? nB : cB + (size_t)(t + 2) * kstep;
            const char* a3 = a2 + kstep; const char* b3 = b2 + kstep;
            if (last && has_next) S.a_ready(nxt);
            if constexpr (SP2) {
            PG8_LDB(B0, 0, 0); PG8_LDB(B1, 0, 1); PG8_SCHED; PG8_LDA(At, 0, 0); PG8_STAGE(PG8_SA(1, 1), a1 + hstep, voffA);
            PG8_WAIT_V(8); PG8_WAIT_L(0); PG8_BAR; PG8_MMA(0, 0, At, B0); PG8_MMA(0, 1, At, B1); PG8_BAR; PG8_SCHED;
            PG8_LDA(At, 0, 1); PG8_STAGE(PG8_SB(0, 0), b2, voffB); PG8_STAGE(PG8_SB(0, 1), b2 + hstep, voffB); PG8_STAGE(PG8_SA(0, 0), a2, voffA);
            PG8_WAIT_V(8); PG8_WAIT_L(0); PG8_BAR; PG8_MMA(1, 0, At, B0); PG8_MMA(1, 1, At, B1); PG8_BAR; PG8_SCHED;
            PG8_LDB(B0, 1, 0); PG8_LDB(B1, 1, 1); PG8_SCHED; PG8_LDA(At, 1, 0); PG8_STAGE(PG8_SA(0, 1), a2 + hstep, voffA);
            PG8_WAIT_V(8); PG8_WAIT_L(0); PG8_BAR; PG8_MMA(0, 0, At, B0); PG8_MMA(0, 1, At, B1); PG8_BAR; PG8_SCHED;
            PG8_LDA(At, 1, 1); PG8_STAGE(PG8_SB(1, 0), b3, voffB); PG8_STAGE(PG8_SB(1, 1), b3 + hstep, voffB); PG8_STAGE(PG8_SA(1, 0), a3, voffA);
            PG8_WAIT_V(8); PG8_WAIT_L(0); PG8_BAR; PG8_MMA(1, 0, At, B0); PG8_MMA(1, 1, At, B1); PG8_BAR; PG8_SCHED;
            } else {
            PG8_LDB(B0, 0, 0); PG8_SCHED; PG8_LDA(At, 0, 0); PG8_STAGE(PG8_SA(1, 1), a1 + hstep, voffA);
            PG8_WAIT_L(8); PG8_BAR; PG8_WAIT_L(0); PG8_MMA(0, 0, At, B0); PG8_BAR; PG8_SCHED;
            PG8_LDB(B1, 0, 1); PG8_STAGE(PG8_SB(0, 0), b2, voffB);
            PG8_BAR; PG8_WAIT_L(0); PG8_MMA(0, 1, At, B1); PG8_BAR;
            PG8_LDA(At, 0, 1); PG8_STAGE(PG8_SA(0, 0), a2, voffA);
            PG8_BAR; PG8_WAIT_L(0); PG8_MMA(1, 0, At, B0); PG8_BAR; PG8_SCHED;
            PG8_STAGE(PG8_SB(0, 1), b2 + hstep, voffB);
            PG8_WAIT_V(6); PG8_BAR; PG8_MMA(1, 1, At, B1); PG8_BAR;
            PG8_LDB(B0, 1, 0); PG8_SCHED; PG8_LDA(At, 1, 0); PG8_STAGE(PG8_SA(0, 1), a2 + hstep, voffA);
            PG8_WAIT_L(8); PG8_BAR; PG8_WAIT_L(0); PG8_MMA(0, 0, At, B0); PG8_BAR; PG8_SCHED;
            PG8_LDB(B1, 1, 1); PG8_STAGE(PG8_SB(1, 0), b3, voffB);
            PG8_BAR; PG8_WAIT_L(0); PG8_MMA(0, 1, At, B1); PG8_BAR;
            PG8_LDA(At, 1, 1); PG8_STAGE(PG8_SA(1, 0), a3, voffA);
            PG8_BAR; PG8_WAIT_L(0); PG8_MMA(1, 0, At, B0); PG8_BAR; PG8_SCHED;
            PG8_STAGE(PG8_SB(1, 1), b3 + hstep, voffB);
            PG8_WAIT_V(6); PG8_BAR; PG8_MMA(1, 1, At, B1); PG8_BAR;
            }
        }
        if constexpr (ALIGN_EPI) { if (wr == 0) PG8_BAR; }
        if constexpr (!Epi::AFTER_DRAIN) { E(acc, cur, wr, wc, fr, fq); S.done(cur); }
        if (!has_next) break;
#pragma unroll
        for (int a = 0; a < 2; ++a)
#pragma unroll
            for (int b = 0; b < 2; ++b)
#pragma unroll
                for (int m = 0; m < 4; ++m)
#pragma unroll
                    for (int n = 0; n < 2; ++n) acc[a][b][m][n] = (f32x4){0.f, 0.f, 0.f, 0.f};
        cur = nxt; cA = nA; cB = nB; ++ui;
        if constexpr (ALIGN_EPI) { if (wr == 1) PG8_BAR; }
    }
    PG8_WAIT_V(0);
    if constexpr (!ALIGN_EPI) { if (wr == 0) PG8_BAR; }
    PG8_BAR;
    if constexpr (Epi::AFTER_DRAIN) { E.fused(acc, cur, wr, wc, fr, fq, lds, wid, lane); S.done(cur); }
#undef PG8_SA
#undef PG8_SB
#undef PG8_STAGE
#undef PG8_LDA
#undef PG8_LDB
#undef PG8_MMA
#undef PG8_WAIT_V
#undef PG8_WAIT_L
#undef PG8_BAR
#undef PG8_SCHED
}
}

#ifndef PG8_SP2
#define PG8_SP2 true
#endif
#ifndef PG8_ALIGN
#define PG8_ALIGN true
#endif
namespace pg8 {
constexpr float C2S = 0.125f * 1.4426950408889634f;
__device__ __forceinline__ float sigm(float x) { return __builtin_amdgcn_rcpf(1.0f + __builtin_amdgcn_exp2f(-1.4426950408889634f * x)); }
__device__ __forceinline__ void st8(bf16_t* p, f32x4 v0, f32x4 v1) { u32x4 w; w.x = cvt_pk_bf16(v0[0], v0[1]); w.y = cvt_pk_bf16(v0[2], v0[3]); w.z = cvt_pk_bf16(v1[0], v1[1]); w.w = cvt_pk_bf16(v1[2], v1[3]); *(u32x4*)p = w; }

struct EpiIn {
    static constexpr bool PERM = true, AFTER_DRAIN = false;
    bf16_t *AQK, *BXG, *CQK, *CV, *GATES; const float* gbias; const float* rc; const float* rs;
    __device__ __forceinline__ void operator()(const f32x4 (&acc)[2][2][4][2], const Unit& u, int wr, int wc, int fr, int fq) const {
        const int pn = u.pn;
        bf16_t* base; int ldc, colt, mode;
        if (pn < 2)       { base = AQK; ldc = 1024; colt = pn * 256; mode = 1; }
        else if (pn < 4)  { base = AQK; ldc = 1024; colt = 512 + (pn - 2) * 256; mode = 0; }
        else if (pn < 10) { base = BXG; ldc = 1024; colt = (pn - 6) * 256; mode = 0; }
        else if (pn < 12) { base = CQK; ldc = 1024; colt = (pn - 10) * 256; mode = 3; }
        else if (pn < 14) { base = CQK; ldc = 1024; colt = 512 + (pn - 12) * 256; mode = 2; }
        else if (pn < 16) { base = CV; ldc = 512; colt = (pn - 14) * 256; mode = 0; }
        else              { base = GATES; ldc = 3072; colt = (pn - 16) * 256; mode = 4; }
        const int row0 = u.pm * BM + wr * 64 + fr, cl = wc * 32 + 8 * fq;
        const float sc = (mode & 1) ? C2S : 1.f;
        if (mode == 4) {
            f32x4 bv[2][2];
#pragma unroll
            for (int bj = 0; bj < 2; ++bj)
#pragma unroll
                for (int n = 0; n < 2; ++n) bv[bj][n] = *(const f32x4*)(gbias + colt + bj * HALF + cl + 4 * n);
#pragma unroll
            for (int ai = 0; ai < 2; ++ai)
#pragma unroll
                for (int m = 0; m < 4; ++m) { bf16_t* rowp = base + (size_t)(row0 + ai * HALF + m * 16) * ldc + colt + cl;
#pragma unroll
                    for (int bj = 0; bj < 2; ++bj) { f32x4 v0 = acc[ai][bj][m][0] + bv[bj][0], v1 = acc[ai][bj][m][1] + bv[bj][1];
#pragma unroll
                        for (int e = 0; e < 4; ++e) { v0[e] = sigm(v0[e]); v1[e] = sigm(v1[e]); }
                        st8(rowp + bj * HALF, v0, v1); }
                    asm volatile("" ::: "memory"); }
        } else if (mode >= 2) {
            const int i0 = (wc & 1) * 16 + 4 * fq;
#pragma unroll
            for (int ai = 0; ai < 2; ++ai)
#pragma unroll
                for (int m = 0; m < 4; ++m) { const int row = row0 + ai * HALF + m * 16; bf16_t* rowp = base + (size_t)row * ldc + colt + cl;
                    const f32x4 cs = *(const f32x4*)(rc + (size_t)row * 32 + i0), sn = *(const f32x4*)(rs + (size_t)row * 32 + i0);
#pragma unroll
                    for (int bj = 0; bj < 2; ++bj) { const f32x4 a0 = acc[ai][bj][m][0], a1 = acc[ai][bj][m][1]; f32x4 v0, v1;
                        v0[0] = (a0[0] * cs[0] - a0[1] * sn[0]) * sc; v0[1] = (a0[1] * cs[0] + a0[0] * sn[0]) * sc;
                        v0[2] = (a0[2] * cs[1] - a0[3] * sn[1]) * sc; v0[3] = (a0[3] * cs[1] + a0[2] * sn[1]) * sc;
                        v1[0] = (a1[0] * cs[2] - a1[1] * sn[2]) * sc; v1[1] = (a1[1] * cs[2] + a1[0] * sn[2]) * sc;
                        v1[2] = (a1[2] * cs[3] - a1[3] * sn[3]) * sc; v1[3] = (a1[3] * cs[3] + a1[2] * sn[3]) * sc;
                        st8(rowp + bj * HALF, v0, v1); }
                    asm volatile("" ::: "memory"); }
        } else {
#pragma unroll
            for (int ai = 0; ai < 2; ++ai)
#pragma unroll
                for (int m = 0; m < 4; ++m) { bf16_t* rowp = base + (size_t)(row0 + ai * HALF + m * 16) * ldc + colt + cl;
#pragma unroll
                    for (int bj = 0; bj < 2; ++bj) st8(rowp + bj * HALF, acc[ai][bj][m][0] * sc, acc[ai][bj][m][1] * sc); }
        }
    }
};
struct InOrder {
    StaticOrder S;
    __device__ void init(int G, int c) { S.init(16384, 26 * 256, G, c); }
    __device__ bool next(int i, Unit& u) const { if (!S.next(i, u)) return false; if (u.pn >= 4) u.pn += 2; return true; }
    __device__ __forceinline__ void a_ready(const Unit&) const {}
    __device__ __forceinline__ void done(const Unit&) const {}
};
template <int NB> struct EpiMerge {
    static constexpr bool PERM = true, AFTER_DRAIN = false;
    const bf16_t* gates; float* mf; bf16_t* merged;
    __device__ __forceinline__ void operator()(const f32x4 (&acc)[2][2][4][2], const Unit& u, int wr, int wc, int fr, int fq) const {
        const int row0 = u.pm * BM + wr * 64 + fr, col0 = u.pn * BM + wc * 32 + 8 * fq;
#pragma unroll
        for (int ai = 0; ai < 2; ++ai)
#pragma unroll
            for (int m = 0; m < 4; ++m) { const size_t row = (size_t)(row0 + ai * HALF + m * 16);
#pragma unroll
                for (int bj = 0; bj < 2; ++bj) { const int col = col0 + bj * HALF;
                    const u32x4 gw = *(const u32x4*)(gates + row * 3072 + NB * 1024 + col);
                    f32x4 g0, g1;
                    g0[0] = __uint_as_float(gw.x << 16); g0[1] = __uint_as_float(gw.x & 0xffff0000u); g0[2] = __uint_as_float(gw.y << 16); g0[3] = __uint_as_float(gw.y & 0xffff0000u);
                    g1[0] = __uint_as_float(gw.z << 16); g1[1] = __uint_as_float(gw.z & 0xffff0000u); g1[2] = __uint_as_float(gw.w << 16); g1[3] = __uint_as_float(gw.w & 0xffff0000u);
                    f32x4 v0 = acc[ai][bj][m][0] * g0, v1 = acc[ai][bj][m][1] * g1;
                    float* mp = mf + row * 1024 + col;
                    if (NB > 0) { v0 += *(const f32x4*)mp; v1 += *(const f32x4*)(mp + 4); }
                    if (NB < 2) { *(f32x4*)mp = v0; *(f32x4*)(mp + 4) = v1; }
                    else st8(merged + row * 1024 + col, v0, v1); }
                asm volatile("" ::: "memory"); }
    }
};
struct EpiOut {
    static constexpr bool PERM = true, AFTER_DRAIN = false;
    const float* resid; float* yf; float alpha;
    __device__ __forceinline__ void operator()(const f32x4 (&acc)[2][2][4][2], const Unit& u, int wr, int wc, int fr, int fq) const {
        const int row0 = u.pm * BM + wr * 64 + fr, col0 = u.pn * BM + wc * 32 + 8 * fq;
#pragma unroll
        for (int ai = 0; ai < 2; ++ai)
#pragma unroll
            for (int m = 0; m < 4; ++m) { const size_t row = (size_t)(row0 + ai * HALF + m * 16);
#pragma unroll
                for (int bj = 0; bj < 2; ++bj) { const size_t o = row * 1024 + col0 + bj * HALF;
                    const f32x4 r0 = *(const f32x4*)(resid + o), r1 = *(const f32x4*)(resid + o + 4);
                    *(f32x4*)(yf + o) = r0 * alpha + acc[ai][bj][m][0]; *(f32x4*)(yf + o + 4) = r1 * alpha + acc[ai][bj][m][1]; }
                asm volatile("" ::: "memory"); }
    }
};
}
#include <hip/hip_bf16.h>
#include <cmath>
namespace attn_body {
using bf16=__hip_bfloat16;
using bf16x8=__attribute__((ext_vector_type(8)))short;
using s16x4=__attribute__((ext_vector_type(4)))short;
using f32x16=__attribute__((ext_vector_type(16)))float;
using u32x4=__attribute__((ext_vector_type(4)))unsigned;
constexpr int BATCH=2,NHEAD=16,SEQ=8192,D=64;
constexpr int QP=1024,KP=1024,VP=512,OP=1024;
constexpr int NW=8,QBLK=32,QB=QBLK*NW,KVBLK=64,NQB=SEQ/QB;
constexpr int ATTN_UNIT_ROWS=QB;
__device__ __forceinline__ int crow(int r,int hi){return (r&3)+8*(r>>2)+4*hi;}
#define SBAR() __builtin_amdgcn_sched_barrier(0)
__device__ __forceinline__ void cmask(f32x16&p0,f32x16&p1,int jb,int qrel,int hi){
  const float NEG=-INFINITY; (void)hi;
  if(jb>(qrel>>6)){
  #pragma unroll
  for(int r=0;r<16;++r){p0[r]=NEG;p1[r]=NEG;} }
}

constexpr int NSLOT=3, SLOTB=8192;
constexpr int LDS_K=0, LDS_V=NSLOT*SLOTB, LDS_WS=2*NSLOT*SLOTB, LDS_OST=LDS_WS+NW*64*4, LDS_BYTES=LDS_OST+NW*4096;
constexpr float C2=0.125f*1.4426950408889634f;
__device__ __forceinline__ void glds16(const void*gsrc,unsigned lds_dst){unsigned keep;
  asm volatile("s_mov_b32 %0, m0\n\ts_mov_b32 m0, %2\n\ts_nop 0\n\tglobal_load_lds_dwordx4 %1, off\n\ts_mov_b32 m0, %0":"=&s"(keep):"v"(gsrc),"s"(lds_dst):"memory");}
__device__ __forceinline__ float max3f(float a,float b,float c){float r;asm("v_max3_f32 %0, %1, %2, %3":"=v"(r):"v"(a),"v"(b),"v"(c));return r;}
__device__ __forceinline__ float max2f(float a,float b){float r;asm("v_max_f32_e32 %0, %1, %2":"=v"(r):"v"(a),"v"(b));return r;}
__device__ __forceinline__ float fadd_s(float a,float b){float r;asm("v_add_f32_e32 %0, %1, %2":"=v"(r):"v"(a),"v"(b));return r;}
__device__ __forceinline__ float fsub_s(float a,float b){float r;asm("v_sub_f32_e32 %0, %1, %2":"=v"(r):"v"(a),"v"(b));return r;}
typedef float f32x2_t __attribute__((ext_vector_type(2))); typedef __bf16 bf16x2_t __attribute__((ext_vector_type(2)));
__device__ __forceinline__ unsigned cvtpk_s(float lo,float hi){f32x2_t v={lo,hi};bf16x2_t b=__builtin_convertvector(v,bf16x2_t);return __builtin_bit_cast(unsigned,b);}
#define WAIT_BAR(N) asm volatile("s_waitcnt vmcnt(" #N ") lgkmcnt(0)\n\ts_barrier":::"memory")

__device__ __forceinline__ void qkt(f32x16&p0,f32x16&p1,const char*Kslot,const bf16x8*qr,const f32x16&negm,int r32,int hi){
  const char*kb=Kslot+hi*1024+r32*16;
  #pragma unroll
  for(int d0=0;d0<4;++d0){
    const bf16x8 b0=*reinterpret_cast<const bf16x8*>(kb+d0*2048);
    const bf16x8 b1=*reinterpret_cast<const bf16x8*>(kb+d0*2048+512);
    if(d0==0){p0=__builtin_amdgcn_mfma_f32_32x32x16_bf16(b0,qr[0],negm,0,0,0);p1=__builtin_amdgcn_mfma_f32_32x32x16_bf16(b1,qr[0],negm,0,0,0);}
    else{p0=__builtin_amdgcn_mfma_f32_32x32x16_bf16(b0,qr[d0],p0,0,0,0);p1=__builtin_amdgcn_mfma_f32_32x32x16_bf16(b1,qr[d0],p1,0,0,0);}}
}
typedef __attribute__((address_space(3))) const char* lds_cptr;
typedef short v4i16_t __attribute__((ext_vector_type(4)));
__device__ __forceinline__ void kload8(bf16x8*kf,lds_cptr kp){
  kf[0]=*(const __attribute__((address_space(3))) bf16x8*)(kp);      kf[1]=*(const __attribute__((address_space(3))) bf16x8*)(kp+512);
  kf[2]=*(const __attribute__((address_space(3))) bf16x8*)(kp+2048); kf[3]=*(const __attribute__((address_space(3))) bf16x8*)(kp+2560);
  kf[4]=*(const __attribute__((address_space(3))) bf16x8*)(kp+4096); kf[5]=*(const __attribute__((address_space(3))) bf16x8*)(kp+4608);
  kf[6]=*(const __attribute__((address_space(3))) bf16x8*)(kp+6144); kf[7]=*(const __attribute__((address_space(3))) bf16x8*)(kp+6656);
}
__device__ __forceinline__ void kload2(bf16x8*kf,lds_cptr kp,int j){ kf[2*j]=*(const __attribute__((address_space(3))) bf16x8*)(kp+j*2048); kf[2*j+1]=*(const __attribute__((address_space(3))) bf16x8*)(kp+j*2048+512); }
__device__ __forceinline__ s16x4 vtr(lds_cptr p){ return __builtin_bit_cast(s16x4,__builtin_amdgcn_ds_read_tr16_b64_v4i16((__attribute__((address_space(3))) v4i16_t*)p)); }
__device__ __forceinline__ float rowmax(const f32x16&p0,const f32x16&p1){
  float a=max3f(p0[0],p0[1],p1[0]),b=max3f(p0[2],p0[3],p1[1]);a=max3f(a,p1[2],p1[3]);
  #pragma unroll
  for(int r=4;r<16;r+=4){a=max3f(a,p0[r],p0[r+1]);b=max3f(b,p0[r+2],p0[r+3]);a=max3f(a,p1[r],p1[r+1]);b=max3f(b,p1[r+2],p1[r+3]);}
  const float m=max2f(a,b);
  auto rr=__builtin_amdgcn_permlane32_swap(__float_as_uint(m),__float_as_uint(m),false,false);
  return max2f(__uint_as_float(rr[0]),__uint_as_float(rr[1]));
}
__device__ __forceinline__ void pv(f32x16*o,int vb,bf16x8 pa0,bf16x8 pa1,bf16x8 pa2,bf16x8 pa3){
  #pragma unroll
  for(int d0=0;d0<2;++d0){s16x4 lo[4],hi[4];
    #pragma unroll
    for(int ks=0;ks<4;++ks){
      asm volatile("ds_read_b64_tr_b16 %0,%1 offset:%c2":"=&v"(lo[ks]):"v"(vb),"i"(d0*4096+ks*1024):"memory");
      asm volatile("ds_read_b64_tr_b16 %0,%1 offset:%c2":"=&v"(hi[ks]):"v"(vb),"i"(d0*4096+ks*1024+512):"memory");}
    asm volatile("s_waitcnt lgkmcnt(0)":::"memory");SBAR();
    #define PK(k) (bf16x8){lo[k][0],lo[k][1],lo[k][2],lo[k][3],hi[k][0],hi[k][1],hi[k][2],hi[k][3]}
    o[d0]=__builtin_amdgcn_mfma_f32_32x32x16_bf16(pa0,PK(0),o[d0],0,0,0);
    o[d0]=__builtin_amdgcn_mfma_f32_32x32x16_bf16(pa1,PK(1),o[d0],0,0,0);
    o[d0]=__builtin_amdgcn_mfma_f32_32x32x16_bf16(pa2,PK(2),o[d0],0,0,0);
    o[d0]=__builtin_amdgcn_mfma_f32_32x32x16_bf16(pa3,PK(3),o[d0],0,0,0);
    #undef PK
  }
}

#ifndef ATTN_STORE16
#define ATTN_STORE16(p,v) (*(u32x4*)(p)=(v))
#endif
template<int THRL> __device__ __forceinline__ void attn_unit(int b,int h,int qb,const bf16*Q,const bf16*__restrict__ K,const bf16*__restrict__ V,bf16*O,char*shm){
  const int qcol=(h>>1)*64, kcol=512+(h>>1)*64, vcol=((h>>2)*2+(h&1))*64, ocol=h*64;
  int tid_=threadIdx.x; asm volatile("":"+v"(tid_)); const int tid=tid_,lane=tid&63,r32=lane&31,hi=lane>>5; const int wid=__builtin_amdgcn_readfirstlane(tid>>6);
  const long rowbase=(long)b*SEQ; const int q0=qb*QB;
  const bf16*Qw=Q+(rowbase+q0+wid*QBLK)*QP+qcol;
  const bf16*Kh=K+rowbase*KP+kcol,*Vh=V+rowbase*VP+vcol;
  const unsigned lds0=(unsigned)(uintptr_t)shm;
  float*wsf=(float*)(shm+LDS_WS)+wid*64;
  const bf16*ksrc=Kh+(long)lane*KP+wid*8;
  const bf16*vsrc=Vh+(long)(16*(wid&3)+(lane>>2))*VP+(wid>>2)*32+(lane&3)*8;
  const unsigned kdst=lds0+LDS_K+wid*1024, vdst=lds0+LDS_V+wid*1024;
  #define DMA_K(t,slot) glds16(ksrc+(long)(t)*KVBLK*KP,(unsigned)__builtin_amdgcn_readfirstlane(kdst+(slot)))
  #define DMA_V(t,slot) glds16(vsrc+(long)(t)*KVBLK*VP,(unsigned)__builtin_amdgcn_readfirstlane(vdst+(slot)))
  const int vb0=(int)(lds0+LDS_V)+((lane>>4)&1)*32+(lane&3)*8+(4*hi+((lane&15)>>2))*64;
  const char*Kbase=shm+LDS_K; bf16x8 kf[8];
  const lds_cptr shm3=(lds_cptr)shm; const lds_cptr kp0=shm3+LDS_K+hi*1024+r32*16; const lds_cptr vp0=shm3+LDS_V+((lane>>4)&1)*32+(lane&3)*8+(4*hi+((lane&15)>>2))*64;
  const int NT=(q0+QB)/KVBLK;
  DMA_K(0,0);DMA_V(0,0);DMA_K(1,SLOTB);
  bf16x8 qr[4];
  #pragma unroll
  for(int d0=0;d0<4;++d0)qr[d0]=*reinterpret_cast<const bf16x8*>(&Qw[(long)r32*QP+d0*16+hi*8]);
  float mhat=0.f,l_reg=0.f;f32x16 o[2];o[0]=f32x16{};o[1]=f32x16{};f32x16 negm=f32x16{};asm volatile("":"+v"(negm));
  const int qrel=wid*QBLK+r32;
  #define CMASK(P0,P1,t) do{int jb_=(t)-(NT-4); if(jb_>=0)cmask(P0,P1,jb_,qrel,hi);}while(0)
  bool resc=false;
  #define START(P0,P1) do{ const float rm=rowmax(P0,P1); resc=false; \
    { const float dl=rm; mhat=fadd_s(mhat,dl); \
      _Pragma("unroll") for(int r=0;r<16;++r){P0[r]=fsub_s(P0[r],dl);P1[r]=fsub_s(P1[r],dl);} \
      _Pragma("unroll") for(int r=0;r<16;++r)negm[r]=-mhat; asm volatile("":"+v"(negm)); } \
    _Pragma("unroll") for(int r=0;r<16;++r)P0[r]=__builtin_amdgcn_exp2f(P0[r]); }while(0)
  #define RESC() do{ if(resc){ asm volatile("s_waitcnt lgkmcnt(0)":::"memory"); \
      _Pragma("unroll") for(int d_=0;d_<2;++d_) _Pragma("unroll") for(int r=0;r<16;++r)o[d_][r]*=wsf[crow(r,hi)]; } }while(0)
  f32x16 pA0,pA1,pB0,pB1;
  int sl_prev=0,sl_cur=0,sl_next=SLOTB;
  #define ROT() do{sl_prev=sl_cur;sl_cur=sl_next;sl_next=(sl_next==(NSLOT-1)*SLOTB)?0:sl_next+SLOTB;}while(0)
  DMA_K(2,2*SLOTB);
  WAIT_BAR(3);
  qkt(pA0,pA1,Kbase,qr,negm,r32,hi);asm volatile("s_nop 15\n\ts_nop 7":"+v"(pA0),"+v"(pA1));CMASK(pA0,pA1,0);
  START(pA0,pA1);
  _Pragma("unroll") for(int r=0;r<16;++r)pA1[r]=__builtin_amdgcn_exp2f(pA1[r]);
  WAIT_BAR(0);
  DMA_K(3,0);DMA_V(1,SLOTB);
  ROT();
  kload8(kf,kp0+sl_cur);
  WAIT_BAR(2);
  s16x4 vlo[8],vhi[8]; u32x4 pw0,pw1,pw2,pw3;
  #define PKW(P,B) cvtpk_s(P[B],P[B+1])
  #define PAF(k) __builtin_bit_cast(bf16x8,pw##k)
  #define VFR(i) (bf16x8){vlo[i][0],vlo[i][1],vlo[i][2],vlo[i][3],vhi[i][0],vhi[i][1],vhi[i][2],vhi[i][3]}
  #define PIN(x) asm volatile("":"+v"(x))
  #define MX3(a,b,c) __builtin_fmaxf(__builtin_fmaxf((a),(b)),(c))
  #define GAPA(MF,A0,A1,A2,A3,W0,W1,PW) do{ MF; sacc+=A0; sacc+=A1; sacc+=A2; sacc+=A3; PIN(sacc); W0; W1; PIN(PW); SBAR(); }while(0)
  #define EX(v) __builtin_amdgcn_exp2f(v)
  #define GAPB(MF,X,B) do{ MF; X[B]=EX(X[B]); X[B+1]=EX(X[B+1]); X[B+2]=EX(X[B+2]); X[B+3]=EX(X[B+3]); PIN(X); SBAR(); }while(0)
  #define VRD(i) do{ vlo[i]=vtr(vp_+(((i)>>2)*4096+((i)&3)*1024)); vhi[i]=vtr(vp_+(((i)>>2)*4096+((i)&3)*1024+512)); }while(0)
  #define KRD(G,j) do{ if(G){ kload2(kf,kp0+sl_next,j); SBAR(); } }while(0)
  #define STEP(C0,C1,P0,P1,t,GK,GV,GL) do{ SBAR(); \
    const lds_cptr vp_=vp0+sl_prev; \
    VRD(0); SBAR(); float sacc=(P0[0]+P0[1]); \
    GAPA(C0=__builtin_amdgcn_mfma_f32_32x32x16_bf16(kf[0],qr[0],negm,0,0,0), P0[2],P0[3],P0[4],P0[5],     pw0[0]=PKW(P0,0), pw0[1]=PKW(P0,2), pw0); \
    VRD(4); SBAR(); GAPA(C1=__builtin_amdgcn_mfma_f32_32x32x16_bf16(kf[1],qr[0],negm,0,0,0), P0[6],P0[7],P0[8],P0[9],     pw0[2]=PKW(P0,4), pw0[3]=PKW(P0,6), pw0); \
    VRD(1); SBAR(); GAPA(C0=__builtin_amdgcn_mfma_f32_32x32x16_bf16(kf[2],qr[1],C0,0,0,0),   P0[10],P0[11],P0[12],P0[13], pw1[0]=PKW(P0,8), pw1[1]=PKW(P0,10), pw1); \
    VRD(5); SBAR(); GAPA(C1=__builtin_amdgcn_mfma_f32_32x32x16_bf16(kf[3],qr[1],C1,0,0,0),   P0[14],P0[15],P1[0],P1[1],   pw1[2]=PKW(P0,12),pw1[3]=PKW(P0,14), pw1); \
    VRD(2); SBAR(); GAPA(C0=__builtin_amdgcn_mfma_f32_32x32x16_bf16(kf[4],qr[2],C0,0,0,0),   P1[2],P1[3],P1[4],P1[5],     pw2[0]=PKW(P1,0), pw2[1]=PKW(P1,2), pw2); \
    VRD(6); SBAR(); GAPA(C1=__builtin_amdgcn_mfma_f32_32x32x16_bf16(kf[5],qr[2],C1,0,0,0),   P1[6],P1[7],P1[8],P1[9],     pw2[2]=PKW(P1,4), pw2[3]=PKW(P1,6), pw2); \
    VRD(3); SBAR(); GAPA(C0=__builtin_amdgcn_mfma_f32_32x32x16_bf16(kf[6],qr[3],C0,0,0,0),   P1[10],P1[11],P1[12],P1[13], pw3[0]=PKW(P1,8), pw3[1]=PKW(P1,10), pw3); \
    VRD(7); SBAR(); GAPA(C1=__builtin_amdgcn_mfma_f32_32x32x16_bf16(kf[7],qr[3],C1,0,0,0),   P1[14],P1[15],0.f,0.f,       pw3[2]=PKW(P1,12),pw3[3]=PKW(P1,14), pw3); \
    l_reg+=sacc; \
    if(GK){DMA_K((t)+3,sl_cur);} if(GV){DMA_V((t)+1,sl_next);} \
    CMASK(C0,C1,t); \
    { float a=MX3(C0[0],C0[1],C1[0]),b=MX3(C0[2],C0[3],C1[1]); a=MX3(a,C1[2],C1[3]); \
      _Pragma("unroll") for(int r=4;r<16;r+=4){a=MX3(a,C0[r],C0[r+1]);b=MX3(b,C0[r+2],C0[r+3]);a=MX3(a,C1[r],C1[r+1]);b=MX3(b,C1[r+2],C1[r+3]);} \
      float rm=__builtin_fmaxf(a,b); { auto rr=__builtin_amdgcn_permlane32_swap(__float_as_uint(rm),__float_as_uint(rm),false,false); rm=__builtin_fmaxf(__uint_as_float(rr[0]),__uint_as_float(rr[1])); } \
      resc=false; \
      if(__builtin_expect(__any(rm>(float)THRL),0)){ const float dl=__builtin_fmaxf(rm,0.f); mhat+=dl; \
        _Pragma("unroll") for(int r=0;r<16;++r){C0[r]-=dl;C1[r]-=dl;} \
        _Pragma("unroll") for(int r=0;r<16;++r)negm[r]=-mhat; asm volatile("":"+v"(negm)); \
        const float f=__builtin_amdgcn_exp2f(-dl); l_reg*=f; if(hi==0)wsf[r32]=f; resc=true; } } \
    SBAR(); \
    GAPB(o[0]=__builtin_amdgcn_mfma_f32_32x32x16_bf16(PAF(0),VFR(0),o[0],0,0,0), C0,0); \
    GAPB(o[1]=__builtin_amdgcn_mfma_f32_32x32x16_bf16(PAF(0),VFR(4),o[1],0,0,0), C0,4); \
    KRD(GL,0); GAPB(o[0]=__builtin_amdgcn_mfma_f32_32x32x16_bf16(PAF(1),VFR(1),o[0],0,0,0), C0,8); \
    KRD(GL,1); GAPB(o[1]=__builtin_amdgcn_mfma_f32_32x32x16_bf16(PAF(1),VFR(5),o[1],0,0,0), C0,12); \
    KRD(GL,2); GAPB(o[0]=__builtin_amdgcn_mfma_f32_32x32x16_bf16(PAF(2),VFR(2),o[0],0,0,0), C1,0); \
    KRD(GL,3); GAPB(o[1]=__builtin_amdgcn_mfma_f32_32x32x16_bf16(PAF(2),VFR(6),o[1],0,0,0), C1,4); \
    GAPB(o[0]=__builtin_amdgcn_mfma_f32_32x32x16_bf16(PAF(3),VFR(3),o[0],0,0,0), C1,8); \
    GAPB(o[1]=__builtin_amdgcn_mfma_f32_32x32x16_bf16(PAF(3),VFR(7),o[1],0,0,0), C1,12); \
    }while(0)
  int t=1;
  #undef CMASK
  #define CMASK(P0,P1,t) do{}while(0)
  for(;t+5<NT;t+=2){
    STEP(pB0,pB1,pA0,pA1,t,true,true,true);     WAIT_BAR(2); RESC(); ROT();
    STEP(pA0,pA1,pB0,pB1,t+1,true,true,true);   WAIT_BAR(2); RESC(); ROT();
  }
  #undef CMASK
  #define CMASK(P0,P1,t) do{int jb_=(t)-(NT-4); if(jb_>=0)cmask(P0,P1,jb_,qrel,hi);}while(0)
  #define ENDW(tt) do{ if((tt)+3<NT){WAIT_BAR(2);} else if((tt)+2<NT){WAIT_BAR(1);} else {WAIT_BAR(0);} }while(0)
  for(;t+1<NT;t+=2){
    STEP(pB0,pB1,pA0,pA1,t,(t+3<NT),(t+1<NT),(t+1<NT));       ENDW(t);   RESC(); ROT();
    STEP(pA0,pA1,pB0,pB1,t+1,(t+4<NT),(t+2<NT),(t+2<NT));     ENDW(t+1); RESC(); ROT();
  }
  STEP(pB0,pB1,pA0,pA1,NT-1,false,false,false); RESC();
  { float sacc=pB0[0]+pB0[1]; _Pragma("unroll") for(int r=2;r<16;++r)sacc+=pB0[r]; _Pragma("unroll") for(int r=0;r<16;++r)sacc+=pB1[r]; l_reg+=sacc;
    pw0=(u32x4){PKW(pB0,0),PKW(pB0,2),PKW(pB0,4),PKW(pB0,6)};pw1=(u32x4){PKW(pB0,8),PKW(pB0,10),PKW(pB0,12),PKW(pB0,14)};pw2=(u32x4){PKW(pB1,0),PKW(pB1,2),PKW(pB1,4),PKW(pB1,6)};pw3=(u32x4){PKW(pB1,8),PKW(pB1,10),PKW(pB1,12),PKW(pB1,14)};
    SBAR(); pv(o,vb0+sl_cur,PAF(0),PAF(1),PAF(2),PAF(3)); }
  #undef PKW
  #undef PAF
  #undef VFR
  #undef PIN
  #undef MX3
  #undef GAPA
  #undef GAPB
  #undef EX
  #undef VRD
  #undef KRD
  #undef STEP
  #undef ENDW
  {auto rr=__builtin_amdgcn_permlane32_swap(__float_as_uint(l_reg),__float_as_uint(l_reg),false,false);l_reg=__uint_as_float(rr[0])+__uint_as_float(rr[1]);}
  if(hi==0)wsf[32+r32]=l_reg;asm volatile("s_waitcnt lgkmcnt(0)":::"memory");
  float rli[16];
  #pragma unroll
  for(int r=0;r<16;++r)rli[r]=__builtin_amdgcn_rcpf(wsf[32+crow(r,hi)]);
  bf16*Ow=O+(rowbase+q0+wid*QBLK)*OP+ocol;
  { bf16*stg=(bf16*)(shm+LDS_OST)+wid*2048;
    #pragma unroll
    for(int r=0;r<16;++r){const int orow=crow(r,hi);
      #pragma unroll
      for(int d0=0;d0<2;++d0)stg[orow*64+d0*32+r32]=__float2bfloat16(o[d0][r]*rli[r]);}
    asm volatile("s_waitcnt lgkmcnt(0)":::"memory");
    #pragma unroll
    for(int i=0;i<4;++i){const int row=i*8+(lane>>3),ch=lane&7; const u32x4 v=*(const u32x4*)(stg+row*64+ch*8); ATTN_STORE16(Ow+(long)row*OP+ch*8,v);} }
  asm volatile("s_waitcnt lgkmcnt(0)\n\ts_barrier":::"memory");
  #undef DMA_K
  #undef DMA_V
  #undef CMASK
  #undef START
  #undef RESC
  #undef ROT
}
constexpr int ATTN_LDS_BYTES=LDS_BYTES;
struct AttnTensors { const bf16* Q; const bf16* K; const bf16* V; bf16* O; };
struct AttnUnit { int bh; int qb; };
struct StaticOrder {
  int vcu;
  __device__ __forceinline__ explicit StaticOrder(int grid,int block):vcu((block%8)*(grid/8)+block/8){}
  __device__ __forceinline__ bool next(int i,AttnUnit&u)const{ if(i>=4)return false; const int s=vcu&7; u.bh=vcu>>3; u.qb=(i==0)?s:(i==1)?15-s:(i==2)?16+s:31-s; return true; }
  __device__ __forceinline__ void a_ready(const AttnUnit&)const{}
  __device__ __forceinline__ void done(const AttnUnit&)const{}
};
template<class Sched,int THRL=8> __device__ __forceinline__ void attn_phase(char*lds,const AttnTensors&T,const Sched&S){
  AttnUnit u;
  for(int i=0;S.next(i,u);++i){ S.a_ready(u); attn_unit<THRL>(u.bh/NHEAD,u.bh%NHEAD,u.qb,T.Q,T.K,T.V,T.O,lds); S.done(u); }
}
#undef SBAR
#undef WAIT_BAR
}
#define GAS __attribute__((address_space(1)))
#define LAS __attribute__((address_space(3)))
typedef unsigned short bf16;
typedef unsigned v4u __attribute__((ext_vector_type(4)));
typedef float f32x4 __attribute__((ext_vector_type(4)));
typedef short bf16x8 __attribute__((ext_vector_type(8)));
typedef GAS unsigned gu32;
typedef GAS unsigned long long gu64;
#define RLX_AGENT __ATOMIC_RELAXED, __HIP_MEMORY_SCOPE_AGENT
#define LDS_WAIT() asm volatile("s_waitcnt lgkmcnt(0)" ::: "memory")
#define VM_WAIT() asm volatile("s_waitcnt vmcnt(0)" ::: "memory")
__device__ __forceinline__ unsigned long long rt() { return __builtin_amdgcn_s_memrealtime(); }
__device__ __forceinline__ unsigned f2bf(float f) { unsigned u = __builtin_bit_cast(unsigned, f); return (u + 0x7fffu + ((u >> 16) & 1u)) >> 16; }
__device__ __forceinline__ unsigned pk2(float lo, float hi) { return f2bf(lo) | (f2bf(hi) << 16); }

#define XB_TMO      128
#define XB_XCNT(j)  (256  + 64 * (j))
#define XB_XSUB(j)  (1280 + 64 * (j))
#define XB_XGEN(j)  (2304 + 64 * (j))
#define XB_TOP      3328
#define XB_TOPGEN   3392
#define XCD_BAR_WORDS 3456
#define XB_SPIN_CAP (1u << 18)

__device__ __forceinline__ unsigned xb_ld(unsigned* p)              { return __hip_atomic_load(p, __ATOMIC_RELAXED, __HIP_MEMORY_SCOPE_AGENT); }
__device__ __forceinline__ unsigned xb_add(unsigned* p, unsigned v) { return __hip_atomic_fetch_add(p, v, __ATOMIC_RELAXED, __HIP_MEMORY_SCOPE_AGENT); }
__device__ __forceinline__ unsigned xb_xcc_id() { return (unsigned)__builtin_amdgcn_s_getreg((3 << 11) | 20) & 0xFu; }
#define XB_SPIN(cond, bar) do { unsigned _sp = 0; while (cond) { __builtin_amdgcn_s_sleep(1); \
    if ((++_sp & 255u) == 0u) { if (xb_ld(&(bar)[XB_TMO])) break; if (_sp > XB_SPIN_CAP) { atomicAdd(&(bar)[XB_TMO], 1u); break; } } } } while (0)

struct XcdBarrier {
    unsigned* bar; unsigned x;
    volatile LAS unsigned* st;
};

__device__ __forceinline__ XcdBarrier xcd_barrier_post(unsigned* bar, volatile LAS unsigned* st) {
    XcdBarrier b; b.bar = bar; b.x = xb_xcc_id(); b.st = st;
    if (threadIdx.x == 0) (void)xb_add(&bar[XB_XCNT(b.x)], 1u);
    return b;
}
__device__ __forceinline__ void xcd_barrier_complete(unsigned* bar, unsigned x, unsigned& nloc, unsigned& nx) {
    const unsigned G = gridDim.x * gridDim.y * gridDim.z;
    unsigned sum, cnt, mine, sp = 0u;
    for (;;) {
        sum = 0u; cnt = 0u; mine = 0u;
#pragma unroll
        for (unsigned j = 0; j < 16; ++j) { const unsigned c = xb_ld(&bar[XB_XCNT(j)]); sum += c; cnt += (c > 0u) ? 1u : 0u; mine = (j == x) ? c : mine; }
        if (sum == G) break;
        __builtin_amdgcn_s_sleep(1);
        if ((++sp & 255u) == 0u) { if (xb_ld(&bar[XB_TMO])) break; if (sp > XB_SPIN_CAP) { atomicAdd(&bar[XB_TMO], 1u); break; } }
    }
    nloc = mine > 0u ? mine : 1u; nx = cnt > 0u ? cnt : 1u;
}

__device__ __forceinline__ void xcd_barrier(const XcdBarrier& b) {
    asm volatile("s_waitcnt vmcnt(0)" ::: "memory");
    __syncthreads();
    if (threadIdx.x == 0) {
        unsigned* bar = b.bar;
        __builtin_amdgcn_s_waitcnt(0);
        unsigned nloc = b.st[0], nx = b.st[1];
        if (nloc == 0u) { xcd_barrier_complete(bar, b.x, nloc, nx); b.st[0] = nloc; b.st[1] = nx; }
        const unsigned old = xb_add(&bar[XB_XSUB(b.x)], 1u);
        const unsigned gen = old / nloc;
        if (old + 1u == (gen + 1u) * nloc) {
            __builtin_amdgcn_fence(__ATOMIC_RELEASE, "agent");
            asm volatile("s_waitcnt vmcnt(0)" ::: "memory");
            const unsigned og = xb_add(&bar[XB_TOP], 1u);
            const unsigned tg = og / nx;
            if (og + 1u == (tg + 1u) * nx) xb_add(&bar[XB_TOPGEN], 1u);
            else XB_SPIN(xb_ld(&bar[XB_TOPGEN]) == tg, bar);
            __builtin_amdgcn_fence(__ATOMIC_ACQUIRE, "agent");
            xb_add(&bar[XB_XGEN(b.x)], 1u);
            asm volatile("s_waitcnt vmcnt(0)" ::: "memory");
        } else {
            XB_SPIN(xb_ld(&bar[XB_XGEN(b.x)]) == gen, bar);
            __builtin_amdgcn_fence(__ATOMIC_ACQUIRE, "agent");
            asm volatile("s_waitcnt vmcnt(0)" ::: "memory");
        }
    }
    __syncthreads();
}
constexpr int NWAVES = 8;
constexpr int BATCH = 2, SEQ = 8192, D = 1024, M = BATCH * SEQ, DEPTH = 2, INC = 7168;
constexpr float LN_EPS = 1e-5f, ALPHA = 1.4142135623730951f, LOG2E = 1.4426950408889634f;
constexpr size_t MiB = 1u << 20;
constexpr size_t WS_CTL = 0, CTL_ZERO_BYTES = 1 * MiB;
constexpr size_t WS_WIN = 2 * MiB;
constexpr size_t WS_WBR = 30 * MiB;
constexpr size_t WS_WOUT = 36 * MiB;
constexpr size_t WS_WQ = 40 * MiB;
constexpr size_t WS_SUBK = 48 * MiB;
constexpr size_t WS_ROPEC = 49 * MiB, WS_ROPES = 51 * MiB;
constexpr size_t WS_LRUW = 53 * MiB;
constexpr size_t WS_MISC = 54 * MiB;
constexpr size_t WS_U = 56 * MiB, WS_V = 88 * MiB;
constexpr size_t WS_SU = 55 * MiB, WS_SV = 55 * MiB + 131072;
constexpr size_t WS_HB = 120 * MiB;
constexpr size_t WS_HL = WS_HB, WS_PP = 152 * MiB;
constexpr size_t WS_AQK = 184 * MiB;
constexpr size_t WS_AVT = 216 * MiB;
constexpr size_t WS_CQK = 232 * MiB;
constexpr size_t WS_CV = 264 * MiB;
constexpr size_t WS_BXG = 280 * MiB;
constexpr size_t WS_GATES = 312 * MiB;
constexpr size_t WS_YA = 408 * MiB, WS_YB = 424 * MiB, WS_YC = 440 * MiB;
constexpr size_t WS_CO = 456 * MiB;
constexpr size_t WS_END = 488 * MiB;
constexpr size_t WS_MERGEF = 184 * MiB;
constexpr size_t WS_MERGED = 248 * MiB;
constexpr size_t WS_YF = 312 * MiB;
constexpr size_t WS_PQ = 184 * MiB;
constexpr size_t WS_EIDX = 248 * MiB, WS_EG = 256 * MiB;
constexpr size_t WS_DBGH1 = 376 * MiB;
constexpr int CW_BAR = 4096;

constexpr int RING_OFF = 0, RING_BYTES = 131072;
constexpr int LDSCTL_OFF = RING_BYTES, MISC_OFF = LDSCTL_OFF + 320;
constexpr int LDS_BYTES = 147456;

typedef unsigned short bf16;
__device__ __forceinline__ float bf2f(unsigned short b) { return __uint_as_float((unsigned)b << 16); }
__device__ __forceinline__ float gelu_tanh(float x) {
    const float t = 1.5957691216057308f * (x + 0.044715f * x * x * x);
    return x * __builtin_amdgcn_rcpf(1.0f + __builtin_amdgcn_exp2f(-LOG2E * t));
}
__device__ __forceinline__ float wave_sum(float v) {
#pragma unroll
    for (int o = 1; o < 64; o <<= 1) v += __shfl_xor(v, o);
    return v;
}
typedef __bf16 bf16x2v __attribute__((ext_vector_type(2)));
__device__ __forceinline__ float dot2bf(unsigned a, unsigned b, float acc) { return __builtin_amdgcn_fdot2_f32_bf16(__builtin_bit_cast(bf16x2v, a), __builtin_bit_cast(bf16x2v, b), acc, false); }
typedef float f32x16 __attribute__((ext_vector_type(16)));
typedef unsigned u32x2e __attribute__((ext_vector_type(2)));
typedef int i32x4e __attribute__((ext_vector_type(4)));
#define MFMA32(a, b, c) __builtin_amdgcn_mfma_f32_32x32x16_bf16(a, b, c, 0, 0, 0)
#define MFMA16(a, b, c) __builtin_amdgcn_mfma_f32_16x16x32_bf16(a, b, c, 0, 0, 0)

__device__ __forceinline__ void p0_transpose_item(const float* W, int K, int N, bf16* WT, int perm_lo, int perm_hi, LAS float* scr, int item, int lane) {
    const int nblk = N / 32, kb = item / nblk, nb = item % nblk, k0 = 64 * kb, n0 = 32 * nb;
#pragma unroll 8
    for (int i = 0; i < 32; ++i) { const int kk = 2 * i + (lane >> 5); scr[kk * 33 + (lane & 31)] = W[(size_t)(k0 + kk) * N + n0 + (lane & 31)]; }
    LDS_WAIT(); asm volatile("" ::: "memory");
    const int c = lane & 7;
#pragma unroll
    for (int j = 0; j < 4; ++j) { const int n = (lane >> 3) + 8 * j; const LAS float* s = scr + (8 * c) * 33 + n;
        v4u o; o.x = pk2(s[0 * 33], s[1 * 33]); o.y = pk2(s[2 * 33], s[3 * 33]); o.z = pk2(s[4 * 33], s[5 * 33]); o.w = pk2(s[6 * 33], s[7 * 33]);
        int dn = n0 + n; if (dn >= perm_lo && dn < perm_hi) dn = (dn & ~63) + 2 * (dn & 31) + ((dn >> 5) & 1);
        *(GAS v4u*)(WT + (size_t)dn * K + k0 + 8 * c) = o; }
    LDS_WAIT(); asm volatile("" ::: "memory");
}
__device__ __forceinline__ void cvt_stream(const float* src, bf16* dst, size_t n8, size_t gt, size_t ngt) {
    for (size_t i = gt; i < n8; i += ngt) { const f32x4 a = *(const GAS f32x4*)(src + 8 * i), b = *(const GAS f32x4*)(src + 8 * i + 4);
        v4u o; o.x = pk2(a.x, a.y); o.y = pk2(a.z, a.w); o.z = pk2(b.x, b.y); o.w = pk2(b.z, b.w); *(GAS v4u*)(dst + 8 * i) = o; }
}
typedef float f32x2q __attribute__((ext_vector_type(2)));
__device__ __forceinline__ void quant_row_fp8(const float* src, unsigned char* dst, float* scale, int lane) {
    f32x4 v[4]; float am = 0.f;
#pragma unroll
    for (int j = 0; j < 4; ++j) { v[j] = *(const GAS f32x4*)(src + 16 * lane + 4 * j); am = fmaxf(am, fmaxf(fmaxf(fabsf(v[j].x), fabsf(v[j].y)), fmaxf(fabsf(v[j].z), fabsf(v[j].w)))); }
#pragma unroll
    for (int o = 1; o < 64; o <<= 1) am = fmaxf(am, __shfl_xor(am, o));
    const float sc = am > 0.f ? am * (1.0f / 448.0f) : 1.0f, inv = 1.0f / sc;
    v4u w; unsigned ww[4];
#pragma unroll
    for (int j = 0; j < 4; ++j) { int t = __builtin_amdgcn_cvt_pk_fp8_f32(v[j].x * inv, v[j].y * inv, 0, false); t = __builtin_amdgcn_cvt_pk_fp8_f32(v[j].z * inv, v[j].w * inv, t, true); ww[j] = (unsigned)t; }
    w.x = ww[0]; w.y = ww[1]; w.z = ww[2]; w.w = ww[3];
    *(GAS v4u*)(dst + 16 * lane) = w;
    if (lane == 0) *scale = sc;
}
__device__ __forceinline__ void b1_unit(int l, int unit, LAS unsigned char* lds, const bf16* BXG, const bf16* LRUW, const float* conv_w, const float* conv_b,
                                        const float* b_r, const float* b_i, const float* lam, float* HL, float* PP, int tid, int wid, int lane) {
    const int b = unit >> 9, c = (unit >> 2) & 127, qt = unit & 3;
    LAS float* XC = (LAS float*)lds;
    LAS float* IG = (LAS float*)(lds + 32768);
    LAS bf16* XB = (LAS bf16*)(lds + 65536);
    {
        const int ch = tid & 127, tq = tid >> 7, gc = qt * 128 + ch, s0 = c * 64 + tq * 16;
        const float w0 = conv_w[(l * 4 + 0) * 512 + gc], w1 = conv_w[(l * 4 + 1) * 512 + gc], w2 = conv_w[(l * 4 + 2) * 512 + gc], w3 = conv_w[(l * 4 + 3) * 512 + gc], cb = conv_b[l * 512 + gc];
        const bf16* bx = BXG + (size_t)b * SEQ * 1024 + gc;
        float xm3 = (s0 >= 3) ? bf2f(bx[(size_t)(s0 - 3) * 1024]) : 0.f, xm2 = (s0 >= 2) ? bf2f(bx[(size_t)(s0 - 2) * 1024]) : 0.f, xm1 = (s0 >= 1) ? bf2f(bx[(size_t)(s0 - 1) * 1024]) : 0.f;
#pragma unroll 4
        for (int t = 0; t < 16; ++t) { const float x0 = bf2f(bx[(size_t)(s0 + t) * 1024]); const float xc = cb + xm3 * w0 + xm2 * w1 + xm1 * w2 + x0 * w3;
            XC[(tq * 16 + t) * 128 + ch] = xc; XB[(tq * 16 + t) * 136 + ch] = (bf16)f2bf(xc); xm3 = xm2; xm2 = xm1; xm1 = x0; }
    }
    __syncthreads();
    const int blk = wid & 1, gate = (wid >> 1) & 1, th = wid >> 2, g = qt * 2 + blk, fr = lane & 15, fq = lane >> 4;
    f32x4 acc[2][4];
#pragma unroll
    for (int mt = 0; mt < 2; ++mt)
#pragma unroll
        for (int nt = 0; nt < 4; ++nt) acc[mt][nt] = (f32x4){0.f, 0.f, 0.f, 0.f};
    {
        const bf16* wb = LRUW + (size_t)(((l * 2 + gate) * 8 + g) * 64) * 64;
#pragma unroll
        for (int ks = 0; ks < 2; ++ks) { bf16x8 af[2], bfr[4];
#pragma unroll
            for (int mt = 0; mt < 2; ++mt) af[mt] = *(const LAS bf16x8*)(XB + (th * 32 + mt * 16 + fr) * 136 + blk * 64 + ks * 32 + 8 * fq);
#pragma unroll
            for (int nt = 0; nt < 4; ++nt) bfr[nt] = *(const GAS bf16x8*)(wb + (nt * 16 + fr) * 64 + ks * 32 + 8 * fq);
#pragma unroll
            for (int mt = 0; mt < 2; ++mt)
#pragma unroll
                for (int nt = 0; nt < 4; ++nt) acc[mt][nt] = MFMA16(af[mt], bfr[nt], acc[mt][nt]); }
    }
    const float* bias = (gate ? b_i : b_r) + (l * 8 + g) * 64;
#pragma unroll
    for (int nt = 0; nt < 4; ++nt) { const float bj = bias[nt * 16 + fr];
#pragma unroll
        for (int mt = 0; mt < 2; ++mt)
#pragma unroll
            for (int e = 0; e < 4; ++e) acc[mt][nt][e] = pg8::sigm(acc[mt][nt][e] + bj); }
    if (gate == 1) {
#pragma unroll
        for (int nt = 0; nt < 4; ++nt)
#pragma unroll
            for (int mt = 0; mt < 2; ++mt)
#pragma unroll
                for (int e = 0; e < 4; ++e) IG[(th * 32 + mt * 16 + 4 * fq + e) * 128 + blk * 64 + nt * 16 + fr] = acc[mt][nt][e];
    }
    __syncthreads();
    if (gate == 0) {
#pragma unroll
        for (int nt = 0; nt < 4; ++nt) { const float lm = lam[l * 512 + g * 64 + nt * 16 + fr];
            const float ls8 = -8.0f * log1pf(expf(-lm));
#pragma unroll
            for (int mt = 0; mt < 2; ++mt)
#pragma unroll
                for (int e = 0; e < 4; ++e) { const int o = (th * 32 + mt * 16 + 4 * fq + e) * 128 + blk * 64 + nt * 16 + fr;
                    const float la = acc[mt][nt][e] * ls8, a = expf(la), mult = sqrtf(-expm1f(2.0f * la));
                    const float u = mult * (IG[o] * XC[o]); IG[o] = a; XC[o] = u; } }
    }
    __syncthreads();
    if (tid < 128) { float h = 0.f, p = 1.f; const size_t o0 = ((size_t)b * SEQ + c * 64) * 512 + qt * 128 + tid;
#pragma unroll 8
        for (int t = 0; t < 64; ++t) { const float a = IG[t * 128 + tid], u = XC[t * 128 + tid]; h = a * h + u; p *= a; HL[o0 + (size_t)t * 512] = h; PP[o0 + (size_t)t * 512] = p; } }
    __syncthreads();
}
__device__ __forceinline__ void b3_unit(int unit, const float* HL, const float* PP, const bf16* BXG, bf16* YB, int tid) {
    const int b = unit >> 7, c = unit & 127; float hin = 0.f;
    const size_t base = (size_t)b * SEQ * 512 + tid;
#pragma unroll 4
    for (int cc = 0; cc < c; ++cc) { const size_t o = base + (size_t)(cc * 64 + 63) * 512; hin = PP[o] * hin + HL[o]; }
#pragma unroll 4
    for (int t = 0; t < 64; ++t) { const size_t row = (size_t)b * SEQ + c * 64 + t; const float h = HL[row * 512 + tid] + PP[row * 512 + tid] * hin;
        YB[row * 512 + tid] = (bf16)f2bf(h * gelu_tanh(bf2f(BXG[row * 1024 + 512 + tid]))); }
}
__device__ __forceinline__ void band_unit(int unit, const bf16* AQK, const bf16* AVT, const float* relb, bf16* YA, int head, int lane) {
    const int b = unit >> 7, c = unit & 127, r32 = lane & 31, hi = lane >> 5;
    const int kap = (r32 & ~12) | ((r32 & 4) << 1) | ((r32 & 8) >> 1);
    const int j0 = c >= 8 ? c - 8 : 0;
    const float* rb = relb + head * 320;
    for (int qh = 0; qh < 2; ++qh) {
        const size_t qrow = (size_t)b * SEQ + c * 64 + qh * 32 + r32; const int qpos = c * 64 + qh * 32 + r32;
        bf16x8 qf[4];
#pragma unroll
        for (int ks = 0; ks < 4; ++ks) qf[ks] = *(const GAS bf16x8*)(AQK + qrow * 1024 + head * 64 + ks * 16 + hi * 8);
        f32x16 o0 = {}, o1 = {}; float mrun = -1e30f, lsum = 0.f;
        for (int j = j0; j <= c; ++j) {
            f32x16 s0 = {}, s1 = {};
            { const bf16* kp = AQK + ((size_t)b * SEQ + j * 64 + kap) * 1024 + 512 + head * 64 + hi * 8;
#pragma unroll
              for (int ks = 0; ks < 4; ++ks) { const bf16x8 k0 = *(const GAS bf16x8*)(kp + ks * 16), k1 = *(const GAS bf16x8*)(kp + 32 * 1024 + ks * 16);
                  s0 = MFMA32(k0, qf[ks], s0); s1 = MFMA32(k1, qf[ks], s1); } }
            float mx = -1e30f;
#pragma unroll
            for (int r = 0; r < 16; ++r) { const int kpos = j * 64 + (r & 3) + 4 * ((r >> 2) & 1) + 8 * hi + 16 * (r >> 3);
                int d0 = qpos - kpos, d1 = d0 - 32; d0 = d0 < -63 ? -63 : (d0 > 256 ? 256 : d0); d1 = d1 < -63 ? -63 : (d1 > 256 ? 256 : d1);
                s0[r] += rb[d0 + 63] * LOG2E; s1[r] += rb[d1 + 63] * LOG2E; mx = fmaxf(mx, fmaxf(s0[r], s1[r])); }
            mx = fmaxf(mx, __shfl_xor(mx, 32));
            const float mnew = fmaxf(mrun, mx), al = __builtin_amdgcn_exp2f(mrun - mnew); mrun = mnew;
            float ps = 0.f;
#pragma unroll
            for (int r = 0; r < 16; ++r) { s0[r] = __builtin_amdgcn_exp2f(s0[r] - mnew); s1[r] = __builtin_amdgcn_exp2f(s1[r] - mnew); ps += s0[r] + s1[r]; }
            lsum = lsum * al + ps;
#pragma unroll
            for (int r = 0; r < 16; ++r) { o0[r] *= al; o1[r] *= al; }
            const bf16* vp = AVT + ((size_t)(head * 64 + r32)) * M + (size_t)b * SEQ + j * 64 + 8 * hi;
#pragma unroll
            for (int kb = 0; kb < 2; ++kb)
#pragma unroll
                for (int s2 = 0; s2 < 2; ++s2) { const f32x16& sv = kb ? s1 : s0; pg8::u32x4 pw;
                    pw.x = pg8::cvt_pk_bf16(sv[8 * s2 + 0], sv[8 * s2 + 1]); pw.y = pg8::cvt_pk_bf16(sv[8 * s2 + 2], sv[8 * s2 + 3]);
                    pw.z = pg8::cvt_pk_bf16(sv[8 * s2 + 4], sv[8 * s2 + 5]); pw.w = pg8::cvt_pk_bf16(sv[8 * s2 + 6], sv[8 * s2 + 7]);
                    const bf16x8 pf = __builtin_bit_cast(bf16x8, pw);
                    const bf16x8 v0 = *(const GAS bf16x8*)(vp + kb * 32 + s2 * 16), v1 = *(const GAS bf16x8*)(vp + (size_t)32 * M + kb * 32 + s2 * 16);
                    o0 = MFMA32(v0, pf, o0); o1 = MFMA32(v1, pf, o1); }
        }
        lsum += __shfl_xor(lsum, 32);
        const float rl = 1.0f / lsum;
        bf16* yp = YA + qrow * 512 + head * 64 + 4 * hi;
#pragma unroll
        for (int g4 = 0; g4 < 4; ++g4) {
            u32x2e w0, w1; w0.x = pg8::cvt_pk_bf16(o0[4 * g4] * rl, o0[4 * g4 + 1] * rl); w0.y = pg8::cvt_pk_bf16(o0[4 * g4 + 2] * rl, o0[4 * g4 + 3] * rl);
            w1.x = pg8::cvt_pk_bf16(o1[4 * g4] * rl, o1[4 * g4 + 1] * rl); w1.y = pg8::cvt_pk_bf16(o1[4 * g4 + 2] * rl, o1[4 * g4 + 3] * rl);
            *(GAS u32x2e*)(yp + 8 * g4) = w0; *(GAS u32x2e*)(yp + 32 + 8 * g4) = w1; }
    }
}
__device__ __forceinline__ void comb_row(size_t row, const bf16* CO, const float* subg, float lamv, float oml, bf16* YC, int lane) {
    const pg8::u32x4 a = *(const GAS pg8::u32x4*)(CO + row * 1024 + 16 * lane), bq = *(const GAS pg8::u32x4*)(CO + row * 1024 + 16 * lane + 8);
    float v[16]; const unsigned w[8] = {a.x, a.y, a.z, a.w, bq.x, bq.y, bq.z, bq.w};
#pragma unroll
    for (int i = 0; i < 8; ++i) { v[2 * i] = __uint_as_float(w[i] << 16); v[2 * i + 1] = __uint_as_float(w[i] & 0xffff0000u); }
    float ss = 0.f;
#pragma unroll
    for (int i = 0; i < 16; ++i) { const float o2 = __shfl_xor(v[i], 8); v[i] = v[i] - lamv * o2; ss += v[i] * v[i]; }
    ss += __shfl_xor(ss, 1); ss += __shfl_xor(ss, 2); ss += __shfl_xor(ss, 4);
    const float rs = 1.0f / sqrtf(ss * (1.0f / 128.0f) + LN_EPS) * oml;
    if ((lane & 8) == 0) { const int h = lane >> 4, e0 = (lane & 7) * 16;
        unsigned ow[8];
#pragma unroll
        for (int i = 0; i < 8; ++i) ow[i] = pk2(v[2 * i] * rs * subg[e0 + 2 * i], v[2 * i + 1] * rs * subg[e0 + 2 * i + 1]);
        bf16* yp = YC + row * 512 + h * 128 + e0;
        *(GAS pg8::u32x4*)yp = (pg8::u32x4){ow[0], ow[1], ow[2], ow[3]}; *(GAS pg8::u32x4*)(yp + 8) = (pg8::u32x4){ow[4], ow[5], ow[6], ow[7]}; }
}
__device__ __forceinline__ void ln_row(const float* yrow, const float* g, const float* bta, float* hf, bf16* hb, float* dbg, int lane) {
    const GAS f32x4* xr = (const GAS f32x4*)yrow + lane;
    f32x4 v[4]; float s = 0.f;
#pragma unroll
    for (int j = 0; j < 4; ++j) { v[j] = xr[64 * j]; s += (v[j].x + v[j].y) + (v[j].z + v[j].w); }
    const float mean = wave_sum(s) * (1.f / D); float s2 = 0.f;
#pragma unroll
    for (int j = 0; j < 4; ++j) { v[j] = v[j] - mean; s2 += (v[j].x * v[j].x + v[j].y * v[j].y) + (v[j].z * v[j].z + v[j].w * v[j].w); }
    const float rstd = 1.f / sqrtf(wave_sum(s2) * (1.f / D) + LN_EPS);
#pragma unroll
    for (int j = 0; j < 4; ++j) { const f32x4 gg = *(const GAS f32x4*)(g + 4 * lane + 256 * j), bb = *(const GAS f32x4*)(bta + 4 * lane + 256 * j);
        const f32x4 o = v[j] * rstd * gg + bb;
        *((GAS f32x4*)hf + lane + 64 * j) = o; if (dbg) *((GAS f32x4*)dbg + lane + 64 * j) = o;
        *((GAS unsigned long long*)hb + lane + 64 * j) = (unsigned long long)pk2(o.x, o.y) | ((unsigned long long)pk2(o.z, o.w) << 32); }
}
__device__ __forceinline__ unsigned ordkey(float f) { unsigned u = __float_as_uint(f); return u ^ ((unsigned)((int)u >> 31) | 0x80000000u); }
__device__ __forceinline__ float ordval(unsigned k) { return __uint_as_float(k ^ ((k & 0x80000000u) ? 0x80000000u : 0xffffffffu)); }
#define INS16(L, x) do { _Pragma("unroll") for (int i_ = 0; i_ < 16; ++i_) { const unsigned h_ = L[i_] > x ? L[i_] : x; x = L[i_] > x ? x : L[i_]; L[i_] = h_; } } while (0)
__device__ __forceinline__ void topk_unit(int unit, const bf16* PQ, const bf16* SUBK, int* EIDX, float* EG, LAS unsigned* wl  , int lane) {
    const int tt = unit >> 3, hh = unit & 7, r32 = lane & 31, hi = lane >> 5;
    const size_t trow = (size_t)tt * 32 + r32;
    unsigned S[2][16];
#pragma unroll
    for (int p = 0; p < 2; ++p) {
        bf16x8 qf[8];
#pragma unroll
        for (int ks = 0; ks < 8; ++ks) qf[ks] = *(const GAS bf16x8*)(PQ + trow * 2048 + (hh * 2 + p) * 128 + ks * 16 + hi * 8);
        unsigned L[16];
#pragma unroll
        for (int i = 0; i < 16; ++i) L[i] = 0u;
        const bf16* kb = SUBK + (size_t)((hh * 2 + p) * 128 + r32) * 128 + hi * 8;
#pragma unroll
        for (int rt = 0; rt < 4; ++rt) { f32x16 acc = {}; const bf16* kr = kb + (size_t)rt * 32 * 128; asm volatile("" : "+v"(kr));
#pragma unroll
            for (int ks = 0; ks < 8; ++ks) { const bf16x8 kf = *(const GAS bf16x8*)(kr + ks * 16); acc = MFMA32(kf, qf[ks], acc); }
#pragma unroll
            for (int r = 0; r < 16; ++r) { const int n = rt * 32 + (r & 3) + 8 * (r >> 2) + 4 * hi; unsigned x = (ordkey(acc[r]) & ~127u) | (unsigned)n; INS16(L, x); }
            asm volatile("" ::: "memory"); }
        unsigned Mx[16];
#pragma unroll
        for (int i = 0; i < 16; ++i) { const unsigned o = (unsigned)__shfl_xor((int)L[15 - i], 32); Mx[i] = L[i] > o ? L[i] : o; }
#pragma unroll
        for (int st = 8; st >= 1; st >>= 1)
#pragma unroll
            for (int i = 0; i < 16; ++i) if ((i & st) == 0) { const unsigned a = Mx[i], b2 = Mx[i + st]; Mx[i] = a > b2 ? a : b2; Mx[i + st] = a > b2 ? b2 : a; }
#pragma unroll
        for (int i = 0; i < 16; ++i) { S[p][i] = Mx[i]; wl[(p * 16 + i) * 64 + lane] = Mx[i]; }
    }
    unsigned F[16];
#pragma unroll
    for (int i = 0; i < 16; ++i) F[i] = 0u;
#pragma unroll
    for (int i = 0; i < 16; ++i)
#pragma unroll
        for (int j = 0; j < 16; ++j) if ((i + 1) * (j + 1) <= 16) { const float sm = ordval(S[0][i] & ~127u) + ordval(S[1][j] & ~127u); unsigned x = (ordkey(sm) & ~255u) | (unsigned)(i * 16 + j); INS16(F, x); }
    LDS_WAIT();
    float fs[16]; int ex[16]; float mx = -1e30f;
#pragma unroll
    for (int k = 0; k < 16; ++k) { const int i = (F[k] >> 4) & 15, j = F[k] & 15; const unsigned k0 = wl[i * 64 + lane], k1 = wl[(16 + j) * 64 + lane];
        fs[k] = ordval(k0 & ~127u) + ordval(k1 & ~127u); ex[k] = (int)((k0 & 127u) * 128u + (k1 & 127u)); mx = fmaxf(mx, fs[k]); }
    float sum = 0.f;
#pragma unroll
    for (int k = 0; k < 16; ++k) { fs[k] = __builtin_amdgcn_exp2f((fs[k] - mx) * LOG2E); sum += fs[k]; }
    const float rs = 1.0f / sum;
    if (hi == 0) { int* ep = EIDX + (trow * 8 + hh) * 16; float* gp = EG + (trow * 8 + hh) * 16;
#pragma unroll
        for (int q4 = 0; q4 < 4; ++q4) { *(GAS i32x4e*)(ep + 4 * q4) = (i32x4e){ex[4 * q4], ex[4 * q4 + 1], ex[4 * q4 + 2], ex[4 * q4 + 3]};
            *(GAS f32x4*)(gp + 4 * q4) = (f32x4){fs[4 * q4] * rs, fs[4 * q4 + 1] * rs, fs[4 * q4 + 2] * rs, fs[4 * q4 + 3] * rs}; } }
    LDS_WAIT();
}
__device__ __forceinline__ void deq16(const pg8::u32x4 w, float (&f)[16]) {
    const unsigned ww[4] = {w.x, w.y, w.z, w.w};
#pragma unroll
    for (int j = 0; j < 4; ++j) { const f32x2q a = __builtin_amdgcn_cvt_pk_f32_fp8((int)ww[j], false), b = __builtin_amdgcn_cvt_pk_f32_fp8((int)ww[j], true); f[4 * j] = a.x; f[4 * j + 1] = a.y; f[4 * j + 2] = b.x; f[4 * j + 3] = b.y; }
}
__device__ __forceinline__ void peer_row(size_t t, const float* hin, const int* EIDX, const float* EG, const unsigned char* U, const unsigned char* V, const float* SU, const float* SV,
                                         const float* g2, const float* b2, float* hf, bf16* hb, int lane) {
    float x[16];
#pragma unroll
    for (int j = 0; j < 4; ++j) { const f32x4 v = *(const GAS f32x4*)(hin + t * 1024 + 16 * lane + 4 * j); x[4 * j] = v.x; x[4 * j + 1] = v.y; x[4 * j + 2] = v.z; x[4 * j + 3] = v.w; }
    float o[16];
#pragma unroll
    for (int i = 0; i < 16; ++i) o[i] = 0.f;
    const int ei0 = EIDX[t * 128 + lane], ei1 = EIDX[t * 128 + 64 + lane];
    const float gs0 = EG[t * 128 + lane] * SV[ei0], gs1 = EG[t * 128 + 64 + lane] * SV[ei1];
    const float su0 = SU[ei0], su1 = SU[ei1];
    const int b5 = lane >> 5, b4 = (lane >> 4) & 1, b3 = (lane >> 3) & 1, b2_ = (lane >> 2) & 1, eloc = b5 * 8 + b4 * 4 + b3 * 2 + b2_;
    for (int grp = 0; grp < 8; ++grp) {
        const int src = grp < 4 ? ei0 : ei1; const float gsrc = grp < 4 ? gs0 : gs1, susrc = grp < 4 ? su0 : su1; const int l0 = (grp & 3) * 16;
        pg8::u32x4 ua[16], va[16];
#pragma unroll
        for (int e = 0; e < 16; ++e) { const int idx = __builtin_amdgcn_readlane(src, l0 + e); ua[e] = *(const GAS pg8::u32x4*)(U + (size_t)idx * 1024 + 16 * lane); va[e] = *(const GAS pg8::u32x4*)(V + (size_t)idx * 1024 + 16 * lane); }
        float p[16];
#pragma unroll
        for (int e = 0; e < 16; ++e) { float f[16]; deq16(ua[e], f); float a = 0.f;
#pragma unroll
            for (int i = 0; i < 16; ++i) a += f[i] * x[i];
            p[e] = a; }
        float q8[8], q4[4], q2[2], s;
#pragma unroll
        for (int i = 0; i < 8; ++i) { const float keep = b5 ? p[i + 8] : p[i], send = b5 ? p[i] : p[i + 8]; q8[i] = keep + __shfl_xor(send, 32); }
#pragma unroll
        for (int i = 0; i < 4; ++i) { const float keep = b4 ? q8[i + 4] : q8[i], send = b4 ? q8[i] : q8[i + 4]; q4[i] = keep + __shfl_xor(send, 16); }
#pragma unroll
        for (int i = 0; i < 2; ++i) { const float keep = b3 ? q4[i + 2] : q4[i], send = b3 ? q4[i] : q4[i + 2]; q2[i] = keep + __shfl_xor(send, 8); }
        { const float keep = b2_ ? q2[1] : q2[0], send = b2_ ? q2[0] : q2[1]; s = keep + __shfl_xor(send, 4); }
        s += __shfl_xor(s, 2); s += __shfl_xor(s, 1);
        const float w = gelu_tanh(s * __shfl(susrc, l0 + eloc)) * __shfl(gsrc, l0 + eloc);
#pragma unroll
        for (int e = 0; e < 16; ++e) { const float we = __builtin_bit_cast(float, __builtin_amdgcn_readlane(__builtin_bit_cast(int, w), e * 4)); float f[16]; deq16(va[e], f);
#pragma unroll
            for (int i = 0; i < 16; ++i) o[i] += we * f[i]; }
    }
    float y[16]; float sm = 0.f;
#pragma unroll
    for (int i = 0; i < 16; ++i) { y[i] = ALPHA * x[i] + o[i]; sm += y[i]; }
    const float mean = wave_sum(sm) * (1.f / D); float s2 = 0.f;
#pragma unroll
    for (int i = 0; i < 16; ++i) { y[i] -= mean; s2 += y[i] * y[i]; }
    const float rstd = 1.f / sqrtf(wave_sum(s2) * (1.f / D) + LN_EPS);
    unsigned ow[8];
#pragma unroll
    for (int j = 0; j < 4; ++j) { const f32x4 gg = *(const GAS f32x4*)(g2 + 16 * lane + 4 * j), bb = *(const GAS f32x4*)(b2 + 16 * lane + 4 * j);
        f32x4 ov; ov.x = y[4 * j] * rstd * gg.x + bb.x; ov.y = y[4 * j + 1] * rstd * gg.y + bb.y; ov.z = y[4 * j + 2] * rstd * gg.z + bb.z; ov.w = y[4 * j + 3] * rstd * gg.w + bb.w;
        *(GAS f32x4*)(hf + t * 1024 + 16 * lane + 4 * j) = ov; ow[2 * j] = pk2(ov.x, ov.y); ow[2 * j + 1] = pk2(ov.z, ov.w); }
    *(GAS pg8::u32x4*)(hb + t * 1024 + 16 * lane) = (pg8::u32x4){ow[0], ow[1], ow[2], ow[3]}; *(GAS pg8::u32x4*)(hb + t * 1024 + 16 * lane + 8) = (pg8::u32x4){ow[4], ow[5], ow[6], ow[7]};
}
#if MK_DEBUG
struct Args;
#define DBG_WORDS 64
__device__ __forceinline__ unsigned dh(unsigned x) { x ^= x >> 16; x *= 0x7feb352dU; x ^= x >> 15; x *= 0x846ca68bU; x ^= x >> 16; return x; }
__device__ __forceinline__ void dbg_rec(unsigned* slot, float got, float want, float fl) {
    float e = fabsf(got - want) / (fabsf(want) + fl); if (!(e == e) || e > 1e30f) e = 1e30f; atomicMax(slot, __float_as_uint(e));
}
__device__ __forceinline__ float dbf(const bf16* p, size_t i) { return bf2f(p[i]); }
__device__ __forceinline__ float rbf(float x) { return bf2f((bf16)f2bf(x)); }
__device__ __forceinline__ float dsig(float x) { return 1.0f / (1.0f + expf(-x)); }
__device__ __forceinline__ float dgelu(float x) { return 0.5f * x * (1.0f + tanhf(0.7978845608028654f * (x + 0.044715f * x * x * x))); }
__device__ __forceinline__ float dq8(const unsigned char* p, size_t i) { const int w = *(const int*)(p + (i & ~(size_t)3)); const int b = (int)(i & 3); return b == 0 ? __builtin_amdgcn_cvt_f32_fp8(w, 0) : b == 1 ? __builtin_amdgcn_cvt_f32_fp8(w, 1) : b == 2 ? __builtin_amdgcn_cvt_f32_fp8(w, 2) : __builtin_amdgcn_cvt_f32_fp8(w, 3); }
struct DArgs { const void* in[24]; float* out; unsigned char* ws; float invf[32]; int p, pad; };
#define DW(T, off) ((T*)(a.ws + (off)))
__global__ void __launch_bounds__(256) dbg_kernel(DArgs a) {
    __shared__ float sh[1024 + 256 + 64];
    const int p = a.p, l = p == 0 ? 0 : (p - 1) / 10, q = p == 0 ? 100 : (p - 1) % 10, tid = threadIdx.x;
    unsigned* slot = DW(unsigned, WS_MISC) + 16 + p;
    const unsigned sid = blockIdx.x * 256 + tid; unsigned r = dh(sid * 2654435761u + 77u * p + 1u);
#define RND(n) ((r = dh(r + 0x9e3779b9u)) % (unsigned)(n))
    const bf16* WINl = DW(bf16, WS_WIN) + (size_t)l * INC * 1024;
    if (q == 100) {
        { const int ll = RND(2), n = RND(INC), k = RND(1024); int dn = n; if (n >= 2560 && n < 3584) dn = (n & ~63) + 2 * (n & 31) + ((n >> 5) & 1);
          dbg_rec(slot, dbf(DW(bf16, WS_WIN), ((size_t)ll * INC + dn) * 1024 + k), rbf(((const float*)a.in[2])[((size_t)ll * 1024 + k) * INC + n]), 1e-3f); }
        { const int qq = RND(6), n = RND(1024), k = RND(512); dbg_rec(slot, dbf(DW(bf16, WS_WBR), ((size_t)qq * 1024 + n) * 512 + k), rbf(((const float*)a.in[14])[((size_t)qq * 512 + k) * 1024 + n]), 1e-3f); }
        { const int ll = RND(2), n = RND(1024), k = RND(1024); dbg_rec(slot, dbf(DW(bf16, WS_WOUT), ((size_t)ll * 1024 + n) * 1024 + k), rbf(((const float*)a.in[15])[((size_t)ll * 1024 + k) * 1024 + n]), 1e-3f); }
        { const int ll = RND(2), n = RND(2048), k = RND(1024); dbg_rec(slot, dbf(DW(bf16, WS_WQ), ((size_t)ll * 2048 + n) * 1024 + k), rbf(((const float*)a.in[18])[((size_t)ll * 1024 + k) * 2048 + n]), 1e-3f); }
        { const size_t i = RND(524288); dbg_rec(slot, dbf(DW(bf16, WS_SUBK), i), rbf(((const float*)a.in[19])[i]), 1e-3f); }
        { const size_t i = (size_t)RND(16384) * 1024 + RND(1024); const size_t i2 = i + (size_t)RND(2) * 16384 * 1024; dbg_rec(slot, dq8(DW(unsigned char, WS_U), i2) * DW(float, WS_SU)[i2 >> 10], ((const float*)a.in[20])[i2], 0.01f); dbg_rec(slot, dq8(DW(unsigned char, WS_V), i2) * DW(float, WS_SV)[i2 >> 10], ((const float*)a.in[21])[i2], 0.1f);
          dbg_rec(slot, dbf(DW(bf16, WS_HB), i), rbf(((const float*)a.in[0])[i]), 1e-3f); }
        { const int row = RND(M), fi = RND(32); const float ang = (float)((const int*)a.in[1])[row] * a.invf[fi]; const double rev = (double)ang * 0.15915494309189535; const float fr = (float)(rev - rint(rev)) * 6.283185307179586f;
          dbg_rec(slot, DW(float, WS_ROPEC)[row * 32 + fi], cosf(fr), 0.05f); dbg_rec(slot, DW(float, WS_ROPES)[row * 32 + fi], sinf(fr), 0.05f); }
        { const int i = RND(131072); const int k = i & 63, j = (i >> 6) & 63, g = (i >> 12) & 7, gate = (i >> 15) & 1, ll = i >> 16;
          dbg_rec(slot, dbf(DW(bf16, WS_LRUW), i), rbf(((const float*)a.in[gate ? 9 : 7])[((size_t)(ll * 8 + g) * 64 + k) * 64 + j]), 1e-3f); }
    } else if (q == 0) {
        const int row = RND(M); int c = RND(INC) & ~1;
        const bf16* hb = DW(bf16, WS_HB) + (size_t)row * 1024; float z0 = 0.f, z1 = 0.f;
        for (int k = 0; k < 1024; ++k) { const float h = bf2f(hb[k]); z0 += h * dbf(WINl, (size_t)c * 1024 + k); z1 += h * dbf(WINl, (size_t)(c + 1) * 1024 + k); }
        float g0, g1; const float C2S = 0.125f * LOG2E;
        if (c < 512) { g0 = dbf(DW(bf16, WS_AQK), (size_t)row * 1024 + c); g1 = dbf(DW(bf16, WS_AQK), (size_t)row * 1024 + c + 1); z0 *= C2S; z1 *= C2S; }
        else if (c < 1024) { g0 = dbf(DW(bf16, WS_AQK), (size_t)row * 1024 + c); g1 = dbf(DW(bf16, WS_AQK), (size_t)row * 1024 + c + 1); }
        else if (c < 1536) { g0 = dbf(DW(bf16, WS_AVT), (size_t)(c - 1024) * M + row); g1 = dbf(DW(bf16, WS_AVT), (size_t)(c - 1023) * M + row); }
        else if (c < 2560) { g0 = dbf(DW(bf16, WS_BXG), (size_t)row * 1024 + c - 1536); g1 = dbf(DW(bf16, WS_BXG), (size_t)row * 1024 + c - 1535); }
        else if (c < 3584) { const int i = (c & 63) >> 1; const float cs = DW(float, WS_ROPEC)[row * 32 + i], sn = DW(float, WS_ROPES)[row * 32 + i]; const float sc = c < 3072 ? C2S : 1.f;
            const float o0 = (z0 * cs - z1 * sn) * sc, o1 = (z1 * cs + z0 * sn) * sc; z0 = o0; z1 = o1;
            g0 = dbf(DW(bf16, WS_CQK), (size_t)row * 1024 + c - 2560); g1 = dbf(DW(bf16, WS_CQK), (size_t)row * 1024 + c - 2559); }
        else if (c < 4096) { g0 = dbf(DW(bf16, WS_CV), (size_t)row * 512 + c - 3584); g1 = dbf(DW(bf16, WS_CV), (size_t)row * 512 + c - 3583); }
        else { const float* gb = (const float*)a.in[3] + l * 3072; z0 = dsig(z0 + gb[c - 4096]); z1 = dsig(z1 + gb[c - 4095]); g0 = dbf(DW(bf16, WS_GATES), (size_t)row * 3072 + c - 4096); g1 = dbf(DW(bf16, WS_GATES), (size_t)row * 3072 + c - 4095); }
        { const int sec = c < 512 ? 0 : c < 1024 ? 1 : c < 1536 ? 2 : c < 2560 ? 3 : c < 3072 ? 4 : c < 3584 ? 5 : c < 4096 ? 6 : 7; unsigned* s2 = DW(unsigned, WS_MISC) + 40 + sec; if (l == 0) { dbg_rec(s2, g0, z0, 0.05f); dbg_rec(s2, g1, z1, 0.05f); if (sec == 7) { unsigned* s3 = DW(unsigned, WS_MISC) + 48 + (c - 4096) / 256; dbg_rec(s3, g0, z0, 0.05f); dbg_rec(s3, g1, z1, 0.05f); } } }
        dbg_rec(slot, g0, z0, 0.05f); dbg_rec(slot, g1, z1, 0.05f);
    } else if (q == 1) {
        if (blockIdx.x < 16) {
        const int row = RND(M), ch = RND(512), b = row >> 13, s = row & 8191, t0 = s & ~63, g = ch >> 6, j = ch & 63;
        const bf16* bxg = DW(bf16, WS_BXG); const float* cw = (const float*)a.in[5] + l * 2048; const float* cb = (const float*)a.in[6] + l * 512;
        const bf16* wr = DW(bf16, WS_LRUW) + (size_t)(((l * 2 + 0) * 8 + g) * 64 + j) * 64; const bf16* wi = DW(bf16, WS_LRUW) + (size_t)(((l * 2 + 1) * 8 + g) * 64 + j) * 64;
        const float lm = ((const float*)a.in[11])[l * 512 + ch], ls8 = -8.0f * log1pf(expf(-lm));
        float h = 0.f, pp = 1.f;
        for (int t = t0; t <= s; ++t) { float ar = ((const float*)a.in[8])[(l * 8 + g) * 64 + j], ai = ((const float*)a.in[10])[(l * 8 + g) * 64 + j], xcm = 0.f;
            for (int k = 0; k < 64; ++k) { const int c2 = g * 64 + k; float xc = cb[c2];
                for (int tap = 0; tap < 4; ++tap) { const int tt = t - 3 + tap; if (tt >= 0) xc += dbf(bxg, ((size_t)b * SEQ + tt) * 1024 + c2) * cw[tap * 512 + c2]; }
                if (k == j) xcm = xc; const float xb = rbf(xc); ar += xb * bf2f(wr[k]); ai += xb * bf2f(wi[k]); }
            const float rg = dsig(ar), ig = dsig(ai), la = rg * ls8, av = expf(la), u = sqrtf(-expm1f(2.f * la)) * (ig * xcm); h = av * h + u; pp *= av; }
        dbg_rec(slot, DW(float, WS_HL)[(size_t)row * 512 + ch], h, 0.02f); dbg_rec(slot, DW(float, WS_PP)[(size_t)row * 512 + ch], pp, 0.02f); }
    } else if (q == 2) {
        if (blockIdx.x < 8) {
            const int row = RND(M), head = RND(8), d = RND(64), b = row >> 13, s = row & 8191, c = s >> 6, j0 = c >= 8 ? c - 8 : 0;
            const bf16* aqk = DW(bf16, WS_AQK); const bf16* avt = DW(bf16, WS_AVT); const float* rb = (const float*)a.in[4] + (l * 8 + head) * 320;
            float mx = -1e30f;
            for (int pass = 0; pass < 2; ++pass) { float den = 0.f, num = 0.f;
                for (int kp = j0 * 64; kp < (c + 1) * 64; ++kp) { float sc = 0.f; for (int k = 0; k < 64; ++k) sc += dbf(aqk, (size_t)row * 1024 + head * 64 + k) * dbf(aqk, ((size_t)b * SEQ + kp) * 1024 + 512 + head * 64 + k);
                    int dist = s - kp; dist = dist < -63 ? -63 : (dist > 256 ? 256 : dist); sc = sc / LOG2E + rb[dist + 63];
                    if (pass == 0) mx = fmaxf(mx, sc); else { const float e = expf(sc - mx); den += e; num += e * dbf(avt, (size_t)(head * 64 + d) * M + (size_t)b * SEQ + kp); } }
                if (pass == 1) dbg_rec(slot, dbf(DW(bf16, WS_YA), (size_t)row * 512 + head * 64 + d), num / den, 0.03f); }
        } else if (blockIdx.x < 24) {
            const int row = RND(M - 1) + 1, ch = RND(512), b = row >> 13, s = row & 8191, g = ch >> 6, j = ch & 63;
            if (s > 0) { const bf16* bxg = DW(bf16, WS_BXG); const float gp = dgelu(dbf(bxg, (size_t)(row - 1) * 1024 + 512 + ch)), gc = dgelu(dbf(bxg, (size_t)row * 1024 + 512 + ch));
              if (fabsf(gp) > 0.2f) { const float* cw = (const float*)a.in[5] + l * 2048; const float* cb = (const float*)a.in[6] + l * 512;
                const bf16* wr = DW(bf16, WS_LRUW) + (size_t)(((l * 2 + 0) * 8 + g) * 64 + j) * 64; const bf16* wi = DW(bf16, WS_LRUW) + (size_t)(((l * 2 + 1) * 8 + g) * 64 + j) * 64;
                const float lm = ((const float*)a.in[11])[l * 512 + ch], ls8 = -8.0f * log1pf(expf(-lm));
                float ar = ((const float*)a.in[8])[(l * 8 + g) * 64 + j], ai = ((const float*)a.in[10])[(l * 8 + g) * 64 + j], xcm = 0.f;
                for (int k = 0; k < 64; ++k) { const int c2 = g * 64 + k; float xc = cb[c2];
                    for (int tap = 0; tap < 4; ++tap) { const int tt = s - 3 + tap; if (tt >= 0) xc += dbf(bxg, ((size_t)b * SEQ + tt) * 1024 + c2) * cw[tap * 512 + c2]; }
                    if (k == j) xcm = xc; const float xb = rbf(xc); ar += xb * bf2f(wr[k]); ai += xb * bf2f(wi[k]); }
                const float la = dsig(ar) * ls8, av = expf(la), u = sqrtf(-expm1f(2.f * la)) * (dsig(ai) * xcm);
                const float hp = dbf(DW(bf16, WS_YB), (size_t)(row - 1) * 512 + ch) / gp;
                dbg_rec(slot, dbf(DW(bf16, WS_YB), (size_t)row * 512 + ch), (av * hp + u) * gc, 0.05f); } }
        } else if (blockIdx.x < 32) {
            const int row = RND(M), vj = RND(16), d = RND(64), b = row >> 13, s = row & 8191, kend = ((s >> 6) + 1) * 64;
            const int qcol = (vj >> 1) * 64, kcol = 512 + (vj >> 1) * 64, vcol = ((vj >> 2) * 2 + (vj & 1)) * 64;
            const bf16* cqk = DW(bf16, WS_CQK); const bf16* cv = DW(bf16, WS_CV);
            float mx = -1e30f;
            for (int pass = 0; pass < 2; ++pass) { float den = 0.f, num = 0.f;
                for (int kp = 0; kp < kend; ++kp) { float sc = 0.f; for (int k = 0; k < 64; ++k) sc += dbf(cqk, (size_t)row * 1024 + qcol + k) * dbf(cqk, ((size_t)b * SEQ + kp) * 1024 + kcol + k);
                    sc = sc / LOG2E;
                    if (pass == 0) mx = fmaxf(mx, sc); else { const float e = expf(sc - mx); den += e; num += e * dbf(cv, ((size_t)b * SEQ + kp) * 512 + vcol + d); } }
                if (pass == 1) dbg_rec(slot, dbf(DW(bf16, WS_CO), (size_t)row * 1024 + vj * 64 + d), num / den, 0.01f); }
        }
    } else if (q == 3) {
        const int row = RND(M), h = RND(4), e = RND(128); const bf16* co = DW(bf16, WS_CO) + (size_t)row * 1024; const float lamv = DW(float, WS_MISC)[l], oml = DW(float, WS_MISC)[2 + l];
        float ss = 0.f, oe = 0.f;
        for (int i = 0; i < 128; ++i) { const int vh = i >> 6, dd = i & 63; const float o = bf2f(co[(h * 4 + vh) * 64 + dd]) - lamv * bf2f(co[(h * 4 + 2 + vh) * 64 + dd]); ss += o * o; if (i == e) oe = o; }
        dbg_rec(slot, dbf(DW(bf16, WS_YC), (size_t)row * 512 + h * 128 + e), oe / sqrtf(ss / 128.f + LN_EPS) * ((const float*)a.in[13])[l * 128 + e] * oml, 0.02f);
        if (sid == 0) { const float* dl = (const float*)a.in[12] + l * 256; float s1 = 0.f, s2 = 0.f; for (int i = 0; i < 64; ++i) { s1 += dl[i] * dl[64 + i]; s2 += dl[128 + i] * dl[192 + i]; }
            const float li = 0.8f - 0.6f * expf(-0.3f * l); dbg_rec(slot, lamv, expf(s1) - expf(s2) + li, 1e-3f); dbg_rec(slot, oml, 1.f - li, 1e-3f); }
    } else if (q == 4) {
        const int row = RND(M), col = RND(1024); float tot = 0.f;
        for (int n = 0; n < 3; ++n) { const bf16* y = DW(bf16, n == 0 ? WS_YA : (n == 1 ? WS_YB : WS_YC)) + (size_t)row * 512; const bf16* w = DW(bf16, WS_WBR) + ((size_t)(l * 3 + n) * 1024 + col) * 512; float acc = 0.f;
            for (int k = 0; k < 512; ++k) acc += bf2f(y[k]) * bf2f(w[k]); tot += acc * dbf(DW(bf16, WS_GATES), (size_t)row * 3072 + n * 1024 + col); }
        dbg_rec(slot, dbf(DW(bf16, WS_MERGED), (size_t)row * 1024 + col), tot, 0.02f);
    } else if (q == 5) {
        const int row = RND(M), col = RND(1024); const bf16* mg = DW(bf16, WS_MERGED) + (size_t)row * 1024; const bf16* w = DW(bf16, WS_WOUT) + ((size_t)l * 1024 + col) * 1024; float acc = 0.f;
        for (int k = 0; k < 1024; ++k) acc += bf2f(mg[k]) * bf2f(w[k]);
        const float res = (l == 0 ? (const float*)a.in[0] : (const float*)a.out)[(size_t)row * 1024 + col];
        dbg_rec(slot, DW(float, WS_YF)[(size_t)row * 1024 + col], ALPHA * res + acc, 0.05f);
    } else if (q == 6) {
        const int row = RND(M), col = RND(1024); const float* y = DW(float, WS_YF) + (size_t)row * 1024; float mu = 0.f, var = 0.f;
        for (int k = 0; k < 1024; ++k) mu += y[k]; mu /= 1024.f; for (int k = 0; k < 1024; ++k) var += (y[k] - mu) * (y[k] - mu); var /= 1024.f;
        const float want = (y[col] - mu) / sqrtf(var + LN_EPS) * ((const float*)a.in[16])[l * 1024 + col] + ((const float*)a.in[17])[l * 1024 + col];
        dbg_rec(slot, a.out[(size_t)row * 1024 + col], want, 0.02f); dbg_rec(slot, dbf(DW(bf16, WS_HB), (size_t)row * 1024 + col), want, 0.05f);
    } else if (q == 7) {
        const int row = RND(M), col = RND(2048); const bf16* hb = DW(bf16, WS_HB) + (size_t)row * 1024; const bf16* w = DW(bf16, WS_WQ) + ((size_t)l * 2048 + col) * 1024; float acc = 0.f;
        for (int k = 0; k < 1024; ++k) acc += bf2f(hb[k]) * bf2f(w[k]);
        dbg_rec(slot, dbf(DW(bf16, WS_PQ), (size_t)row * 2048 + col), acc, 0.05f);
    } else if (q == 8) {
        unsigned rr = dh(blockIdx.x * 2654435761u + 977u * p + 5u); const int row = rr % M, hh = (rr >> 20) & 7;
        const bf16* pq = DW(bf16, WS_PQ) + (size_t)row * 2048 + hh * 256; const bf16* sk = DW(bf16, WS_SUBK) + (size_t)(l * 16 + hh * 2) * 128 * 128;
        { const int pp = tid >> 7, n = tid & 127; float acc = 0.f; for (int k = 0; k < 128; ++k) acc += bf2f(pq[pp * 128 + k]) * bf2f(sk[((size_t)pp * 128 + n) * 128 + k]); sh[tid] = acc; }
        __syncthreads();
        const int* ei = DW(int, WS_EIDX) + ((size_t)row * 8 + hh) * 16; const float* eg = DW(float, WS_EG) + ((size_t)row * 8 + hh) * 16;
        float fmin = 1e30f, fmax = -1e30f, gs = 0.f; for (int k = 0; k < 16; ++k) { const int e = ei[k]; const float f = sh[(e >> 7) & 127] + sh[128 + (e & 127)]; fmin = fminf(fmin, f); fmax = fmaxf(fmax, f); gs += eg[k]; }
        int cnt = 0; for (int i = tid; i < 16384; i += 256) cnt += (sh[i >> 7] + sh[128 + (i & 127)] > fmin + 2e-3f) ? 1 : 0;
        sh[512 + tid] = (float)cnt; __syncthreads();
        if (tid == 0) { float tot = 0.f; for (int i = 0; i < 256; ++i) tot += sh[512 + i]; dbg_rec(slot, tot > 15.5f ? 1.f : 0.f, 0.f, 1.f);
            dbg_rec(slot, gs, 1.f, 0.f); float den = 0.f; for (int k = 0; k < 16; ++k) { const int e = ei[k]; den += expf(sh[(e >> 7) & 127] + sh[128 + (e & 127)] - fmax); }
            for (int k = 0; k < 16; ++k) { const int e = ei[k]; dbg_rec(slot, eg[k], expf(sh[(e >> 7) & 127] + sh[128 + (e & 127)] - fmax) / den, 0.01f); }
            for (int k = 0; k < 16; ++k) for (int k2 = 0; k2 < k; ++k2) if (ei[k] == ei[k2]) dbg_rec(slot, 1.f, 0.f, 1.f); }
    } else if (q == 9) {
        unsigned rr = dh(blockIdx.x * 2654435761u + 31u * p + 9u); const int row = rr % M;
        const float* h1 = DW(float, WS_DBGH1) + (size_t)row * 1024; const int* ei = DW(int, WS_EIDX) + (size_t)row * 128; const float* eg = DW(float, WS_EG) + (size_t)row * 128;
        float y[4] = {0.f, 0.f, 0.f, 0.f};
        for (int e = 0; e < 128; ++e) { const size_t ex = (size_t)ei[e]; float part = 0.f; for (int k = tid; k < 1024; k += 256) part += h1[k] * dq8(DW(unsigned char, WS_U) + (size_t)l * 16384 * 1024, ex * 1024 + k);
            sh[tid] = part; __syncthreads(); if (tid < 64) { float s2 = sh[tid] + sh[tid + 64] + sh[tid + 128] + sh[tid + 192]; s2 = wave_sum(s2); if (tid == 0) sh[1024] = s2; } __syncthreads();
            const float w = eg[e] * dgelu(sh[1024] * DW(float, WS_SU)[l * 16384 + ex]) * DW(float, WS_SV)[l * 16384 + ex]; for (int i = 0; i < 4; ++i) y[i] += w * dq8(DW(unsigned char, WS_V) + (size_t)l * 16384 * 1024, ex * 1024 + tid + 256 * i); __syncthreads(); }
        float ps = 0.f; for (int i = 0; i < 4; ++i) { y[i] += ALPHA * h1[tid + 256 * i]; ps += y[i]; }
        sh[tid] = ps; __syncthreads(); if (tid == 0) { float t2 = 0.f; for (int i = 0; i < 256; ++i) t2 += sh[i]; sh[1025] = t2 / 1024.f; } __syncthreads(); const float mu = sh[1025];
        ps = 0.f; for (int i = 0; i < 4; ++i) ps += (y[i] - mu) * (y[i] - mu);
        __syncthreads(); sh[tid] = ps; __syncthreads(); if (tid == 0) { float t2 = 0.f; for (int i = 0; i < 256; ++i) t2 += sh[i]; sh[1026] = 1.f / sqrtf(t2 / 1024.f + LN_EPS); } __syncthreads();
        for (int i = 0; i < 4; ++i) { const int col = tid + 256 * i; dbg_rec(slot, a.out[(size_t)row * 1024 + col], (y[i] - mu) * sh[1026] * ((const float*)a.in[22])[l * 1024 + col] + ((const float*)a.in[23])[l * 1024 + col], 0.03f); }
    }
#undef RND
}
__global__ void dbg_scan(DArgs a) { const size_t i = (size_t)blockIdx.x * 256 + threadIdx.x; unsigned bad = 0; for (size_t j = i; j < (size_t)M * D; j += (size_t)gridDim.x * 256) { const float v = a.out[j]; if (!(v == v) || fabsf(v) > 1e30f) bad = 1; } if (bad) atomicMax(DW(unsigned, WS_MISC) + 15, 1u); }
__global__ void dbg_encode(DArgs a, float tol) {
    const unsigned* w = DW(unsigned, WS_MISC) + 16; int k = 0;
    for (int p = 0; p < 21; ++p) if (__uint_as_float(w[p]) > tol) { k = p + 1; break; }
    if (k == 2) { for (int s2 = 0; s2 < 8; ++s2) if (__uint_as_float(w[24 + s2]) > tol) { k = 50 + s2; break; } }
    if (k == 57) { int nf = 0, first = -1; for (int s3 = 0; s3 < 12; ++s3) if (__uint_as_float(w[32 + s3]) > tol) { ++nf; if (first < 0) first = s3; } k = 60 + first + 13 * (nf > 1 ? 1 : 0) + 13 * (nf == 12 ? 1 : 0); }
    if (k == 0 && DW(unsigned, WS_MISC)[15]) k = 40;
    if (k == 0) return;
    const float c = sqrtf((float)k);
    for (size_t j = (size_t)blockIdx.x * 256 + threadIdx.x; j < (size_t)M * D; j += (size_t)gridDim.x * 256) a.out[j] = c;
}
static void dbg_check(int p, const void* const* in, float* out, unsigned char* ws, const float* invf, hipStream_t stream) {
    DArgs d{}; for (int i = 0; i < 24; ++i) d.in[i] = in[i]; d.out = out; d.ws = ws; for (int i = 0; i < 32; ++i) d.invf[i] = invf[i]; d.p = p;
    hipLaunchKernelGGL(dbg_kernel, dim3(64), dim3(256), 0, stream, d);
}
static void dbg_final(const void* const* in, float* out, unsigned char* ws, hipStream_t stream) {
    DArgs d{}; for (int i = 0; i < 24; ++i) d.in[i] = in[i]; d.out = out; d.ws = ws; d.p = 0;
    hipLaunchKernelGGL(dbg_scan, dim3(1024), dim3(256), 0, stream, d);
    hipLaunchKernelGGL(dbg_encode, dim3(1024), dim3(256), 0, stream, d, 0.08f);
}
#endif
struct Args { const void* in[24]; float* out; unsigned char* ws; float invf[32]; int ph_lo, ph_hi, dbg, pad; };
constexpr int NPH = 1 + DEPTH * 10;

__global__ void __launch_bounds__(NWAVES * 64, 2) mk_fwd(Args args) {
    extern __shared__ __attribute__((aligned(16))) unsigned char lds[];
    LAS unsigned char* L = (LAS unsigned char*)lds;
    volatile LAS unsigned* MISC = (volatile LAS unsigned*)(L + MISC_OFF);
#define PH_IDS int tid = threadIdx.x; asm volatile("" : "+v"(tid)); const int lane = tid & 63, wave = __builtin_amdgcn_readfirstlane(tid >> 6); (void)lane; (void)wave;
    const int G = gridDim.x, bx = blockIdx.x, vcu = (G % 8 == 0) ? (bx % 8) * (G / 8) + bx / 8 : bx;
    gu32* ctl = (gu32*)(args.ws + WS_CTL);
    for (int u = threadIdx.x; u < (LDS_BYTES - LDSCTL_OFF) / 4; u += NWAVES * 64) ((LAS unsigned*)(L + LDSCTL_OFF))[u] = 0u;
    __syncthreads();
    XcdBarrier bar = xcd_barrier_post((unsigned*)(ctl + CW_BAR), MISC + 8);
    const int lo = args.ph_lo, hi = args.ph_hi;
#if MK_STAMP
    if (blockIdx.x == 0 && threadIdx.x == 0) ((unsigned long long*)(args.ws + WS_MISC + 1024))[0] = __builtin_amdgcn_s_memrealtime();
#endif
#ifndef MK_ONLYQ
#define MK_ONLYQ -1
#endif
#define IN(k) (lo <= (k) && (k) < hi)
#define INQ(q) ((MK_ONLYQ < 0 || MK_ONLYQ == (q)) && IN(pb + (q)))
#define REP(q) for (int rep_ = 0; rep_ < ((((MK_DUP) >> (q)) & 1) ? 2 : 1); ++rep_)
#if MK_STAMP
#define STAMP(k) do { if (blockIdx.x == 0 && threadIdx.x == 0) ((unsigned long long*)(args.ws + WS_MISC + 1024))[(k)] = __builtin_amdgcn_s_memrealtime(); } while (0)
#else
#define STAMP(k) do {} while (0)
#endif
#define SEAM(k) do { if (IN(k) && IN((k) + 1)) xcd_barrier(bar); STAMP((k) + 1); } while (0)
#define GT ((size_t)vcu * 512 + tid)
#define NGT ((size_t)G * 512)
#define GW (vcu * NWAVES + wave)
#define NGW (G * NWAVES)
#define WSP(T, off) ((T*)(args.ws + (off)))
#define x_in ((const float*)args.in[0])
#define WIN WSP(bf16, WS_WIN)
#define WBR WSP(bf16, WS_WBR)
#define WOUT WSP(bf16, WS_WOUT)
#define WQ WSP(bf16, WS_WQ)
#define SUBK WSP(bf16, WS_SUBK)
#define ROPEC WSP(float, WS_ROPEC)
#define ROPES WSP(float, WS_ROPES)
#define LRUW WSP(bf16, WS_LRUW)
#define MISCW WSP(float, WS_MISC)
#define UB WSP(unsigned char, WS_U)
#define VB WSP(unsigned char, WS_V)
#define SUB WSP(float, WS_SU)
#define SVB WSP(float, WS_SV)
#define HB WSP(bf16, WS_HB)
#define HL WSP(float, WS_HL)
#define PP WSP(float, WS_PP)
#define AQK WSP(bf16, WS_AQK)
#define AVT WSP(bf16, WS_AVT)
#define CQK WSP(bf16, WS_CQK)
#define CV WSP(bf16, WS_CV)
#define BXG WSP(bf16, WS_BXG)
#define GATES WSP(bf16, WS_GATES)
#define YA WSP(bf16, WS_YA)
#define YB WSP(bf16, WS_YB)
#define YC WSP(bf16, WS_YC)
#define CO WSP(bf16, WS_CO)
#define MERGEF WSP(float, WS_MERGEF)
#define MERGED WSP(bf16, WS_MERGED)
#define YF WSP(float, WS_YF)
#define PQ WSP(bf16, WS_PQ)
#define EIDX WSP(int, WS_EIDX)
#define EG WSP(float, WS_EG)
#define HF (args.out)
#define DBGH1 (args.dbg ? WSP(float, WS_DBGH1) : (float*)nullptr)

    if ((MK_ONLYQ < 0 || MK_ONLYQ == 100) && IN(0)) { PH_IDS
        LAS float* scr = (LAS float*)(L + RING_OFF + wave * 16384);
        constexpr int I_IN = 16 * 224, I_BR = 8 * 32, I_OUT = 16 * 32, I_Q = 16 * 64;
        constexpr int NITEMS = 2 * I_IN + 6 * I_BR + 2 * I_OUT + 2 * I_Q;
        for (int it = GW; it < NITEMS; it += NGW) {
            int r = it;
            if (r < 2 * I_IN) { const int l = r / I_IN; p0_transpose_item((const float*)args.in[2] + (size_t)l * 1024 * INC, 1024, INC, WIN + (size_t)l * INC * 1024, 2560, 3584, scr, r % I_IN, lane); continue; } r -= 2 * I_IN;
            if (r < 6 * I_BR) { const int q = r / I_BR; p0_transpose_item((const float*)args.in[14] + (size_t)q * 512 * 1024, 512, 1024, WBR + (size_t)q * 1024 * 512, 0, 0, scr, r % I_BR, lane); continue; } r -= 6 * I_BR;
            if (r < 2 * I_OUT) { const int l = r / I_OUT; p0_transpose_item((const float*)args.in[15] + (size_t)l * 1024 * 1024, 1024, 1024, WOUT + (size_t)l * 1024 * 1024, 0, 0, scr, r % I_OUT, lane); continue; } r -= 2 * I_OUT;
            { const int l = r / I_Q; p0_transpose_item((const float*)args.in[18] + (size_t)l * 1024 * 2048, 1024, 2048, WQ + (size_t)l * 2048 * 1024, 0, 0, scr, r % I_Q, lane); }
        }
        cvt_stream((const float*)args.in[19], SUBK, (size_t)2 * 8 * 2 * 128 * 128 / 8, GT, NGT);
        cvt_stream(x_in, HB, (size_t)M * D / 8, GT, NGT);
        for (int r = GW; r < 2 * 32768; r += NGW) { const int tsel = r >> 15, row = r & 32767;
            quant_row_fp8((const float*)args.in[tsel ? 21 : 20] + (size_t)row * 1024, (tsel ? VB : UB) + (size_t)row * 1024, (tsel ? SVB : SUB) + row, lane); }
        for (size_t i = GT; i < (size_t)2 * 2 * 8 * 4096; i += NGT) { const int k = i & 63, j = (i >> 6) & 63, g = (i >> 12) & 7, gate = (i >> 15) & 1, l = (int)(i >> 16);
            const float* w = (const float*)args.in[gate ? 9 : 7]; LRUW[i] = (bf16)f2bf(w[((size_t)(l * 8 + g) * 64 + k) * 64 + j]); }
        for (size_t i = GT; i < (size_t)M * 32; i += NGT) { const int row = (int)(i >> 5), fi = (int)(i & 31);
            const float ang = (float)((const int*)args.in[1])[row] * args.invf[fi];
            const double rev = (double)ang * 0.15915494309189535; const float fr = (float)(rev - __builtin_rint(rev));
            ROPEC[i] = __builtin_amdgcn_cosf(fr); ROPES[i] = __builtin_amdgcn_sinf(fr); }
        if (bx == 0 && tid < 2) { const float* dl = (const float*)args.in[12] + tid * 256; float s1 = 0.f, s2 = 0.f;
            for (int i = 0; i < 64; ++i) { s1 += dl[i] * dl[64 + i]; s2 += dl[128 + i] * dl[192 + i]; }
            const float li = tid == 0 ? 0.2f : 0.35550906759096926f;
            MISCW[tid] = expf(s1) - expf(s2) + li; MISCW[2 + tid] = 1.0f - li; }
    }
    SEAM(0);
    for (int l = 0; l < DEPTH; ++l) {
        const int pb = 1 + 10 * l;
        if (INQ(0)) REP(0) { PH_IDS
            { pg8::Gemm g{HB, WIN + (size_t)l * INC * 1024, M, INC, 1024}; pg8::InOrder S; S.init(G, bx);
              pg8::EpiIn E{AQK, BXG, CQK, CV, GATES, (const float*)args.in[3] + l * 3072, ROPEC, ROPES};
              pg8::gemm_phase<pg8::EpiIn, pg8::InOrder, PG8_ALIGN, PG8_SP2>(L + RING_OFF, g, S, E); }
            { pg8::Gemm g{WIN + (size_t)l * INC * 1024 + (size_t)1024 * 1024, HB, 512, M, 1024}; pg8::StaticOrder S; S.init(512, M, G, bx);
              pg8::EpiBf16<0> E{AVT, M, nullptr, 0, 0, 1.f};
              pg8::gemm_phase<pg8::EpiBf16<0>, pg8::StaticOrder, PG8_ALIGN, PG8_SP2>(L + RING_OFF, g, S, E); }
        }
        SEAM(pb + 0);
        if (INQ(1)) REP(1) { PH_IDS
            for (int u = vcu; u < 1024; u += G)
                b1_unit(l, u, L, BXG, LRUW, (const float*)args.in[5], (const float*)args.in[6], (const float*)args.in[8], (const float*)args.in[10], (const float*)args.in[11], HL, PP, tid, wave, lane);
        }
        SEAM(pb + 1);
        if (INQ(2)) REP(2) { PH_IDS
            for (int u = vcu; u < 256; u += G) band_unit(u, AQK, AVT, (const float*)args.in[4] + l * 8 * 320, YA, wave, lane);
            for (int u = vcu; u < 256; u += G) b3_unit(u, HL, PP, BXG, YB, tid);
            __syncthreads();
            const attn_body::AttnTensors AT{(const attn_body::bf16*)CQK, (const attn_body::bf16*)CQK, (const attn_body::bf16*)CV, (attn_body::bf16*)CO};
            const attn_body::StaticOrder S(G, bx);
            attn_body::attn_phase<attn_body::StaticOrder>((char*)lds + RING_OFF, AT, S);
        }
        SEAM(pb + 2);
        if (INQ(3)) REP(3) { PH_IDS
            const float lamv = MISCW[l], oml = MISCW[2 + l];
            for (int m = GW; m < M; m += NGW) comb_row((size_t)m, CO, (const float*)args.in[13] + l * 128, lamv, oml, YC, lane);
        }
        SEAM(pb + 3);
        if (INQ(4)) REP(4) { PH_IDS
            const bf16* wbr = WBR + (size_t)l * 3 * 1024 * 512;
            { pg8::Gemm g{YA, wbr, M, 1024, 512}; pg8::StaticOrder S; S.init(M, 1024, G, bx); pg8::EpiMerge<0> E{GATES, MERGEF, MERGED};
              pg8::gemm_phase<pg8::EpiMerge<0>, pg8::StaticOrder, false, PG8_SP2>(L + RING_OFF, g, S, E); }
            { pg8::Gemm g{YB, wbr + (size_t)1024 * 512, M, 1024, 512}; pg8::StaticOrder S; S.init(M, 1024, G, bx); pg8::EpiMerge<1> E{GATES, MERGEF, MERGED};
              pg8::gemm_phase<pg8::EpiMerge<1>, pg8::StaticOrder, false, PG8_SP2>(L + RING_OFF, g, S, E); }
            { pg8::Gemm g{YC, wbr + (size_t)2 * 1024 * 512, M, 1024, 512}; pg8::StaticOrder S; S.init(M, 1024, G, bx); pg8::EpiMerge<2> E{GATES, MERGEF, MERGED};
              pg8::gemm_phase<pg8::EpiMerge<2>, pg8::StaticOrder, false, PG8_SP2>(L + RING_OFF, g, S, E); }
        }
        SEAM(pb + 4);
        if (INQ(5)) REP(5) { PH_IDS
            pg8::Gemm g{MERGED, WOUT + (size_t)l * 1024 * 1024, M, 1024, 1024}; pg8::StaticOrder S; S.init(M, 1024, G, bx);
            pg8::EpiOut E{l == 0 ? x_in : HF, YF, ALPHA};
            pg8::gemm_phase<pg8::EpiOut, pg8::StaticOrder, false, PG8_SP2>(L + RING_OFF, g, S, E);
        }
        SEAM(pb + 5);
        if (INQ(6)) REP(6) { PH_IDS
            for (int m = GW; m < M; m += NGW) ln_row(YF + (size_t)m * D, (const float*)args.in[16] + l * D, (const float*)args.in[17] + l * D, HF + (size_t)m * D, HB + (size_t)m * D, args.dbg ? DBGH1 + (size_t)m * D : (float*)nullptr, lane);
        }
        SEAM(pb + 6);
        if (INQ(7)) REP(7) { PH_IDS
            pg8::Gemm g{HB, WQ + (size_t)l * 2048 * 1024, M, 2048, 1024}; pg8::StaticOrder S; S.init(M, 2048, G, bx);
            pg8::EpiBf16<0> E{PQ, 2048, nullptr, 0, 0, 1.f};
            pg8::gemm_phase<pg8::EpiBf16<0>, pg8::StaticOrder, PG8_ALIGN, PG8_SP2>(L + RING_OFF, g, S, E);
        }
        SEAM(pb + 7);
        if (INQ(8)) REP(8) { PH_IDS
            LAS unsigned* wl = (LAS unsigned*)(L + RING_OFF + wave * 8192);
            for (int u = GW; u < 4096; u += NGW) topk_unit(u, PQ, SUBK + (size_t)l * 8 * 2 * 128 * 128, EIDX, EG, wl, lane);
        }
        SEAM(pb + 8);
        if (INQ(9)) REP(9) { PH_IDS
            for (int m = GW; m < M; m += NGW) peer_row((size_t)m, HF, EIDX, EG, UB + (size_t)l * 16384 * 1024, VB + (size_t)l * 16384 * 1024, SUB + l * 16384, SVB + l * 16384, (const float*)args.in[22] + l * D, (const float*)args.in[23] + l * D, (((MK_DUP) >> 9) & 1) && rep_ == 0 ? WSP(float, WS_YF) : HF, (((MK_DUP) >> 9) & 1) && rep_ == 0 ? WSP(bf16, WS_GATES + 64 * MiB) : HB, lane);
        }
        SEAM(pb + 9);
    }
#undef IN
#undef INQ
#undef SEAM
}

#if MK_STAMP
__global__ void probe_encode(float* out, unsigned char* ws, unsigned maskA, unsigned maskB) {
    const unsigned long long* st = (const unsigned long long*)(ws + WS_MISC + 1024); float tA = 0.f;
    for (int p = 0; p < NPH; ++p) { const float d = (float)(st[p + 1] - st[p]) * 0.01f; if ((maskA >> p) & 1u) tA += d; }
    const float c = logf(tA + 1.f); (void)maskB;
    for (size_t j = (size_t)blockIdx.x * 256 + threadIdx.x; j < (size_t)M * D; j += (size_t)gridDim.x * 256) out[j] = c;
}
#endif
extern "C" void kernel_launch(void* const* d_in, const int* in_sizes, int n_in, void* d_out, int out_size, void* d_ws, size_t ws_size, hipStream_t stream) {
    static int grid = 0;
    if (grid == 0) {
        if (n_in != 24 || out_size != M * D || ws_size < WS_END) { fprintf(stderr, "kernel_launch: unexpected shapes (n_in %d out %d ws %zu)\n", n_in, out_size, ws_size); grid = -1; return; }
        int dev = 0, cus = 0;
        if (hipGetDevice(&dev) != hipSuccess || hipDeviceGetAttribute(&cus, hipDeviceAttributeMultiprocessorCount, dev) != hipSuccess) { grid = -1; return; }
        if (hipFuncSetAttribute((const void*)mk_fwd, hipFuncAttributeMaxDynamicSharedMemorySize, LDS_BYTES) != hipSuccess) { grid = -1; return; }
        (void)hipGetLastError();
        grid = cus;
        if (grid != 256) { fprintf(stderr, "kernel_launch: built for 256 CUs, found %d\n", cus); grid = -1; return; }
    }
    if (grid < 0) return;
    if (hipMemsetAsync((char*)d_ws + WS_CTL, 0, CTL_ZERO_BYTES, stream) != hipSuccess) return;
#if MK_DEBUG
    (void)hipMemsetAsync((char*)d_ws + WS_MISC + 60, 0, 196, stream);
#endif
    Args a{};
    for (int i = 0; i < 24; ++i) a.in[i] = d_in[i];
    a.out = (float*)d_out; a.ws = (unsigned char*)d_ws;
    for (int i = 0; i < 32; ++i) a.invf[i] = (float)pow(10000.0, -(double)(2 * i) / 64.0);
    a.dbg = MK_DEBUG;
#if MK_N_LAUNCHES == 1
    a.ph_lo = 0; a.ph_hi = NPH;
    hipLaunchKernelGGL(mk_fwd, dim3(grid), dim3(NWAVES * 64), LDS_BYTES, stream, a);
#if MK_STAMP
    hipLaunchKernelGGL(probe_encode, dim3(1024), dim3(256), 0, stream, (float*)d_out, (unsigned char*)d_ws, (unsigned)MK_STAMP_A, (unsigned)MK_STAMP_B);
#endif
#else
    for (int p = 0; p < NPH; ++p) { a.ph_lo = p; a.ph_hi = p + 1;
        hipLaunchKernelGGL(mk_fwd, dim3(grid), dim3(NWAVES * 64), LDS_BYTES, stream, a);
#if MK_DEBUG
        dbg_check(p, a.in, a.out, a.ws, a.invf, stream);
#endif
    }
#if MK_DEBUG
    dbg_final(a.in, a.out, a.ws, stream);
#endif
#endif
}
```

```cpp
#ifndef MK_N_LAUNCHES
#define MK_N_LAUNCHES 1
#endif
#ifndef MK_DEBUG
#define MK_DEBUG 0
#endif
#ifndef MK_STAMP
#define MK_STAMP 0
#endif
#ifndef MK_STAMP_A
#define MK_STAMP_A 0
#endif
#ifndef MK_STAMP_B
#define MK_STAMP_B 0
#endif
#ifndef MK_DUP
#define MK_DUP 0
#endif
#include <hip/hip_runtime.h>
#include <cstdio>
#include <cstdint>
namespace pg8 {
#define PG8_LAS __attribute__((address_space(3)))
typedef unsigned short bf16_t;
typedef short bf16x8 __attribute__((ext_vector_type(8)));
typedef float f32x4 __attribute__((ext_vector_type(4)));
typedef unsigned u32x4 __attribute__((ext_vector_type(4)));
constexpr int BM = 256, BK = 64, HALF = 128, HTB = HALF * BK * 2  , STAGE_BYTES = 8 * HTB, NXCD = 8, WGM = 8;

__host__ __device__ __forceinline__ int lds_byte(int r, int c) { const int st = (r >> 4) * 2 + (c >> 5), rr = r & 15, cc = c & 31, ob = rr * 64 + cc * 2; return st * 1024 + (ob ^ (((ob >> 9) & 1) << 5)); }
__host__ __device__ __forceinline__ void stage_rc(int b, int& R, int& C) { const int st = b / 1024, sb = b % 1024, swz = sb ^ (((sb >> 9) & 1) << 5); R = (st >> 1) * 16 + swz / 64; C = (st & 1) * 32 + (swz % 64) / 2; }
__host__ __device__ __forceinline__ int perm32(int rho) { const int n = rho >> 4, i = rho & 15; return 8 * (i >> 2) + 4 * n + (i & 3); }

struct Unit { int pm, pn; };
struct Gemm { const bf16_t* A; const bf16_t* Bt; int M, N, K; };

struct StaticOrder {
    int nM, nN, nwg, G, c;
    __host__ __device__ void init(int M, int N, int G_, int c_) { nM = M / BM; nN = N / BM; nwg = nM * nN; G = G_; c = c_; }
    __host__ __device__ bool next(int i, Unit& u) const {
        const long L = (long)i * G + c; if (L >= nwg) return false;
        int wgid = (int)L; { const int q = nwg / NXCD, r = nwg % NXCD, xcd = wgid % NXCD, off = wgid / NXCD; wgid = (xcd < r ? xcd * (q + 1) : r * (q + 1) + (xcd - r) * q) + off; }
        const int nig = WGM * nN, gid = wgid / nig, fm = gid * WGM, gsz = (nM - fm) < WGM ? (nM - fm) : WGM;
        u.pm = fm + ((wgid % nig) % gsz); u.pn = (wgid % nig) / gsz; return true;
    }
    __device__ __forceinline__ void a_ready(const Unit&) const {}
    __device__ __forceinline__ void done(const Unit&) const {}
};

typedef float f32x2c __attribute__((ext_vector_type(2))); typedef __bf16 bf16x2c __attribute__((ext_vector_type(2)));
__device__ __forceinline__ unsigned cvt_pk_bf16(float lo, float hi) { f32x2c v = {lo, hi}; bf16x2c b = __builtin_convertvector(v, bf16x2c); return __builtin_bit_cast(unsigned, b); }
typedef float f32x2 __attribute__((ext_vector_type(2)));
__device__ __forceinline__ f32x2 gelu_pk(f32x2 v) {
    const f32x2 av = __builtin_elementwise_abs(v), d = av * 0.2316418882f + 1.0f;
    f32x2 t; t.x = __builtin_amdgcn_rcpf(d.x); t.y = __builtin_amdgcn_rcpf(d.y);
    f32x2 q = t * 0.5307027145f + (-0.7265760135f); q = q * t + 0.7107068705f; q = q * t + (-0.142248368f); q = q * t + 0.127414796f; q = q * t;
    const f32x2 s = (v * v) * (-0.72134752044f);
    f32x2 e; e.x = __builtin_amdgcn_exp2f(s.x); e.y = __builtin_amdgcn_exp2f(s.y);
    const f32x2 m = v * (q * e), r = v - m;
    f32x2 o; o.x = v.x < 0.f ? m.x : r.x; o.y = v.y < 0.f ? m.y : r.y; return o;
}

template <int ACT  > struct EpiBf16 {
    static constexpr bool PERM = true, AFTER_DRAIN = false; static_assert(ACT == 0 || ACT == 1, "EpiBf16: ACT is 0 (none) or 1 (gelu_pk)");
    bf16_t* O; int ldc; const float* bias; int split_cols; size_t split_stride; float scale0;
    __device__ __forceinline__ void operator()(const f32x4 (&acc)[2][2][4][2], const Unit& u, int wr, int wc, int fr, int fq) const {
        const int row0 = u.pm * BM + wr * 64 + fr; int colt = u.pn * BM; bf16_t* base = O;
        float sc = 1.f; if (split_cols) { const int t = colt / split_cols; base += (size_t)t * split_stride; colt -= t * split_cols; if (t == 0) sc = scale0; }
        const int col0 = colt + wc * 32 + 8 * fq, bcol0 = u.pn * BM + wc * 32 + 8 * fq;
        f32x4 bv[2][2];
#pragma unroll
        for (int bj = 0; bj < 2; ++bj)
#pragma unroll
            for (int n = 0; n < 2; ++n) bv[bj][n] = bias ? *(const f32x4*)(bias + bcol0 + bj * HALF + 4 * n) : (f32x4){0.f, 0.f, 0.f, 0.f};
#pragma unroll
        for (int ai = 0; ai < 2; ++ai)
#pragma unroll
            for (int m = 0; m < 4; ++m) { bf16_t* rowp = base + (size_t)(row0 + ai * HALF + m * 16) * ldc + col0;
#pragma unroll
                for (int bj = 0; bj < 2; ++bj) { f32x4 v0 = acc[ai][bj][m][0] + bv[bj][0], v1 = acc[ai][bj][m][1] + bv[bj][1];
                    if (ACT == 1) { f32x2 a = gelu_pk((f32x2){v0[0], v0[1]}), b = gelu_pk((f32x2){v0[2], v0[3]}), c = gelu_pk((f32x2){v1[0], v1[1]}), d = gelu_pk((f32x2){v1[2], v1[3]});
                        v0 = (f32x4){a.x, a.y, b.x, b.y}; v1 = (f32x4){c.x, c.y, d.x, d.y}; }
                    v0 = v0 * sc; v1 = v1 * sc; u32x4 w; w.x = cvt_pk_bf16(v0[0], v0[1]); w.y = cvt_pk_bf16(v0[2], v0[3]); w.z = cvt_pk_bf16(v1[0], v1[1]); w.w = cvt_pk_bf16(v1[2], v1[3]);
                    *(u32x4*)(rowp + bj * HALF) = w; } }
    }
};


template <class Epi, class Sched, bool ALIGN_EPI = false, bool SP2 = false>
__device__ __forceinline__ void gemm_phase(PG8_LAS unsigned char* lds, const Gemm g_in, const Sched& S, const Epi& E) {
    Gemm g = g_in; asm volatile("" : "+s"(g.A), "+s"(g.Bt));
    int tid_ = threadIdx.x; asm volatile("" : "+v"(tid_));
    const int tid = tid_, wid = __builtin_amdgcn_readfirstlane(tid >> 6), lane = tid & 63, wr = wid >> 2, wc = wid & 3, fr = lane & 15, fq = lane >> 4;
    const int K = g.K, nt = K / BK;
    unsigned voffA[2], voffB[2];
#pragma unroll
    for (int i = 0; i < 2; ++i) { int R, C; stage_rc(tid * 16 + i * 8192, R, C); const int Rb = Epi::PERM ? ((R & ~31) + perm32(R & 31)) : R;
        voffA[i] = (unsigned)(R * K + C) * 2u; voffB[i] = (unsigned)(Rb * K + C) * 2u; }
    const size_t kstep = (size_t)(BK * 2);
    const size_t hstep = (size_t)HALF * K * 2;
    const size_t tstep = 2 * hstep;
    const unsigned ldsw = (unsigned)wid * 1024u;
    const int aoff = lds_byte(wr * 64 + fr, fq * 8), boff = lds_byte(wc * 32 + fr, fq * 8);
#define PG8_SA(b, h) (((b) * 2 + (h)) * HTB)
#define PG8_SB(b, h) ((4 + (b) * 2 + (h)) * HTB)
#define PG8_STAGE(bufoff, gbase, voff) do { _Pragma("unroll") for (int _i = 0; _i < 2; ++_i) \
        __builtin_amdgcn_global_load_lds((const unsigned*)((const char*)(gbase) + (voff)[_i]), (PG8_LAS unsigned*)(lds + (bufoff) + ldsw + _i * 8192), 16, 0, 0); } while (0)
#define PG8_LDA(dst, b, h) do { _Pragma("unroll") for (int m = 0; m < 4; ++m) _Pragma("unroll") for (int k = 0; k < 2; ++k) dst[m][k] = *(const PG8_LAS bf16x8*)(lds + PG8_SA(b, h) + aoff + m * 2048 + k * 1024); } while (0)
#define PG8_LDB(dst, b, h) do { _Pragma("unroll") for (int n = 0; n < 2; ++n) _Pragma("unroll") for (int k = 0; k < 2; ++k) dst[n][k] = *(const PG8_LAS bf16x8*)(lds + PG8_SB(b, h) + boff + n * 2048 + k * 1024); } while (0)
#define PG8_MMA(ai, bj, At, Bt) do { __builtin_amdgcn_s_setprio(1); _Pragma("unroll") for (int m = 0; m < 4; ++m) _Pragma("unroll") for (int n = 0; n < 2; ++n) _Pragma("unroll") for (int k = 0; k < 2; ++k) \
        acc[ai][bj][m][n] = __builtin_amdgcn_mfma_f32_16x16x32_bf16(Bt[n][k], At[m][k], acc[ai][bj][m][n], 0, 0, 0); __builtin_amdgcn_s_setprio(0); } while (0)
#define PG8_WAIT_V(n) asm volatile("s_waitcnt vmcnt(" #n ")" ::: "memory")
#define PG8_WAIT_L(n) asm volatile("s_waitcnt lgkmcnt(" #n ")" ::: "memory")
#define PG8_BAR __builtin_amdgcn_s_barrier()
#define PG8_SCHED __builtin_amdgcn_sched_barrier(0)
    Unit cur, nxt; int ui = 0;
    if (!S.next(0, cur)) return;
    f32x4 acc[2][2][4][2];
#pragma unroll
    for (int a = 0; a < 2; ++a)
#pragma unroll
        for (int b = 0; b < 2; ++b)
#pragma unroll
            for (int m = 0; m < 4; ++m)
#pragma unroll
                for (int n = 0; n < 2; ++n) acc[a][b][m][n] = (f32x4){0.f, 0.f, 0.f, 0.f};
    bf16x8 At[4][2], B0[2][2], B1[2][2];
    const char* cA = (const char*)g.A + (size_t)cur.pm * tstep; const char* cB = (const char*)g.Bt + (size_t)cur.pn * tstep;
    S.a_ready(cur);
    if constexpr (SP2) {
        PG8_STAGE(PG8_SB(0, 0), cB, voffB); PG8_STAGE(PG8_SB(0, 1), cB + hstep, voffB); PG8_STAGE(PG8_SA(0, 0), cA, voffA); PG8_STAGE(PG8_SA(0, 1), cA + hstep, voffA);
        if (wr == 1) PG8_BAR;
        PG8_WAIT_V(2); PG8_BAR;
        PG8_STAGE(PG8_SB(1, 0), cB + kstep, voffB); PG8_STAGE(PG8_SA(1, 0), cA + kstep, voffA); PG8_STAGE(PG8_SB(1, 1), cB + hstep + kstep, voffB);
        PG8_WAIT_V(6); PG8_BAR;
    } else {
        PG8_STAGE(PG8_SB(0, 0), cB, voffB); PG8_STAGE(PG8_SA(0, 0), cA, voffA); PG8_STAGE(PG8_SB(0, 1), cB + hstep, voffB); PG8_STAGE(PG8_SA(0, 1), cA + hstep, voffA);
        if (wr == 1) PG8_BAR;
        PG8_WAIT_V(4); PG8_BAR;
        PG8_STAGE(PG8_SB(1, 0), cB + kstep, voffB); PG8_STAGE(PG8_SA(1, 0), cA + kstep, voffA); PG8_STAGE(PG8_SB(1, 1), cB + hstep + kstep, voffB);
        PG8_WAIT_V(6); PG8_BAR;
    }
    for (;;) {
        const bool has_next = S.next(ui + 1, nxt);
        const char* nA = has_next ? (const char*)g.A + (size_t)nxt.pm * tstep : cA; const char* nB = has_next ? (const char*)g.Bt + (size_t)nxt.pn * tstep : cB;
        for (int t = 0; t < nt; t += 2) {
            const bool last = (t == nt - 2);
            const char* a1 = cA + (size_t)(t + 1) * kstep;
            const char* a2 = last ? nA : cA + (size_t)(t + 2) * kstep; const char* b2 = last ? nB : cB + (size_t)(t + 2) * kstep;
            const char* a3 = a2 + kstep; const char* b3 = b2 + kstep;
            if (last && has_next) S.a_ready(nxt);
            if constexpr (SP2) {
            PG8_LDB(B0, 0, 0); PG8_LDB(B1, 0, 1); PG8_SCHED; PG8_LDA(At, 0, 0); PG8_STAGE(PG8_SA(1, 1), a1 + hstep, voffA);
            PG8_WAIT_V(8); PG8_WAIT_L(0); PG8_BAR; PG8_MMA(0, 0, At, B0); PG8_MMA(0, 1, At, B1); PG8_BAR; PG8_SCHED;
            PG8_LDA(At, 0, 1); PG8_STAGE(PG8_SB(0, 0), b2, voffB); PG8_STAGE(PG8_SB(0, 1), b2 + hstep, voffB); PG8_STAGE(PG8_SA(0, 0), a2, voffA);
            PG8_WAIT_V(8); PG8_WAIT_L(0); PG8_BAR; PG8_MMA(1, 0, At, B0); PG8_MMA(1, 1, At, B1); PG8_BAR; PG8_SCHED;
            PG8_LDB(B0, 1, 0); PG8_LDB(B1, 1, 1); PG8_SCHED; PG8_LDA(At, 1, 0); PG8_STAGE(PG8_SA(0, 1), a2 + hstep, voffA);
            PG8_WAIT_V(8); PG8_WAIT_L(0); PG8_BAR; PG8_MMA(0, 0, At, B0); PG8_MMA(0, 1, At, B1); PG8_BAR; PG8_SCHED;
            PG8_LDA(At, 1, 1); PG8_STAGE(PG8_SB(1, 0), b3, voffB); PG8_STAGE(PG8_SB(1, 1), b3 + hstep, voffB); PG8_STAGE(PG8_SA(1, 0), a3, voffA);
            PG8_WAIT_V(8); PG8_WAIT_L(0); PG8_BAR; PG8_MMA(1, 0, At, B0); PG8_MMA(1, 1, At, B1); PG8_BAR; PG8_SCHED;
            } else {
            PG8_LDB(B0, 0, 0); PG8_SCHED; PG8_LDA(At, 0, 0); PG8_STAGE(PG8_SA(1, 1), a1 + hstep, voffA);
            PG8_WAIT_L(8); PG8_BAR; PG8_WAIT_L(0); PG8_MMA(0, 0, At, B0); PG8_BAR; PG8_SCHED;
            PG8_LDB(B1, 0, 1); PG8_STAGE(PG8_SB(0, 0), b2, voffB);
            PG8_BAR; PG8_WAIT_L(0); PG8_MMA(0, 1, At, B1); PG8_BAR;
            PG8_LDA(At, 0, 1); PG8_STAGE(PG8_SA(0, 0), a2, voffA);
            PG8_BAR; PG8_WAIT_L(0); PG8_MMA(1, 0, At, B0); PG8_BAR; PG8_SCHED;
            PG8_STAGE(PG8_SB(0, 1), b2 + hstep, voffB);
            PG8_WAIT_V(6); PG8_BAR; PG8_MMA(1, 1, At, B1); PG8_BAR;
            PG8_LDB(B0, 1, 0); PG8_SCHED; PG8_LDA(At, 1, 0); PG8_STAGE(PG8_SA(0, 1), a2 + hstep, voffA);
            PG8_WAIT_L(8); PG8_BAR; PG8_WAIT_L(0); PG8_MMA(0, 0, At, B0); PG8_BAR; PG8_SCHED;
            PG8_LDB(B1, 1, 1); PG8_STAGE(PG8_SB(1, 0), b3, voffB);
            PG8_BAR; PG8_WAIT_L(0); PG8_MMA(0, 1, At, B1); PG8_BAR;
            PG8_LDA(At, 1, 1); PG8_STAGE(PG8_SA(1, 0), a3, voffA);
            PG8_BAR; PG8_WAIT_L(0); PG8_MMA(1, 0, At, B0); PG8_BAR; PG8_SCHED;
            PG8_STAGE(PG8_SB(1, 1), b3 + hstep, voffB);
            PG8_WAIT_V(6); PG8_BAR; PG8_MMA(1, 1, At, B1); PG8_BAR;
            }
        }
        if constexpr (ALIGN_EPI) { if (wr == 0) PG8_BAR; }
        if constexpr (!Epi::AFTER_DRAIN) { E(acc, cur, wr, wc, fr, fq); S.done(cur); }
        if (!has_next) break;
#pragma unroll
        for (int a = 0; a < 2; ++a)
#pragma unroll
            for (int b = 0; b < 2; ++b)
#pragma unroll
                for (int m = 0; m < 4; ++m)
#pragma unroll
                    for (int n = 0; n < 2; ++n) acc[a][b][m][n] = (f32x4){0.f, 0.f, 0.f, 0.f};
        cur = nxt; cA = nA; cB = nB; ++ui;
        if constexpr (ALIGN_EPI) { if (wr == 1) PG8_BAR; }
    }
    PG8_WAIT_V(0);
    if constexpr (!ALIGN_EPI) { if (wr == 0) PG8_BAR; }
    PG8_BAR;
    if constexpr (Epi::AFTER_DRAIN) { E.fused(acc, cur, wr, wc, fr, fq, lds, wid, lane); S.done(cur); }
#undef PG8_SA
#undef PG8_SB
#undef PG8_STAGE
#undef PG8_LDA
#undef PG8_LDB
#undef PG8_MMA
#undef PG8_WAIT_V
#undef PG8_WAIT_L
#undef PG8_BAR
#undef PG8_SCHED
}
}

#ifndef PG8_SP2
#define PG8_SP2 true
#endif
#ifndef PG8_ALIGN
#define PG8_ALIGN true
#endif
namespace pg8 {
constexpr float C2S = 0.125f * 1.4426950408889634f;
__device__ __forceinline__ float sigm(float x) { return __builtin_amdgcn_rcpf(1.0f + __builtin_amdgcn_exp2f(-1.4426950408889634f * x)); }
__device__ __forceinline__ void st8(bf16_t* p, f32x4 v0, f32x4 v1) { u32x4 w; w.x = cvt_pk_bf16(v0[0], v0[1]); w.y = cvt_pk_bf16(v0[2], v0[3]); w.z = cvt_pk_bf16(v1[0], v1[1]); w.w = cvt_pk_bf16(v1[2], v1[3]); *(u32x4*)p = w; }

struct EpiIn {
    static constexpr bool PERM = true, AFTER_DRAIN = false;
    bf16_t *AQK, *BXG, *CQK, *CV, *GATES; const float* gbias; const float* rc; const float* rs;
    __device__ __forceinline__ void operator()(const f32x4 (&acc)[2][2][4][2], const Unit& u, int wr, int wc, int fr, int fq) const {
        const int pn = u.pn;
        bf16_t* base; int ldc, colt, mode;
        if (pn < 2)       { base = AQK; ldc = 1024; colt = pn * 256; mode = 1; }
        else if (pn < 4)  { base = AQK; ldc = 1024; colt = 512 + (pn - 2) * 256; mode = 0; }
        else if (pn < 10) { base = BXG; ldc = 1024; colt = (pn - 6) * 256; mode = 0; }
        else if (pn < 12) { base = CQK; ldc = 1024; colt = (pn - 10) * 256; mode = 3; }
        else if (pn < 14) { base = CQK; ldc = 1024; colt = 512 + (pn - 12) * 256; mode = 2; }
        else if (pn < 16) { base = CV; ldc = 512; colt = (pn - 14) * 256; mode = 0; }
        else              { base = GATES; ldc = 3072; colt = (pn - 16) * 256; mode = 4; }
        const int row0 = u.pm * BM + wr * 64 + fr, cl = wc * 32 + 8 * fq;
        const float sc = (mode & 1) ? C2S : 1.f;
        if (mode == 4) {
            f32x4 bv[2][2];
#pragma unroll
            for (int bj = 0; bj < 2; ++bj)
#pragma unroll
                for (int n = 0; n < 2; ++n) bv[bj][n] = *(const f32x4*)(gbias + colt + bj * HALF + cl + 4 * n);
#pragma unroll
            for (int ai = 0; ai < 2; ++ai)
#pragma unroll
                for (int m = 0; m < 4; ++m) { bf16_t* rowp = base + (size_t)(row0 + ai * HALF + m * 16) * ldc + colt + cl;
#pragma unroll
                    for (int bj = 0; bj < 2; ++bj) { f32x4 v0 = acc[ai][bj][m][0] + bv[bj][0], v1 = acc[ai][bj][m][1] + bv[bj][1];
#pragma unroll
                        for (int e = 0; e < 4; ++e) { v0[e] = sigm(v0[e]); v1[e] = sigm(v1[e]); }
                        st8(rowp + bj * HALF, v0, v1); }
                    asm volatile("" ::: "memory"); }
        } else if (mode >= 2) {
            const int i0 = (wc & 1) * 16 + 4 * fq;
#pragma unroll
            for (int ai = 0; ai < 2; ++ai)
#pragma unroll
                for (int m = 0; m < 4; ++m) { const int row = row0 + ai * HALF + m * 16; bf16_t* rowp = base + (size_t)row * ldc + colt + cl;
                    const f32x4 cs = *(const f32x4*)(rc + (size_t)row * 32 + i0), sn = *(const f32x4*)(rs + (size_t)row * 32 + i0);
#pragma unroll
                    for (int bj = 0; bj < 2; ++bj) { const f32x4 a0 = acc[ai][bj][m][0], a1 = acc[ai][bj][m][1]; f32x4 v0, v1;
                        v0[0] = (a0[0] * cs[0] - a0[1] * sn[0]) * sc; v0[1] = (a0[1] * cs[0] + a0[0] * sn[0]) * sc;
                        v0[2] = (a0[2] * cs[1] - a0[3] * sn[1]) * sc; v0[3] = (a0[3] * cs[1] + a0[2] * sn[1]) * sc;
                        v1[0] = (a1[0] * cs[2] - a1[1] * sn[2]) * sc; v1[1] = (a1[1] * cs[2] + a1[0] * sn[2]) * sc;
                        v1[2] = (a1[2] * cs[3] - a1[3] * sn[3]) * sc; v1[3] = (a1[3] * cs[3] + a1[2] * sn[3]) * sc;
                        st8(rowp + bj * HALF, v0, v1); }
                    asm volatile("" ::: "memory"); }
        } else {
#pragma unroll
            for (int ai = 0; ai < 2; ++ai)
#pragma unroll
                for (int m = 0; m < 4; ++m) { bf16_t* rowp = base + (size_t)(row0 + ai * HALF + m * 16) * ldc + colt + cl;
#pragma unroll
                    for (int bj = 0; bj < 2; ++bj) st8(rowp + bj * HALF, acc[ai][bj][m][0] * sc, acc[ai][bj][m][1] * sc); }
        }
    }
};
struct InOrder {
    StaticOrder S;
    __device__ void init(int G, int c) { S.init(16384, 26 * 256, G, c); }
    __device__ bool next(int i, Unit& u) const { if (!S.next(i, u)) return false; if (u.pn >= 4) u.pn += 2; return true; }
    __device__ __forceinline__ void a_ready(const Unit&) const {}
    __device__ __forceinline__ void done(const Unit&) const {}
};
struct MergeOrder {
    StaticOrder S;
    __device__ void init(int G, int c) { S.init(16384, 1024, G, c); }
    __device__ bool next(int i, Unit& u) const { const int n = i % 3; if (!S.next(i / 3, u)) return false; u.pm += n * 64; u.pn += n * 4; return true; }
    __device__ __forceinline__ void a_ready(const Unit&) const {}
    __device__ __forceinline__ void done(const Unit&) const {}
};
struct EpiMerge {
    static constexpr bool PERM = true, AFTER_DRAIN = false;
    const bf16_t* gates; bf16_t* merged;
    __device__ __forceinline__ void operator()(const f32x4 (&acc)[2][2][4][2], const Unit& u, int wr, int wc, int fr, int fq) const {
        const int nb = u.pm >> 6, pm = u.pm & 63, pn = u.pn & 3;
        const int row0 = pm * BM + wr * 64 + fr, col0 = pn * BM + wc * 32 + 8 * fq;
#pragma unroll
        for (int ai = 0; ai < 2; ++ai)
#pragma unroll
            for (int m = 0; m < 4; ++m) { const size_t row = (size_t)(row0 + ai * HALF + m * 16);
#pragma unroll
                for (int bj = 0; bj < 2; ++bj) { const int col = col0 + bj * HALF;
                    const u32x4 gw = *(const u32x4*)(gates + row * 3072 + nb * 1024 + col);
                    f32x4 g0, g1;
                    g0[0] = __uint_as_float(gw.x << 16); g0[1] = __uint_as_float(gw.x & 0xffff0000u); g0[2] = __uint_as_float(gw.y << 16); g0[3] = __uint_as_float(gw.y & 0xffff0000u);
                    g1[0] = __uint_as_float(gw.z << 16); g1[1] = __uint_as_float(gw.z & 0xffff0000u); g1[2] = __uint_as_float(gw.w << 16); g1[3] = __uint_as_float(gw.w & 0xffff0000u);
                    f32x4 v0 = acc[ai][bj][m][0] * g0, v1 = acc[ai][bj][m][1] * g1;
                    bf16_t* mp = merged + row * 1024 + col;
                    if (nb > 0) { const u32x4 pw = *(const u32x4*)mp;
                        v0[0] += __uint_as_float(pw.x << 16); v0[1] += __uint_as_float(pw.x & 0xffff0000u); v0[2] += __uint_as_float(pw.y << 16); v0[3] += __uint_as_float(pw.y & 0xffff0000u);
                        v1[0] += __uint_as_float(pw.z << 16); v1[1] += __uint_as_float(pw.z & 0xffff0000u); v1[2] += __uint_as_float(pw.w << 16); v1[3] += __uint_as_float(pw.w & 0xffff0000u); }
                    st8(mp, v0, v1); }
                if (m & 1) asm volatile("" ::: "memory"); }
    }
};
struct EpiOut {
    static constexpr bool PERM = true, AFTER_DRAIN = false;
    const float* resid; float* yf; float alpha;
    __device__ __forceinline__ void operator()(const f32x4 (&acc)[2][2][4][2], const Unit& u, int wr, int wc, int fr, int fq) const {
        const int row0 = u.pm * BM + wr * 64 + fr, col0 = u.pn * BM + wc * 32 + 8 * fq;
#pragma unroll
        for (int ai = 0; ai < 2; ++ai)
#pragma unroll
            for (int m = 0; m < 4; ++m) { const size_t row = (size_t)(row0 + ai * HALF + m * 16);
#pragma unroll
                for (int bj = 0; bj < 2; ++bj) { const size_t o = row * 1024 + col0 + bj * HALF;
                    const f32x4 r0 = *(const f32x4*)(resid + o), r1 = *(const f32x4*)(resid + o + 4);
                    *(f32x4*)(yf + o) = r0 * alpha + acc[ai][bj][m][0]; *(f32x4*)(yf + o + 4) = r1 * alpha + acc[ai][bj][m][1]; }
                asm volatile("" ::: "memory"); }
    }
};
}
#include <hip/hip_bf16.h>
#include <cmath>
namespace attn_body {
using bf16=__hip_bfloat16;
using bf16x8=__attribute__((ext_vector_type(8)))short;
using s16x4=__attribute__((ext_vector_type(4)))short;
using f32x16=__attribute__((ext_vector_type(16)))float;
using u32x4=__attribute__((ext_vector_type(4)))unsigned;
constexpr int BATCH=2,NHEAD=16,SEQ=8192,D=64;
constexpr int QP=1024,KP=1024,VP=512,OP=1024;
constexpr int NW=8,QBLK=32,QB=QBLK*NW,KVBLK=64,NQB=SEQ/QB;
constexpr int ATTN_UNIT_ROWS=QB;
__device__ __forceinline__ int crow(int r,int hi){return (r&3)+8*(r>>2)+4*hi;}
#define SBAR() __builtin_amdgcn_sched_barrier(0)
__device__ __forceinline__ void cmask(f32x16&p0,f32x16&p1,int jb,int qrel,int hi){
  const float NEG=-INFINITY; (void)hi;
  if(jb>(qrel>>6)){
  #pragma unroll
  for(int r=0;r<16;++r){p0[r]=NEG;p1[r]=NEG;} }
}

constexpr int NSLOT=3, SLOTB=8192;
constexpr int LDS_K=0, LDS_V=NSLOT*SLOTB, LDS_WS=2*NSLOT*SLOTB, LDS_OST=LDS_WS+NW*64*4, LDS_BYTES=LDS_OST+NW*4096;
constexpr float C2=0.125f*1.4426950408889634f;
__device__ __forceinline__ void glds16(const void*gsrc,unsigned lds_dst){unsigned keep;
  asm volatile("s_mov_b32 %0, m0\n\ts_mov_b32 m0, %2\n\ts_nop 0\n\tglobal_load_lds_dwordx4 %1, off\n\ts_mov_b32 m0, %0":"=&s"(keep):"v"(gsrc),"s"(lds_dst):"memory");}
__device__ __forceinline__ float max3f(float a,float b,float c){float r;asm("v_max3_f32 %0, %1, %2, %3":"=v"(r):"v"(a),"v"(b),"v"(c));return r;}
__device__ __forceinline__ float max2f(float a,float b){float r;asm("v_max_f32_e32 %0, %1, %2":"=v"(r):"v"(a),"v"(b));return r;}
__device__ __forceinline__ float fadd_s(float a,float b){float r;asm("v_add_f32_e32 %0, %1, %2":"=v"(r):"v"(a),"v"(b));return r;}
__device__ __forceinline__ float fsub_s(float a,float b){float r;asm("v_sub_f32_e32 %0, %1, %2":"=v"(r):"v"(a),"v"(b));return r;}
typedef float f32x2_t __attribute__((ext_vector_type(2))); typedef __bf16 bf16x2_t __attribute__((ext_vector_type(2)));
__device__ __forceinline__ unsigned cvtpk_s(float lo,float hi){f32x2_t v={lo,hi};bf16x2_t b=__builtin_convertvector(v,bf16x2_t);return __builtin_bit_cast(unsigned,b);}
#define WAIT_BAR(N) asm volatile("s_waitcnt vmcnt(" #N ") lgkmcnt(0)\n\ts_barrier":::"memory")

__device__ __forceinline__ void qkt(f32x16&p0,f32x16&p1,const char*Kslot,const bf16x8*qr,const f32x16&negm,int r32,int hi){
  const char*kb=Kslot+hi*1024+r32*16;
  #pragma unroll
  for(int d0=0;d0<4;++d0){
    const bf16x8 b0=*reinterpret_cast<const bf16x8*>(kb+d0*2048);
    const bf16x8 b1=*reinterpret_cast<const bf16x8*>(kb+d0*2048+512);
    if(d0==0){p0=__builtin_amdgcn_mfma_f32_32x32x16_bf16(b0,qr[0],negm,0,0,0);p1=__builtin_amdgcn_mfma_f32_32x32x16_bf16(b1,qr[0],negm,0,0,0);}
    else{p0=__builtin_amdgcn_mfma_f32_32x32x16_bf16(b0,qr[d0],p0,0,0,0);p1=__builtin_amdgcn_mfma_f32_32x32x16_bf16(b1,qr[d0],p1,0,0,0);}}
}
typedef __attribute__((address_space(3))) const char* lds_cptr;
typedef short v4i16_t __attribute__((ext_vector_type(4)));
__device__ __forceinline__ void kload8(bf16x8*kf,lds_cptr kp){
  kf[0]=*(const __attribute__((address_space(3))) bf16x8*)(kp);      kf[1]=*(const __attribute__((address_space(3))) bf16x8*)(kp+512);
  kf[2]=*(const __attribute__((address_space(3))) bf16x8*)(kp+2048); kf[3]=*(const __attribute__((address_space(3))) bf16x8*)(kp+2560);
  kf[4]=*(const __attribute__((address_space(3))) bf16x8*)(kp+4096); kf[5]=*(const __attribute__((address_space(3))) bf16x8*)(kp+4608);
  kf[6]=*(const __attribute__((address_space(3))) bf16x8*)(kp+6144); kf[7]=*(const __attribute__((address_space(3))) bf16x8*)(kp+6656);
}
__device__ __forceinline__ void kload2(bf16x8*kf,lds_cptr kp,int j){ kf[2*j]=*(const __attribute__((address_space(3))) bf16x8*)(kp+j*2048); kf[2*j+1]=*(const __attribute__((address_space(3))) bf16x8*)(kp+j*2048+512); }
__device__ __forceinline__ s16x4 vtr(lds_cptr p){ return __builtin_bit_cast(s16x4,__builtin_amdgcn_ds_read_tr16_b64_v4i16((__attribute__((address_space(3))) v4i16_t*)p)); }
__device__ __forceinline__ float rowmax(const f32x16&p0,const f32x16&p1){
  float a=max3f(p0[0],p0[1],p1[0]),b=max3f(p0[2],p0[3],p1[1]);a=max3f(a,p1[2],p1[3]);
  #pragma unroll
  for(int r=4;r<16;r+=4){a=max3f(a,p0[r],p0[r+1]);b=max3f(b,p0[r+2],p0[r+3]);a=max3f(a,p1[r],p1[r+1]);b=max3f(b,p1[r+2],p1[r+3]);}
  const float m=max2f(a,b);
  auto rr=__builtin_amdgcn_permlane32_swap(__float_as_uint(m),__float_as_uint(m),false,false);
  return max2f(__uint_as_float(rr[0]),__uint_as_float(rr[1]));
}
__device__ __forceinline__ void pv(f32x16*o,int vb,bf16x8 pa0,bf16x8 pa1,bf16x8 pa2,bf16x8 pa3){
  #pragma unroll
  for(int d0=0;d0<2;++d0){s16x4 lo[4],hi[4];
    #pragma unroll
    for(int ks=0;ks<4;++ks){
      asm volatile("ds_read_b64_tr_b16 %0,%1 offset:%c2":"=&v"(lo[ks]):"v"(vb),"i"(d0*4096+ks*1024):"memory");
      asm volatile("ds_read_b64_tr_b16 %0,%1 offset:%c2":"=&v"(hi[ks]):"v"(vb),"i"(d0*4096+ks*1024+512):"memory");}
    asm volatile("s_waitcnt lgkmcnt(0)":::"memory");SBAR();
    #define PK(k) (bf16x8){lo[k][0],lo[k][1],lo[k][2],lo[k][3],hi[k][0],hi[k][1],hi[k][2],hi[k][3]}
    o[d0]=__builtin_amdgcn_mfma_f32_32x32x16_bf16(pa0,PK(0),o[d0],0,0,0);
    o[d0]=__builtin_amdgcn_mfma_f32_32x32x16_bf16(pa1,PK(1),o[d0],0,0,0);
    o[d0]=__builtin_amdgcn_mfma_f32_32x32x16_bf16(pa2,PK(2),o[d0],0,0,0);
    o[d0]=__builtin_amdgcn_mfma_f32_32x32x16_bf16(pa3,PK(3),o[d0],0,0,0);
    #undef PK
  }
}

#ifndef ATTN_STORE16
#define ATTN_STORE16(p,v) (*(u32x4*)(p)=(v))
#endif
template<int THRL> __device__ __forceinline__ void attn_unit(int b,int h,int qb,const bf16*Q,const bf16*__restrict__ K,const bf16*__restrict__ V,bf16*O,char*shm){
  const int qcol=(h>>1)*64, kcol=512+(h>>1)*64, vcol=((h>>2)*2+(h&1))*64, ocol=h*64;
  int tid_=threadIdx.x; asm volatile("":"+v"(tid_)); const int tid=tid_,lane=tid&63,r32=lane&31,hi=lane>>5; const int wid=__builtin_amdgcn_readfirstlane(tid>>6);
  const long rowbase=(long)b*SEQ; const int q0=qb*QB;
  const bf16*Qw=Q+(rowbase+q0+wid*QBLK)*QP+qcol;
  const bf16*Kh=K+rowbase*KP+kcol,*Vh=V+rowbase*VP+vcol;
  const unsigned lds0=(unsigned)(uintptr_t)shm;
  float*wsf=(float*)(shm+LDS_WS)+wid*64;
  const bf16*ksrc=Kh+(long)lane*KP+wid*8;
  const bf16*vsrc=Vh+(long)(16*(wid&3)+(lane>>2))*VP+(wid>>2)*32+(lane&3)*8;
  const unsigned kdst=lds0+LDS_K+wid*1024, vdst=lds0+LDS_V+wid*1024;
  #define DMA_K(t,slot) glds16(ksrc+(long)(t)*KVBLK*KP,(unsigned)__builtin_amdgcn_readfirstlane(kdst+(slot)))
  #define DMA_V(t,slot) glds16(vsrc+(long)(t)*KVBLK*VP,(unsigned)__builtin_amdgcn_readfirstlane(vdst+(slot)))
  const int vb0=(int)(lds0+LDS_V)+((lane>>4)&1)*32+(lane&3)*8+(4*hi+((lane&15)>>2))*64;
  const char*Kbase=shm+LDS_K; bf16x8 kf[8];
  const lds_cptr shm3=(lds_cptr)shm; const lds_cptr kp0=shm3+LDS_K+hi*1024+r32*16; const lds_cptr vp0=shm3+LDS_V+((lane>>4)&1)*32+(lane&3)*8+(4*hi+((lane&15)>>2))*64;
  const int NT=(q0+QB)/KVBLK;
  DMA_K(0,0);DMA_V(0,0);DMA_K(1,SLOTB);
  bf16x8 qr[4];
  #pragma unroll
  for(int d0=0;d0<4;++d0)qr[d0]=*reinterpret_cast<const bf16x8*>(&Qw[(long)r32*QP+d0*16+hi*8]);
  float mhat=0.f,l_reg=0.f;f32x16 o[2];o[0]=f32x16{};o[1]=f32x16{};f32x16 negm=f32x16{};asm volatile("":"+v"(negm));
  const int qrel=wid*QBLK+r32;
  #define CMASK(P0,P1,t) do{int jb_=(t)-(NT-4); if(jb_>=0)cmask(P0,P1,jb_,qrel,hi);}while(0)
  bool resc=false;
  #define START(P0,P1) do{ const float rm=rowmax(P0,P1); resc=false; \
    { const float dl=rm; mhat=fadd_s(mhat,dl); \
      _Pragma("unroll") for(int r=0;r<16;++r){P0[r]=fsub_s(P0[r],dl);P1[r]=fsub_s(P1[r],dl);} \
      _Pragma("unroll") for(int r=0;r<16;++r)negm[r]=-mhat; asm volatile("":"+v"(negm)); } \
    _Pragma("unroll") for(int r=0;r<16;++r)P0[r]=__builtin_amdgcn_exp2f(P0[r]); }while(0)
  #define RESC() do{ if(resc){ asm volatile("s_waitcnt lgkmcnt(0)":::"memory"); \
      _Pragma("unroll") for(int d_=0;d_<2;++d_) _Pragma("unroll") for(int r=0;r<16;++r)o[d_][r]*=wsf[crow(r,hi)]; } }while(0)
  f32x16 pA0,pA1,pB0,pB1;
  int sl_prev=0,sl_cur=0,sl_next=SLOTB;
  #define ROT() do{sl_prev=sl_cur;sl_cur=sl_next;sl_next=(sl_next==(NSLOT-1)*SLOTB)?0:sl_next+SLOTB;}while(0)
  DMA_K(2,2*SLOTB);
  WAIT_BAR(3);
  qkt(pA0,pA1,Kbase,qr,negm,r32,hi);asm volatile("s_nop 15\n\ts_nop 7":"+v"(pA0),"+v"(pA1));CMASK(pA0,pA1,0);
  START(pA0,pA1);
  _Pragma("unroll") for(int r=0;r<16;++r)pA1[r]=__builtin_amdgcn_exp2f(pA1[r]);
  WAIT_BAR(0);
  DMA_K(3,0);DMA_V(1,SLOTB);
  ROT();
  kload8(kf,kp0+sl_cur);
  WAIT_BAR(2);
  s16x4 vlo[8],vhi[8]; u32x4 pw0,pw1,pw2,pw3;
  #define PKW(P,B) cvtpk_s(P[B],P[B+1])
  #define PAF(k) __builtin_bit_cast(bf16x8,pw##k)
  #define VFR(i) (bf16x8){vlo[i][0],vlo[i][1],vlo[i][2],vlo[i][3],vhi[i][0],vhi[i][1],vhi[i][2],vhi[i][3]}
  #define PIN(x) asm volatile("":"+v"(x))
  #define MX3(a,b,c) __builtin_fmaxf(__builtin_fmaxf((a),(b)),(c))
  #define GAPA(MF,A0,A1,A2,A3,W0,W1,PW) do{ MF; sacc+=A0; sacc+=A1; sacc+=A2; sacc+=A3; PIN(sacc); W0; W1; PIN(PW); SBAR(); }while(0)
  #define EX(v) __builtin_amdgcn_exp2f(v)
  #define GAPB(MF,X,B) do{ MF; X[B]=EX(X[B]); X[B+1]=EX(X[B+1]); X[B+2]=EX(X[B+2]); X[B+3]=EX(X[B+3]); PIN(X); SBAR(); }while(0)
  #define VRD(i) do{ vlo[i]=vtr(vp_+(((i)>>2)*4096+((i)&3)*1024)); vhi[i]=vtr(vp_+(((i)>>2)*4096+((i)&3)*1024+512)); }while(0)
  #define KRD(G,j) do{ if(G){ kload2(kf,kp0+sl_next,j); SBAR(); } }while(0)
  #define STEP(C0,C1,P0,P1,t,GK,GV,GL) do{ SBAR(); \
    const lds_cptr vp_=vp0+sl_prev; \
    VRD(0); SBAR(); float sacc=(P0[0]+P0[1]); \
    GAPA(C0=__builtin_amdgcn_mfma_f32_32x32x16_bf16(kf[0],qr[0],negm,0,0,0), P0[2],P0[3],P0[4],P0[5],     pw0[0]=PKW(P0,0), pw0[1]=PKW(P0,2), pw0); \
    VRD(4); SBAR(); GAPA(C1=__builtin_amdgcn_mfma_f32_32x32x16_bf16(kf[1],qr[0],negm,0,0,0), P0[6],P0[7],P0[8],P0[9],     pw0[2]=PKW(P0,4), pw0[3]=PKW(P0,6), pw0); \
    VRD(1); SBAR(); GAPA(C0=__builtin_amdgcn_mfma_f32_32x32x16_bf16(kf[2],qr[1],C0,0,0,0),   P0[10],P0[11],P0[12],P0[13], pw1[0]=PKW(P0,8), pw1[1]=PKW(P0,10), pw1); \
    VRD(5); SBAR(); GAPA(C1=__builtin_amdgcn_mfma_f32_32x32x16_bf16(kf[3],qr[1],C1,0,0,0),   P0[14],P0[15],P1[0],P1[1],   pw1[2]=PKW(P0,12),pw1[3]=PKW(P0,14), pw1); \
    VRD(2); SBAR(); GAPA(C0=__builtin_amdgcn_mfma_f32_32x32x16_bf16(kf[4],qr[2],C0,0,0,0),   P1[2],P1[3],P1[4],P1[5],     pw2[0]=PKW(P1,0), pw2[1]=PKW(P1,2), pw2); \
    VRD(6); SBAR(); GAPA(C1=__builtin_amdgcn_mfma_f32_32x32x16_bf16(kf[5],qr[2],C1,0,0,0),   P1[6],P1[7],P1[8],P1[9],     pw2[2]=PKW(P1,4), pw2[3]=PKW(P1,6), pw2); \
    VRD(3); SBAR(); GAPA(C0=__builtin_amdgcn_mfma_f32_32x32x16_bf16(kf[6],qr[3],C0,0,0,0),   P1[10],P1[11],P1[12],P1[13], pw3[0]=PKW(P1,8), pw3[1]=PKW(P1,10), pw3); \
    VRD(7); SBAR(); GAPA(C1=__builtin_amdgcn_mfma_f32_32x32x16_bf16(kf[7],qr[3],C1,0,0,0),   P1[14],P1[15],0.f,0.f,       pw3[2]=PKW(P1,12),pw3[3]=PKW(P1,14), pw3); \
    l_reg+=sacc; \
    if(GK){DMA_K((t)+3,sl_cur);} if(GV){DMA_V((t)+1,sl_next);} \
    CMASK(C0,C1,t); \
    { float a=MX3(C0[0],C0[1],C1[0]),b=MX3(C0[2],C0[3],C1[1]); a=MX3(a,C1[2],C1[3]); \
      _Pragma("unroll") for(int r=4;r<16;r+=4){a=MX3(a,C0[r],C0[r+1]);b=MX3(b,C0[r+2],C0[r+3]);a=MX3(a,C1[r],C1[r+1]);b=MX3(b,C1[r+2],C1[r+3]);} \
      float rm=__builtin_fmaxf(a,b); { auto rr=__builtin_amdgcn_permlane32_swap(__float_as_uint(rm),__float_as_uint(rm),false,false); rm=__builtin_fmaxf(__uint_as_float(rr[0]),__uint_as_float(rr[1])); } \
      resc=false; \
      if(__builtin_expect(__any(rm>(float)THRL),0)){ const float dl=__builtin_fmaxf(rm,0.f); mhat+=dl; \
        _Pragma("unroll") for(int r=0;r<16;++r){C0[r]-=dl;C1[r]-=dl;} \
        _Pragma("unroll") for(int r=0;r<16;++r)negm[r]=-mhat; asm volatile("":"+v"(negm)); \
        const float f=__builtin_amdgcn_exp2f(-dl); l_reg*=f; if(hi==0)wsf[r32]=f; resc=true; } } \
    SBAR(); \
    GAPB(o[0]=__builtin_amdgcn_mfma_f32_32x32x16_bf16(PAF(0),VFR(0),o[0],0,0,0), C0,0); \
    GAPB(o[1]=__builtin_amdgcn_mfma_f32_32x32x16_bf16(PAF(0),VFR(4),o[1],0,0,0), C0,4); \
    KRD(GL,0); GAPB(o[0]=__builtin_amdgcn_mfma_f32_32x32x16_bf16(PAF(1),VFR(1),o[0],0,0,0), C0,8); \
    KRD(GL,1); GAPB(o[1]=__builtin_amdgcn_mfma_f32_32x32x16_bf16(PAF(1),VFR(5),o[1],0,0,0), C0,12); \
    KRD(GL,2); GAPB(o[0]=__builtin_amdgcn_mfma_f32_32x32x16_bf16(PAF(2),VFR(2),o[0],0,0,0), C1,0); \
    KRD(GL,3); GAPB(o[1]=__builtin_amdgcn_mfma_f32_32x32x16_bf16(PAF(2),VFR(6),o[1],0,0,0), C1,4); \
    GAPB(o[0]=__builtin_amdgcn_mfma_f32_32x32x16_bf16(PAF(3),VFR(3),o[0],0,0,0), C1,8); \
    GAPB(o[1]=__builtin_amdgcn_mfma_f32_32x32x16_bf16(PAF(3),VFR(7),o[1],0,0,0), C1,12); \
    }while(0)
  int t=1;
  #undef CMASK
  #define CMASK(P0,P1,t) do{}while(0)
  for(;t+5<NT;t+=2){
    STEP(pB0,pB1,pA0,pA1,t,true,true,true);     WAIT_BAR(2); RESC(); ROT();
    STEP(pA0,pA1,pB0,pB1,t+1,true,true,true);   WAIT_BAR(2); RESC(); ROT();
  }
  #undef CMASK
  #define CMASK(P0,P1,t) do{int jb_=(t)-(NT-4); if(jb_>=0)cmask(P0,P1,jb_,qrel,hi);}while(0)
  #define ENDW(tt) do{ if((tt)+3<NT){WAIT_BAR(2);} else if((tt)+2<NT){WAIT_BAR(1);} else {WAIT_BAR(0);} }while(0)
  for(;t+1<NT;t+=2){
    STEP(pB0,pB1,pA0,pA1,t,(t+3<NT),(t+1<NT),(t+1<NT));       ENDW(t);   RESC(); ROT();
    STEP(pA0,pA1,pB0,pB1,t+1,(t+4<NT),(t+2<NT),(t+2<NT));     ENDW(t+1); RESC(); ROT();
  }
  STEP(pB0,pB1,pA0,pA1,NT-1,false,false,false); RESC();
  { float sacc=pB0[0]+pB0[1]; _Pragma("unroll") for(int r=2;r<16;++r)sacc+=pB0[r]; _Pragma("unroll") for(int r=0;r<16;++r)sacc+=pB1[r]; l_reg+=sacc;
    pw0=(u32x4){PKW(pB0,0),PKW(pB0,2),PKW(pB0,4),PKW(pB0,6)};pw1=(u32x4){PKW(pB0,8),PKW(pB0,10),PKW(pB0,12),PKW(pB0,14)};pw2=(u32x4){PKW(pB1,0),PKW(pB1,2),PKW(pB1,4),PKW(pB1,6)};pw3=(u32x4){PKW(pB1,8),PKW(pB1,10),PKW(pB1,12),PKW(pB1,14)};
    SBAR(); pv(o,vb0+sl_cur,PAF(0),PAF(1),PAF(2),PAF(3)); }
  #undef PKW
  #undef PAF
  #undef VFR
  #undef PIN
  #undef MX3
  #undef GAPA
  #undef GAPB
  #undef EX
  #undef VRD
  #undef KRD
  #undef STEP
  #undef ENDW
  {auto rr=__builtin_amdgcn_permlane32_swap(__float_as_uint(l_reg),__float_as_uint(l_reg),false,false);l_reg=__uint_as_float(rr[0])+__uint_as_float(rr[1]);}
  if(hi==0)wsf[32+r32]=l_reg;asm volatile("s_waitcnt lgkmcnt(0)":::"memory");
  float rli[16];
  #pragma unroll
  for(int r=0;r<16;++r)rli[r]=__builtin_amdgcn_rcpf(wsf[32+crow(r,hi)]);
  bf16*Ow=O+(rowbase+q0+wid*QBLK)*OP+ocol;
  { bf16*stg=(bf16*)(shm+LDS_OST)+wid*2048;
    #pragma unroll
    for(int r=0;r<16;++r){const int orow=crow(r,hi);
      #pragma unroll
      for(int d0=0;d0<2;++d0)stg[orow*64+d0*32+r32]=__float2bfloat16(o[d0][r]*rli[r]);}
    asm volatile("s_waitcnt lgkmcnt(0)":::"memory");
    #pragma unroll
    for(int i=0;i<4;++i){const int row=i*8+(lane>>3),ch=lane&7; const u32x4 v=*(const u32x4*)(stg+row*64+ch*8); ATTN_STORE16(Ow+(long)row*OP+ch*8,v);} }
  asm volatile("s_waitcnt lgkmcnt(0)\n\ts_barrier":::"memory");
  #undef DMA_K
  #undef DMA_V
  #undef CMASK
  #undef START
  #undef RESC
  #undef ROT
}
constexpr int ATTN_LDS_BYTES=LDS_BYTES;
struct AttnTensors { const bf16* Q; const bf16* K; const bf16* V; bf16* O; };
struct AttnUnit { int bh; int qb; };
struct StaticOrder {
  int vcu;
  __device__ __forceinline__ explicit StaticOrder(int grid,int block):vcu((block%8)*(grid/8)+block/8){}
  __device__ __forceinline__ bool next(int i,AttnUnit&u)const{ if(i>=4)return false; const int s=vcu&7; u.bh=vcu>>3; u.qb=(i==0)?s:(i==1)?15-s:(i==2)?16+s:31-s; return true; }
  __device__ __forceinline__ void a_ready(const AttnUnit&)const{}
  __device__ __forceinline__ void done(const AttnUnit&)const{}
};
template<class Sched,int THRL=8> __device__ __forceinline__ void attn_phase(char*lds,const AttnTensors&T,const Sched&S){
  AttnUnit u;
  for(int i=0;S.next(i,u);++i){ S.a_ready(u); attn_unit<THRL>(u.bh/NHEAD,u.bh%NHEAD,u.qb,T.Q,T.K,T.V,T.O,lds); S.done(u); }
}
#undef SBAR
#undef WAIT_BAR
}
#define GAS __attribute__((address_space(1)))
#define LAS __attribute__((address_space(3)))
typedef unsigned short bf16;
typedef unsigned v4u __attribute__((ext_vector_type(4)));
typedef float f32x4 __attribute__((ext_vector_type(4)));
typedef short bf16x8 __attribute__((ext_vector_type(8)));
typedef GAS unsigned gu32;
typedef GAS unsigned long long gu64;
#define RLX_AGENT __ATOMIC_RELAXED, __HIP_MEMORY_SCOPE_AGENT
#define LDS_WAIT() asm volatile("s_waitcnt lgkmcnt(0)" ::: "memory")
#define VM_WAIT() asm volatile("s_waitcnt vmcnt(0)" ::: "memory")
__device__ __forceinline__ unsigned long long rt() { return __builtin_amdgcn_s_memrealtime(); }
__device__ __forceinline__ unsigned f2bf(float f) { unsigned u = __builtin_bit_cast(unsigned, f); return (u + 0x7fffu + ((u >> 16) & 1u)) >> 16; }
__device__ __forceinline__ unsigned pk2(float lo, float hi) { return f2bf(lo) | (f2bf(hi) << 16); }

#define XB_TMO      128
#define XB_XCNT(j)  (256  + 64 * (j))
#define XB_XSUB(j)  (1280 + 64 * (j))
#define XB_XGEN(j)  (2304 + 64 * (j))
#define XB_TOP      3328
#define XB_TOPGEN   3392
#define XCD_BAR_WORDS 3456
#define XB_SPIN_CAP (1u << 18)

__device__ __forceinline__ unsigned xb_ld(unsigned* p)              { return __hip_atomic_load(p, __ATOMIC_RELAXED, __HIP_MEMORY_SCOPE_AGENT); }
__device__ __forceinline__ unsigned xb_add(unsigned* p, unsigned v) { return __hip_atomic_fetch_add(p, v, __ATOMIC_RELAXED, __HIP_MEMORY_SCOPE_AGENT); }
__device__ __forceinline__ unsigned xb_xcc_id() { return (unsigned)__builtin_amdgcn_s_getreg((3 << 11) | 20) & 0xFu; }
#define XB_SPIN(cond, bar) do { unsigned _sp = 0; while (cond) { __builtin_amdgcn_s_sleep(1); \
    if ((++_sp & 255u) == 0u) { if (xb_ld(&(bar)[XB_TMO])) break; if (_sp > XB_SPIN_CAP) { atomicAdd(&(bar)[XB_TMO], 1u); break; } } } } while (0)

struct XcdBarrier {
    unsigned* bar; unsigned x;
    volatile LAS unsigned* st;
};

__device__ __forceinline__ XcdBarrier xcd_barrier_post(unsigned* bar, volatile LAS unsigned* st) {
    XcdBarrier b; b.bar = bar; b.x = xb_xcc_id(); b.st = st;
    if (threadIdx.x == 0) (void)xb_add(&bar[XB_XCNT(b.x)], 1u);
    return b;
}
__device__ __forceinline__ void xcd_barrier_complete(unsigned* bar, unsigned x, unsigned& nloc, unsigned& nx) {
    const unsigned G = gridDim.x * gridDim.y * gridDim.z;
    unsigned sum, cnt, mine, sp = 0u;
    for (;;) {
        sum = 0u; cnt = 0u; mine = 0u;
#pragma unroll
        for (unsigned j = 0; j < 16; ++j) { const unsigned c = xb_ld(&bar[XB_XCNT(j)]); sum += c; cnt += (c > 0u) ? 1u : 0u; mine = (j == x) ? c : mine; }
        if (sum == G) break;
        __builtin_amdgcn_s_sleep(1);
        if ((++sp & 255u) == 0u) { if (xb_ld(&bar[XB_TMO])) break; if (sp > XB_SPIN_CAP) { atomicAdd(&bar[XB_TMO], 1u); break; } }
    }
    nloc = mine > 0u ? mine : 1u; nx = cnt > 0u ? cnt : 1u;
}

__device__ __forceinline__ void xcd_barrier(const XcdBarrier& b) {
    asm volatile("s_waitcnt vmcnt(0)" ::: "memory");
    __syncthreads();
    if (threadIdx.x == 0) {
        unsigned* bar = b.bar;
        __builtin_amdgcn_s_waitcnt(0);
        unsigned nloc = b.st[0], nx = b.st[1];
        if (nloc == 0u) { xcd_barrier_complete(bar, b.x, nloc, nx); b.st[0] = nloc; b.st[1] = nx; }
        const unsigned old = xb_add(&bar[XB_XSUB(b.x)], 1u);
        const unsigned gen = old / nloc;
        if (old + 1u == (gen + 1u) * nloc) {
            __builtin_amdgcn_fence(__ATOMIC_RELEASE, "agent");
            asm volatile("s_waitcnt vmcnt(0)" ::: "memory");
            const unsigned og = xb_add(&bar[XB_TOP], 1u);
            const unsigned tg = og / nx;
            if (og + 1u == (tg + 1u) * nx) xb_add(&bar[XB_TOPGEN], 1u);
            else XB_SPIN(xb_ld(&bar[XB_TOPGEN]) == tg, bar);
            __builtin_amdgcn_fence(__ATOMIC_ACQUIRE, "agent");
            xb_add(&bar[XB_XGEN(b.x)], 1u);
            asm volatile("s_waitcnt vmcnt(0)" ::: "memory");
        } else {
            XB_SPIN(xb_ld(&bar[XB_XGEN(b.x)]) == gen, bar);
            __builtin_amdgcn_fence(__ATOMIC_ACQUIRE, "agent");
            asm volatile("s_waitcnt vmcnt(0)" ::: "memory");
        }
    }
    __syncthreads();
}
constexpr int NWAVES = 8;
constexpr int BATCH = 2, SEQ = 8192, D = 1024, M = BATCH * SEQ, DEPTH = 2, INC = 7168;
constexpr float LN_EPS = 1e-5f, ALPHA = 1.4142135623730951f, LOG2E = 1.4426950408889634f;
constexpr size_t MiB = 1u << 20;
constexpr size_t WS_CTL = 0, CTL_ZERO_BYTES = 1 * MiB;
constexpr size_t WS_WIN = 2 * MiB;
constexpr size_t WS_WBR = 30 * MiB;
constexpr size_t WS_WOUT = 36 * MiB;
constexpr size_t WS_WQ = 40 * MiB;
constexpr size_t WS_SUBK = 48 * MiB;
constexpr size_t WS_ROPEC = 49 * MiB, WS_ROPES = 51 * MiB;
constexpr size_t WS_LRUW = 53 * MiB;
constexpr size_t WS_MISC = 54 * MiB;
constexpr size_t WS_U = 56 * MiB, WS_V = 88 * MiB;
constexpr size_t WS_SU = 55 * MiB, WS_SV = 55 * MiB + 131072;
constexpr size_t WS_HB = 120 * MiB;
constexpr size_t WS_HL = WS_HB, WS_PP = 152 * MiB;
constexpr size_t WS_AQK = 184 * MiB;
constexpr size_t WS_AVT = 216 * MiB;
constexpr size_t WS_CQK = 232 * MiB;
constexpr size_t WS_CV = 264 * MiB;
constexpr size_t WS_BXG = 280 * MiB;
constexpr size_t WS_GATES = 312 * MiB;
constexpr size_t WS_YA = 408 * MiB, WS_YB = 424 * MiB, WS_YC = 440 * MiB;
constexpr size_t WS_CO = 456 * MiB;
constexpr size_t WS_END = 488 * MiB;
constexpr size_t WS_MERGEF = 184 * MiB;
constexpr size_t WS_MERGED = 248 * MiB;
constexpr size_t WS_YF = 312 * MiB;
constexpr size_t WS_PQ = 184 * MiB;
constexpr size_t WS_EIDX = 248 * MiB, WS_EG = 256 * MiB;
constexpr size_t WS_DBGH1 = 376 * MiB;
constexpr int CW_BAR = 4096;

constexpr int RING_OFF = 0, RING_BYTES = 131072;
constexpr int LDSCTL_OFF = RING_BYTES, MISC_OFF = LDSCTL_OFF + 320;
constexpr int LDS_BYTES = 147456;

typedef unsigned short bf16;
__device__ __forceinline__ float bf2f(unsigned short b) { return __uint_as_float((unsigned)b << 16); }
__device__ __forceinline__ float gelu_tanh(float x) {
    const float t = 1.5957691216057308f * (x + 0.044715f * x * x * x);
    return x * __builtin_amdgcn_rcpf(1.0f + __builtin_amdgcn_exp2f(-LOG2E * t));
}
__device__ __forceinline__ float wave_sum(float v) {
#pragma unroll
    for (int o = 1; o < 64; o <<= 1) v += __shfl_xor(v, o);
    return v;
}
typedef __bf16 bf16x2v __attribute__((ext_vector_type(2)));
__device__ __forceinline__ float dot2bf(unsigned a, unsigned b, float acc) { return __builtin_amdgcn_fdot2_f32_bf16(__builtin_bit_cast(bf16x2v, a), __builtin_bit_cast(bf16x2v, b), acc, false); }
typedef float f32x16 __attribute__((ext_vector_type(16)));
typedef unsigned u32x2e __attribute__((ext_vector_type(2)));
typedef int i32x4e __attribute__((ext_vector_type(4)));
#define MFMA32(a, b, c) __builtin_amdgcn_mfma_f32_32x32x16_bf16(a, b, c, 0, 0, 0)
#define MFMA16(a, b, c) __builtin_amdgcn_mfma_f32_16x16x32_bf16(a, b, c, 0, 0, 0)

__device__ __forceinline__ void p0_transpose_item(const float* W, int K, int N, bf16* WT, int perm_lo, int perm_hi, LAS float* scr, int item, int lane) {
    const int nblk = N / 32, kb = item / nblk, nb = item % nblk, k0 = 64 * kb, n0 = 32 * nb;
#pragma unroll 8
    for (int i = 0; i < 32; ++i) { const int kk = 2 * i + (lane >> 5); scr[kk * 33 + (lane & 31)] = W[(size_t)(k0 + kk) * N + n0 + (lane & 31)]; }
    LDS_WAIT(); asm volatile("" ::: "memory");
    const int c = lane & 7;
#pragma unroll
    for (int j = 0; j < 4; ++j) { const int n = (lane >> 3) + 8 * j; const LAS float* s = scr + (8 * c) * 33 + n;
        v4u o; o.x = pk2(s[0 * 33], s[1 * 33]); o.y = pk2(s[2 * 33], s[3 * 33]); o.z = pk2(s[4 * 33], s[5 * 33]); o.w = pk2(s[6 * 33], s[7 * 33]);
        int dn = n0 + n; if (dn >= perm_lo && dn < perm_hi) dn = (dn & ~63) + 2 * (dn & 31) + ((dn >> 5) & 1);
        *(GAS v4u*)(WT + (size_t)dn * K + k0 + 8 * c) = o; }
    LDS_WAIT(); asm volatile("" ::: "memory");
}
__device__ __forceinline__ void cvt_stream(const float* src, bf16* dst, size_t n8, size_t gt, size_t ngt) {
    for (size_t i = gt; i < n8; i += ngt) { const f32x4 a = *(const GAS f32x4*)(src + 8 * i), b = *(const GAS f32x4*)(src + 8 * i + 4);
        v4u o; o.x = pk2(a.x, a.y); o.y = pk2(a.z, a.w); o.z = pk2(b.x, b.y); o.w = pk2(b.z, b.w); *(GAS v4u*)(dst + 8 * i) = o; }
}
typedef float f32x2q __attribute__((ext_vector_type(2)));
__device__ __forceinline__ void quant_row_fp8(const float* src, unsigned char* dst, float* scale, int lane) {
    f32x4 v[4]; float am = 0.f;
#pragma unroll
    for (int j = 0; j < 4; ++j) { v[j] = *(const GAS f32x4*)(src + 16 * lane + 4 * j); am = fmaxf(am, fmaxf(fmaxf(fabsf(v[j].x), fabsf(v[j].y)), fmaxf(fabsf(v[j].z), fabsf(v[j].w)))); }
#pragma unroll
    for (int o = 1; o < 64; o <<= 1) am = fmaxf(am, __shfl_xor(am, o));
    const float sc = am > 0.f ? am * (1.0f / 448.0f) : 1.0f, inv = 1.0f / sc;
    v4u w; unsigned ww[4];
#pragma unroll
    for (int j = 0; j < 4; ++j) { int t = __builtin_amdgcn_cvt_pk_fp8_f32(v[j].x * inv, v[j].y * inv, 0, false); t = __builtin_amdgcn_cvt_pk_fp8_f32(v[j].z * inv, v[j].w * inv, t, true); ww[j] = (unsigned)t; }
    w.x = ww[0]; w.y = ww[1]; w.z = ww[2]; w.w = ww[3];
    *(GAS v4u*)(dst + 16 * lane) = w;
    if (lane == 0) *scale = sc;
}
__device__ __forceinline__ void b1_unit(int l, int unit, LAS unsigned char* lds, const bf16* BXG, const bf16* LRUW, const float* conv_w, const float* conv_b,
                                        const float* b_r, const float* b_i, const float* lam, float* HL, float* PP, int tid, int wid, int lane) {
    const int b = unit >> 9, c = (unit >> 2) & 127, qt = unit & 3;
    LAS float* XC = (LAS float*)lds;
    LAS float* IG = (LAS float*)(lds + 32768);
    LAS bf16* XB = (LAS bf16*)(lds + 65536);
    {
        const int ch = tid & 127, tq = tid >> 7, gc = qt * 128 + ch, s0 = c * 64 + tq * 16;
        const float w0 = conv_w[(l * 4 + 0) * 512 + gc], w1 = conv_w[(l * 4 + 1) * 512 + gc], w2 = conv_w[(l * 4 + 2) * 512 + gc], w3 = conv_w[(l * 4 + 3) * 512 + gc], cb = conv_b[l * 512 + gc];
        const bf16* bx = BXG + (size_t)b * SEQ * 1024 + gc;
        float xm3 = (s0 >= 3) ? bf2f(bx[(size_t)(s0 - 3) * 1024]) : 0.f, xm2 = (s0 >= 2) ? bf2f(bx[(size_t)(s0 - 2) * 1024]) : 0.f, xm1 = (s0 >= 1) ? bf2f(bx[(size_t)(s0 - 1) * 1024]) : 0.f;
#pragma unroll 4
        for (int t = 0; t < 16; ++t) { const float x0 = bf2f(bx[(size_t)(s0 + t) * 1024]); const float xc = cb + xm3 * w0 + xm2 * w1 + xm1 * w2 + x0 * w3;
            XC[(tq * 16 + t) * 128 + ch] = xc; XB[(tq * 16 + t) * 136 + ch] = (bf16)f2bf(xc); xm3 = xm2; xm2 = xm1; xm1 = x0; }
    }
    __syncthreads();
    const int blk = wid & 1, gate = (wid >> 1) & 1, th = wid >> 2, g = qt * 2 + blk, fr = lane & 15, fq = lane >> 4;
    f32x4 acc[2][4];
#pragma unroll
    for (int mt = 0; mt < 2; ++mt)
#pragma unroll
        for (int nt = 0; nt < 4; ++nt) acc[mt][nt] = (f32x4){0.f, 0.f, 0.f, 0.f};
    {
        const bf16* wb = LRUW + (size_t)(((l * 2 + gate) * 8 + g) * 64) * 64;
#pragma unroll
        for (int ks = 0; ks < 2; ++ks) { bf16x8 af[2], bfr[4];
#pragma unroll
            for (int mt = 0; mt < 2; ++mt) af[mt] = *(const LAS bf16x8*)(XB + (th * 32 + mt * 16 + fr) * 136 + blk * 64 + ks * 32 + 8 * fq);
#pragma unroll
            for (int nt = 0; nt < 4; ++nt) bfr[nt] = *(const GAS bf16x8*)(wb + (nt * 16 + fr) * 64 + ks * 32 + 8 * fq);
#pragma unroll
            for (int mt = 0; mt < 2; ++mt)
#pragma unroll
                for (int nt = 0; nt < 4; ++nt) acc[mt][nt] = MFMA16(af[mt], bfr[nt], acc[mt][nt]); }
    }
    const float* bias = (gate ? b_i : b_r) + (l * 8 + g) * 64;
#pragma unroll
    for (int nt = 0; nt < 4; ++nt) { const float bj = bias[nt * 16 + fr];
#pragma unroll
        for (int mt = 0; mt < 2; ++mt)
#pragma unroll
            for (int e = 0; e < 4; ++e) acc[mt][nt][e] = pg8::sigm(acc[mt][nt][e] + bj); }
    if (gate == 1) {
#pragma unroll
        for (int nt = 0; nt < 4; ++nt)
#pragma unroll
            for (int mt = 0; mt < 2; ++mt)
#pragma unroll
                for (int e = 0; e < 4; ++e) IG[(th * 32 + mt * 16 + 4 * fq + e) * 128 + blk * 64 + nt * 16 + fr] = acc[mt][nt][e];
    }
    __syncthreads();
    if (gate == 0) {
#pragma unroll
        for (int nt = 0; nt < 4; ++nt) { const float lm = lam[l * 512 + g * 64 + nt * 16 + fr];
            const float ls8 = -8.0f * log1pf(expf(-lm));
#pragma unroll
            for (int mt = 0; mt < 2; ++mt)
#pragma unroll
                for (int e = 0; e < 4; ++e) { const int o = (th * 32 + mt * 16 + 4 * fq + e) * 128 + blk * 64 + nt * 16 + fr;
                    const float la = acc[mt][nt][e] * ls8, a = expf(la), mult = sqrtf(-expm1f(2.0f * la));
                    const float u = mult * (IG[o] * XC[o]); IG[o] = a; XC[o] = u; } }
    }
    __syncthreads();
    if (tid < 128) { float h = 0.f, p = 1.f; const size_t o0 = ((size_t)b * SEQ + c * 64) * 512 + qt * 128 + tid;
#pragma unroll 8
        for (int t = 0; t < 64; ++t) { const float a = IG[t * 128 + tid], u = XC[t * 128 + tid]; h = a * h + u; p *= a; HL[o0 + (size_t)t * 512] = h; PP[o0 + (size_t)t * 512] = p; } }
    __syncthreads();
}
__device__ __forceinline__ void b3_unit(int unit, const float* HL, const float* PP, const bf16* BXG, bf16* YB, int tid) {
    const int b = unit >> 7, c = unit & 127; float hin = 0.f;
    const size_t base = (size_t)b * SEQ * 512 + tid;
#pragma unroll 4
    for (int cc = 0; cc < c; ++cc) { const size_t o = base + (size_t)(cc * 64 + 63) * 512; hin = PP[o] * hin + HL[o]; }
#pragma unroll 4
    for (int t = 0; t < 64; ++t) { const size_t row = (size_t)b * SEQ + c * 64 + t; const float h = HL[row * 512 + tid] + PP[row * 512 + tid] * hin;
        YB[row * 512 + tid] = (bf16)f2bf(h * gelu_tanh(bf2f(BXG[row * 1024 + 512 + tid]))); }
}
struct BandCtx { const bf16* kbase; const bf16* vbase; const float* rb; int qpos, hi; };
__device__ __forceinline__ void band_ldk(bf16x8 (&kf)[8], const BandCtx& cx, int j) {
    const bf16* kp = cx.kbase + (size_t)j * 64 * 1024;
#pragma unroll
    for (int ks = 0; ks < 4; ++ks) { kf[ks] = *(const GAS bf16x8*)(kp + ks * 16); kf[4 + ks] = *(const GAS bf16x8*)(kp + 32 * 1024 + ks * 16); }
}
__device__ __forceinline__ void band_tile(const bf16x8 (&kf)[8], bf16x8 (&kn)[8], bool has_next, const bf16x8 (&qf)[4], const BandCtx& cx, int j, f32x16& o0, f32x16& o1, float& mrun, float& lsum) {
    bf16x8 vf[8];
    { const bf16* vp = cx.vbase + (size_t)j * 64;
#pragma unroll
      for (int t4 = 0; t4 < 4; ++t4) { vf[t4] = *(const GAS bf16x8*)(vp + t4 * 16); vf[4 + t4] = *(const GAS bf16x8*)(vp + (size_t)32 * M + t4 * 16); } }
    if (has_next) band_ldk(kn, cx, j + 1);
    f32x16 s0 = {}, s1 = {};
#pragma unroll
    for (int ks = 0; ks < 4; ++ks) { s0 = MFMA32(kf[ks], qf[ks], s0); s1 = MFMA32(kf[4 + ks], qf[ks], s1); }
    float mx = -1e30f;
#pragma unroll
    for (int r = 0; r < 16; ++r) { const int kpos = j * 64 + (r & 3) + 4 * ((r >> 2) & 1) + 8 * cx.hi + 16 * (r >> 3);
        int d0 = cx.qpos - kpos, d1 = d0 - 32; d0 = d0 < -63 ? -63 : (d0 > 256 ? 256 : d0); d1 = d1 < -63 ? -63 : (d1 > 256 ? 256 : d1);
        s0[r] += cx.rb[d0 + 63]; s1[r] += cx.rb[d1 + 63]; mx = fmaxf(mx, fmaxf(s0[r], s1[r])); }
    mx = fmaxf(mx, __shfl_xor(mx, 32));
    const float mnew = fmaxf(mrun, mx), al = __builtin_amdgcn_exp2f(mrun - mnew); mrun = mnew;
    float ps = 0.f;
#pragma unroll
    for (int r = 0; r < 16; ++r) { s0[r] = __builtin_amdgcn_exp2f(s0[r] - mnew); s1[r] = __builtin_amdgcn_exp2f(s1[r] - mnew); ps += s0[r] + s1[r]; }
    lsum = lsum * al + ps;
#pragma unroll
    for (int r = 0; r < 16; ++r) { o0[r] *= al; o1[r] *= al; }
#pragma unroll
    for (int kb = 0; kb < 2; ++kb)
#pragma unroll
        for (int s2 = 0; s2 < 2; ++s2) { const f32x16& sv = kb ? s1 : s0; pg8::u32x4 pw;
            pw.x = pg8::cvt_pk_bf16(sv[8 * s2 + 0], sv[8 * s2 + 1]); pw.y = pg8::cvt_pk_bf16(sv[8 * s2 + 2], sv[8 * s2 + 3]);
            pw.z = pg8::cvt_pk_bf16(sv[8 * s2 + 4], sv[8 * s2 + 5]); pw.w = pg8::cvt_pk_bf16(sv[8 * s2 + 6], sv[8 * s2 + 7]);
            const bf16x8 pf = __builtin_bit_cast(bf16x8, pw);
            o0 = MFMA32(vf[kb * 2 + s2], pf, o0); o1 = MFMA32(vf[4 + kb * 2 + s2], pf, o1); }
}
__device__ __forceinline__ void band_unit(int unit, const bf16* AQK, const bf16* AVT, const float* rbl  , bf16* YA, int head, int lane) {
    const int b = unit >> 7, c = unit & 127, r32 = lane & 31, hi = lane >> 5;
    const int kap = (r32 & ~12) | ((r32 & 4) << 1) | ((r32 & 8) >> 1);
    const int j0 = c >= 8 ? c - 8 : 0;
    for (int qh = 0; qh < 2; ++qh) {
        const size_t qrow = (size_t)b * SEQ + c * 64 + qh * 32 + r32;
        BandCtx cx; cx.kbase = AQK + ((size_t)b * SEQ + kap) * 1024 + 512 + head * 64 + hi * 8; cx.vbase = AVT + ((size_t)(head * 64 + r32)) * M + (size_t)b * SEQ + 8 * hi;
        cx.rb = rbl; cx.qpos = c * 64 + qh * 32 + r32; cx.hi = hi;
        bf16x8 qf[4];
#pragma unroll
        for (int ks = 0; ks < 4; ++ks) qf[ks] = *(const GAS bf16x8*)(AQK + qrow * 1024 + head * 64 + ks * 16 + hi * 8);
        f32x16 o0 = {}, o1 = {}; float mrun = -1e30f, lsum = 0.f;
        bf16x8 kA[8], kB[8];
        band_ldk(kA, cx, j0);
        int j = j0;
        for (; j + 1 <= c; j += 2) { band_tile(kA, kB, true, qf, cx, j, o0, o1, mrun, lsum); band_tile(kB, kA, j + 2 <= c, qf, cx, j + 1, o0, o1, mrun, lsum); }
        if (j <= c) band_tile(kA, kB, false, qf, cx, j, o0, o1, mrun, lsum);
        lsum += __shfl_xor(lsum, 32);
        const float rl = 1.0f / lsum;
        bf16* yp = YA + qrow * 512 + head * 64 + 4 * hi;
#pragma unroll
        for (int g4 = 0; g4 < 4; ++g4) {
            u32x2e w0, w1; w0.x = pg8::cvt_pk_bf16(o0[4 * g4] * rl, o0[4 * g4 + 1] * rl); w0.y = pg8::cvt_pk_bf16(o0[4 * g4 + 2] * rl, o0[4 * g4 + 3] * rl);
            w1.x = pg8::cvt_pk_bf16(o1[4 * g4] * rl, o1[4 * g4 + 1] * rl); w1.y = pg8::cvt_pk_bf16(o1[4 * g4 + 2] * rl, o1[4 * g4 + 3] * rl);
            *(GAS u32x2e*)(yp + 8 * g4) = w0; *(GAS u32x2e*)(yp + 32 + 8 * g4) = w1; }
    }
}
__device__ __forceinline__ void comb_row(size_t row, const bf16* CO, const float* subg, float lamv, float oml, bf16* YC, int lane) {
    const pg8::u32x4 a = *(const GAS pg8::u32x4*)(CO + row * 1024 + 16 * lane), bq = *(const GAS pg8::u32x4*)(CO + row * 1024 + 16 * lane + 8);
    float v[16]; const unsigned w[8] = {a.x, a.y, a.z, a.w, bq.x, bq.y, bq.z, bq.w};
#pragma unroll
    for (int i = 0; i < 8; ++i) { v[2 * i] = __uint_as_float(w[i] << 16); v[2 * i + 1] = __uint_as_float(w[i] & 0xffff0000u); }
    float ss = 0.f;
#pragma unroll
    for (int i = 0; i < 16; ++i) { const float o2 = __shfl_xor(v[i], 8); v[i] = v[i] - lamv * o2; ss += v[i] * v[i]; }
    ss += __shfl_xor(ss, 1); ss += __shfl_xor(ss, 2); ss += __shfl_xor(ss, 4);
    const float rs = 1.0f / sqrtf(ss * (1.0f / 128.0f) + LN_EPS) * oml;
    if ((lane & 8) == 0) { const int h = lane >> 4, e0 = (lane & 7) * 16;
        unsigned ow[8];
#pragma unroll
        for (int i = 0; i < 8; ++i) ow[i] = pk2(v[2 * i] * rs * subg[e0 + 2 * i], v[2 * i + 1] * rs * subg[e0 + 2 * i + 1]);
        bf16* yp = YC + row * 512 + h * 128 + e0;
        *(GAS pg8::u32x4*)yp = (pg8::u32x4){ow[0], ow[1], ow[2], ow[3]}; *(GAS pg8::u32x4*)(yp + 8) = (pg8::u32x4){ow[4], ow[5], ow[6], ow[7]}; }
}
__device__ __forceinline__ void ln_row(const float* yrow, const float* g, const float* bta, float* hf, bf16* hb, float* dbg, int lane) {
    const GAS f32x4* xr = (const GAS f32x4*)yrow + lane;
    f32x4 v[4]; float s = 0.f;
#pragma unroll
    for (int j = 0; j < 4; ++j) { v[j] = xr[64 * j]; s += (v[j].x + v[j].y) + (v[j].z + v[j].w); }
    const float mean = wave_sum(s) * (1.f / D); float s2 = 0.f;
#pragma unroll
    for (int j = 0; j < 4; ++j) { v[j] = v[j] - mean; s2 += (v[j].x * v[j].x + v[j].y * v[j].y) + (v[j].z * v[j].z + v[j].w * v[j].w); }
    const float rstd = 1.f / sqrtf(wave_sum(s2) * (1.f / D) + LN_EPS);
#pragma unroll
    for (int j = 0; j < 4; ++j) { const f32x4 gg = *(const GAS f32x4*)(g + 4 * lane + 256 * j), bb = *(const GAS f32x4*)(bta + 4 * lane + 256 * j);
        const f32x4 o = v[j] * rstd * gg + bb;
        *((GAS f32x4*)hf + lane + 64 * j) = o; if (dbg) *((GAS f32x4*)dbg + lane + 64 * j) = o;
        *((GAS unsigned long long*)hb + lane + 64 * j) = (unsigned long long)pk2(o.x, o.y) | ((unsigned long long)pk2(o.z, o.w) << 32); }
}
__device__ __forceinline__ unsigned ordkey(float f) { unsigned u = __float_as_uint(f); return u ^ ((unsigned)((int)u >> 31) | 0x80000000u); }
__device__ __forceinline__ float ordval(unsigned k) { return __uint_as_float(k ^ ((k & 0x80000000u) ? 0x80000000u : 0xffffffffu)); }
#define INS16(L, x) do { _Pragma("unroll") for (int i_ = 0; i_ < 16; ++i_) { const unsigned h_ = L[i_] > x ? L[i_] : x; x = L[i_] > x ? x : L[i_]; L[i_] = h_; } } while (0)
__device__ __forceinline__ void topk_unit(int unit, const bf16* PQ, const bf16* SUBK, int* EIDX, float* EG, LAS unsigned* wl  , int lane) {
    const int tt = unit >> 3, hh = unit & 7, r32 = lane & 31, hi = lane >> 5;
    const size_t trow = (size_t)tt * 32 + r32;
    unsigned S[2][16];
#pragma unroll
    for (int p = 0; p < 2; ++p) {
        bf16x8 qf[8];
#pragma unroll
        for (int ks = 0; ks < 8; ++ks) qf[ks] = *(const GAS bf16x8*)(PQ + trow * 2048 + (hh * 2 + p) * 128 + ks * 16 + hi * 8);
        unsigned L[16];
#pragma unroll
        for (int i = 0; i < 16; ++i) L[i] = 0u;
        const bf16* kb = SUBK + (size_t)((hh * 2 + p) * 128 + r32) * 128 + hi * 8;
#pragma unroll
        for (int rt = 0; rt < 4; ++rt) { f32x16 acc = {}; const bf16* kr = kb + (size_t)rt * 32 * 128; asm volatile("" : "+v"(kr));
#pragma unroll
            for (int ks = 0; ks < 8; ++ks) { const bf16x8 kf = *(const GAS bf16x8*)(kr + ks * 16); acc = MFMA32(kf, qf[ks], acc); }
#pragma unroll
            for (int r = 0; r < 16; ++r) { const int n = rt * 32 + (r & 3) + 8 * (r >> 2) + 4 * hi; unsigned x = (ordkey(acc[r]) & ~127u) | (unsigned)n; INS16(L, x); }
            asm volatile("" ::: "memory"); }
        unsigned Mx[16];
#pragma unroll
        for (int i = 0; i < 16; ++i) { const unsigned o = (unsigned)__shfl_xor((int)L[15 - i], 32); Mx[i] = L[i] > o ? L[i] : o; }
#pragma unroll
        for (int st = 8; st >= 1; st >>= 1)
#pragma unroll
            for (int i = 0; i < 16; ++i) if ((i & st) == 0) { const unsigned a = Mx[i], b2 = Mx[i + st]; Mx[i] = a > b2 ? a : b2; Mx[i + st] = a > b2 ? b2 : a; }
#pragma unroll
        for (int i = 0; i < 16; ++i) { S[p][i] = Mx[i]; wl[(p * 16 + i) * 64 + lane] = Mx[i]; }
    }
    unsigned F[16];
#pragma unroll
    for (int i = 0; i < 16; ++i) F[i] = 0u;
#pragma unroll
    for (int i = 0; i < 16; ++i)
#pragma unroll
        for (int j = 0; j < 16; ++j) if ((i + 1) * (j + 1) <= 16) { const float sm = ordval(S[0][i] & ~127u) + ordval(S[1][j] & ~127u); unsigned x = (ordkey(sm) & ~255u) | (unsigned)(i * 16 + j); INS16(F, x); }
    LDS_WAIT();
    float fs[16]; int ex[16]; float mx = -1e30f;
#pragma unroll
    for (int k = 0; k < 16; ++k) { const int i = (F[k] >> 4) & 15, j = F[k] & 15; const unsigned k0 = wl[i * 64 + lane], k1 = wl[(16 + j) * 64 + lane];
        fs[k] = ordval(k0 & ~127u) + ordval(k1 & ~127u); ex[k] = (int)((k0 & 127u) * 128u + (k1 & 127u)); mx = fmaxf(mx, fs[k]); }
    float sum = 0.f;
#pragma unroll
    for (int k = 0; k < 16; ++k) { fs[k] = __builtin_amdgcn_exp2f((fs[k] - mx) * LOG2E); sum += fs[k]; }
    const float rs = 1.0f / sum;
    if (hi == 0) { int* ep = EIDX + (trow * 8 + hh) * 16; float* gp = EG + (trow * 8 + hh) * 16;
#pragma unroll
        for (int q4 = 0; q4 < 4; ++q4) { *(GAS i32x4e*)(ep + 4 * q4) = (i32x4e){ex[4 * q4], ex[4 * q4 + 1], ex[4 * q4 + 2], ex[4 * q4 + 3]};
            *(GAS f32x4*)(gp + 4 * q4) = (f32x4){fs[4 * q4] * rs, fs[4 * q4 + 1] * rs, fs[4 * q4 + 2] * rs, fs[4 * q4 + 3] * rs}; } }
    LDS_WAIT();
}
__device__ __forceinline__ void deq16(const pg8::u32x4 w, float (&f)[16]) {
    const unsigned ww[4] = {w.x, w.y, w.z, w.w};
#pragma unroll
    for (int j = 0; j < 4; ++j) { const f32x2q a = __builtin_amdgcn_cvt_pk_f32_fp8((int)ww[j], false), b = __builtin_amdgcn_cvt_pk_f32_fp8((int)ww[j], true); f[4 * j] = a.x; f[4 * j + 1] = a.y; f[4 * j + 2] = b.x; f[4 * j + 3] = b.y; }
}
__device__ __forceinline__ void peer_row(size_t t, const float* hin, const int* EIDX, const float* EG, const unsigned char* U, const unsigned char* V, const float* SU, const float* SV,
                                         const float* g2, const float* b2, float* hf, bf16* hb, int lane) {
    float x[16];
#pragma unroll
    for (int j = 0; j < 4; ++j) { const f32x4 v = *(const GAS f32x4*)(hin + t * 1024 + 16 * lane + 4 * j); x[4 * j] = v.x; x[4 * j + 1] = v.y; x[4 * j + 2] = v.z; x[4 * j + 3] = v.w; }
    float o[16];
#pragma unroll
    for (int i = 0; i < 16; ++i) o[i] = 0.f;
    const int ei0 = EIDX[t * 128 + lane], ei1 = EIDX[t * 128 + 64 + lane];
    const float gs0 = EG[t * 128 + lane] * SV[ei0], gs1 = EG[t * 128 + 64 + lane] * SV[ei1];
    const float su0 = SU[ei0], su1 = SU[ei1];
    const int b5 = lane >> 5, b4 = (lane >> 4) & 1, b3 = (lane >> 3) & 1, b2_ = (lane >> 2) & 1, eloc = b5 * 8 + b4 * 4 + b3 * 2 + b2_;
    for (int grp = 0; grp < 8; ++grp) {
        const int src = grp < 4 ? ei0 : ei1; const float gsrc = grp < 4 ? gs0 : gs1, susrc = grp < 4 ? su0 : su1; const int l0 = (grp & 3) * 16;
        pg8::u32x4 ua[16], va[16];
#pragma unroll
        for (int e = 0; e < 16; ++e) { const int idx = __builtin_amdgcn_readlane(src, l0 + e); ua[e] = *(const GAS pg8::u32x4*)(U + (size_t)idx * 1024 + 16 * lane); va[e] = *(const GAS pg8::u32x4*)(V + (size_t)idx * 1024 + 16 * lane); }
        float p[16];
#pragma unroll
        for (int e = 0; e < 16; ++e) { float f[16]; deq16(ua[e], f); float a = 0.f;
#pragma unroll
            for (int i = 0; i < 16; ++i) a += f[i] * x[i];
            p[e] = a; }
        float q8[8], q4[4], q2[2], s;
#pragma unroll
        for (int i = 0; i < 8; ++i) { const float keep = b5 ? p[i + 8] : p[i], send = b5 ? p[i] : p[i + 8]; q8[i] = keep + __shfl_xor(send, 32); }
#pragma unroll
        for (int i = 0; i < 4; ++i) { const float keep = b4 ? q8[i + 4] : q8[i], send = b4 ? q8[i] : q8[i + 4]; q4[i] = keep + __shfl_xor(send, 16); }
#pragma unroll
        for (int i = 0; i < 2; ++i) { const float keep = b3 ? q4[i + 2] : q4[i], send = b3 ? q4[i] : q4[i + 2]; q2[i] = keep + __shfl_xor(send, 8); }
        { const float keep = b2_ ? q2[1] : q2[0], send = b2_ ? q2[0] : q2[1]; s = keep + __shfl_xor(send, 4); }
        s += __shfl_xor(s, 2); s += __shfl_xor(s, 1);
        const float w = gelu_tanh(s * __shfl(susrc, l0 + eloc)) * __shfl(gsrc, l0 + eloc);
#pragma unroll
        for (int e = 0; e < 16; ++e) { const float we = __builtin_bit_cast(float, __builtin_amdgcn_readlane(__builtin_bit_cast(int, w), e * 4)); float f[16]; deq16(va[e], f);
#pragma unroll
            for (int i = 0; i < 16; ++i) o[i] += we * f[i]; }
    }
    float y[16]; float sm = 0.f;
#pragma unroll
    for (int i = 0; i < 16; ++i) { y[i] = ALPHA * x[i] + o[i]; sm += y[i]; }
    const float mean = wave_sum(sm) * (1.f / D); float s2 = 0.f;
#pragma unroll
    for (int i = 0; i < 16; ++i) { y[i] -= mean; s2 += y[i] * y[i]; }
    const float rstd = 1.f / sqrtf(wave_sum(s2) * (1.f / D) + LN_EPS);
    unsigned ow[8];
#pragma unroll
    for (int j = 0; j < 4; ++j) { const f32x4 gg = *(const GAS f32x4*)(g2 + 16 * lane + 4 * j), bb = *(const GAS f32x4*)(b2 + 16 * lane + 4 * j);
        f32x4 ov; ov.x = y[4 * j] * rstd * gg.x + bb.x; ov.y = y[4 * j + 1] * rstd * gg.y + bb.y; ov.z = y[4 * j + 2] * rstd * gg.z + bb.z; ov.w = y[4 * j + 3] * rstd * gg.w + bb.w;
        *(GAS f32x4*)(hf + t * 1024 + 16 * lane + 4 * j) = ov; ow[2 * j] = pk2(ov.x, ov.y); ow[2 * j + 1] = pk2(ov.z, ov.w); }
    *(GAS pg8::u32x4*)(hb + t * 1024 + 16 * lane) = (pg8::u32x4){ow[0], ow[1], ow[2], ow[3]}; *(GAS pg8::u32x4*)(hb + t * 1024 + 16 * lane + 8) = (pg8::u32x4){ow[4], ow[5], ow[6], ow[7]};
}
#if MK_DEBUG
struct Args;
#define DBG_WORDS 64
__device__ __forceinline__ unsigned dh(unsigned x) { x ^= x >> 16; x *= 0x7feb352dU; x ^= x >> 15; x *= 0x846ca68bU; x ^= x >> 16; return x; }
__device__ __forceinline__ void dbg_rec(unsigned* slot, float got, float want, float fl) {
    float e = fabsf(got - want) / (fabsf(want) + fl); if (!(e == e) || e > 1e30f) e = 1e30f; atomicMax(slot, __float_as_uint(e));
}
__device__ __forceinline__ float dbf(const bf16* p, size_t i) { return bf2f(p[i]); }
__device__ __forceinline__ float rbf(float x) { return bf2f((bf16)f2bf(x)); }
__device__ __forceinline__ float dsig(float x) { return 1.0f / (1.0f + expf(-x)); }
__device__ __forceinline__ float dgelu(float x) { return 0.5f * x * (1.0f + tanhf(0.7978845608028654f * (x + 0.044715f * x * x * x))); }
__device__ __forceinline__ float dq8(const unsigned char* p, size_t i) { const int w = *(const int*)(p + (i & ~(size_t)3)); const int b = (int)(i & 3); return b == 0 ? __builtin_amdgcn_cvt_f32_fp8(w, 0) : b == 1 ? __builtin_amdgcn_cvt_f32_fp8(w, 1) : b == 2 ? __builtin_amdgcn_cvt_f32_fp8(w, 2) : __builtin_amdgcn_cvt_f32_fp8(w, 3); }
struct DArgs { const void* in[24]; float* out; unsigned char* ws; float invf[32]; int p, pad; };
#define DW(T, off) ((T*)(a.ws + (off)))
__global__ void __launch_bounds__(256) dbg_kernel(DArgs a) {
    __shared__ float sh[1024 + 256 + 64];
    const int p = a.p, l = p == 0 ? 0 : (p - 1) / 10, q = p == 0 ? 100 : (p - 1) % 10, tid = threadIdx.x;
    unsigned* slot = DW(unsigned, WS_MISC) + 16 + p;
    const unsigned sid = blockIdx.x * 256 + tid; unsigned r = dh(sid * 2654435761u + 77u * p + 1u);
#define RND(n) ((r = dh(r + 0x9e3779b9u)) % (unsigned)(n))
    const bf16* WINl = DW(bf16, WS_WIN) + (size_t)l * INC * 1024;
    if (q == 100) {
        { const int ll = RND(2), n = RND(INC), k = RND(1024); int dn = n; if (n >= 2560 && n < 3584) dn = (n & ~63) + 2 * (n & 31) + ((n >> 5) & 1);
          dbg_rec(slot, dbf(DW(bf16, WS_WIN), ((size_t)ll * INC + dn) * 1024 + k), rbf(((const float*)a.in[2])[((size_t)ll * 1024 + k) * INC + n]), 1e-3f); }
        { const int qq = RND(6), n = RND(1024), k = RND(512); dbg_rec(slot, dbf(DW(bf16, WS_WBR), ((size_t)qq * 1024 + n) * 512 + k), rbf(((const float*)a.in[14])[((size_t)qq * 512 + k) * 1024 + n]), 1e-3f); }
        { const int ll = RND(2), n = RND(1024), k = RND(1024); dbg_rec(slot, dbf(DW(bf16, WS_WOUT), ((size_t)ll * 1024 + n) * 1024 + k), rbf(((const float*)a.in[15])[((size_t)ll * 1024 + k) * 1024 + n]), 1e-3f); }
        { const int ll = RND(2), n = RND(2048), k = RND(1024); dbg_rec(slot, dbf(DW(bf16, WS_WQ), ((size_t)ll * 2048 + n) * 1024 + k), rbf(((const float*)a.in[18])[((size_t)ll * 1024 + k) * 2048 + n]), 1e-3f); }
        { const size_t i = RND(524288); dbg_rec(slot, dbf(DW(bf16, WS_SUBK), i), rbf(((const float*)a.in[19])[i]), 1e-3f); }
        { const size_t i = (size_t)RND(16384) * 1024 + RND(1024); const size_t i2 = i + (size_t)RND(2) * 16384 * 1024; dbg_rec(slot, dq8(DW(unsigned char, WS_U), i2) * DW(float, WS_SU)[i2 >> 10], ((const float*)a.in[20])[i2], 0.01f); dbg_rec(slot, dq8(DW(unsigned char, WS_V), i2) * DW(float, WS_SV)[i2 >> 10], ((const float*)a.in[21])[i2], 0.1f);
          dbg_rec(slot, dbf(DW(bf16, WS_HB), i), rbf(((const float*)a.in[0])[i]), 1e-3f); }
        { const int row = RND(M), fi = RND(32); const float ang = (float)((const int*)a.in[1])[row] * a.invf[fi]; const double rev = (double)ang * 0.15915494309189535; const float fr = (float)(rev - rint(rev)) * 6.283185307179586f;
          dbg_rec(slot, DW(float, WS_ROPEC)[row * 32 + fi], cosf(fr), 0.05f); dbg_rec(slot, DW(float, WS_ROPES)[row * 32 + fi], sinf(fr), 0.05f); }
        { const int i = RND(131072); const int k = i & 63, j = (i >> 6) & 63, g = (i >> 12) & 7, gate = (i >> 15) & 1, ll = i >> 16;
          dbg_rec(slot, dbf(DW(bf16, WS_LRUW), i), rbf(((const float*)a.in[gate ? 9 : 7])[((size_t)(ll * 8 + g) * 64 + k) * 64 + j]), 1e-3f); }
    } else if (q == 0) {
        const int row = RND(M); int c = RND(INC) & ~1;
        const bf16* hb = DW(bf16, WS_HB) + (size_t)row * 1024; float z0 = 0.f, z1 = 0.f;
        for (int k = 0; k < 1024; ++k) { const float h = bf2f(hb[k]); z0 += h * dbf(WINl, (size_t)c * 1024 + k); z1 += h * dbf(WINl, (size_t)(c + 1) * 1024 + k); }
        float g0, g1; const float C2S = 0.125f * LOG2E;
        if (c < 512) { g0 = dbf(DW(bf16, WS_AQK), (size_t)row * 1024 + c); g1 = dbf(DW(bf16, WS_AQK), (size_t)row * 1024 + c + 1); z0 *= C2S; z1 *= C2S; }
        else if (c < 1024) { g0 = dbf(DW(bf16, WS_AQK), (size_t)row * 1024 + c); g1 = dbf(DW(bf16, WS_AQK), (size_t)row * 1024 + c + 1); }
        else if (c < 1536) { g0 = dbf(DW(bf16, WS_AVT), (size_t)(c - 1024) * M + row); g1 = dbf(DW(bf16, WS_AVT), (size_t)(c - 1023) * M + row); }
        else if (c < 2560) { g0 = dbf(DW(bf16, WS_BXG), (size_t)row * 1024 + c - 1536); g1 = dbf(DW(bf16, WS_BXG), (size_t)row * 1024 + c - 1535); }
        else if (c < 3584) { const int i = (c & 63) >> 1; const float cs = DW(float, WS_ROPEC)[row * 32 + i], sn = DW(float, WS_ROPES)[row * 32 + i]; const float sc = c < 3072 ? C2S : 1.f;
            const float o0 = (z0 * cs - z1 * sn) * sc, o1 = (z1 * cs + z0 * sn) * sc; z0 = o0; z1 = o1;
            g0 = dbf(DW(bf16, WS_CQK), (size_t)row * 1024 + c - 2560); g1 = dbf(DW(bf16, WS_CQK), (size_t)row * 1024 + c - 2559); }
        else if (c < 4096) { g0 = dbf(DW(bf16, WS_CV), (size_t)row * 512 + c - 3584); g1 = dbf(DW(bf16, WS_CV), (size_t)row * 512 + c - 3583); }
        else { const float* gb = (const float*)a.in[3] + l * 3072; z0 = dsig(z0 + gb[c - 4096]); z1 = dsig(z1 + gb[c - 4095]); g0 = dbf(DW(bf16, WS_GATES), (size_t)row * 3072 + c - 4096); g1 = dbf(DW(bf16, WS_GATES), (size_t)row * 3072 + c - 4095); }
        { const int sec = c < 512 ? 0 : c < 1024 ? 1 : c < 1536 ? 2 : c < 2560 ? 3 : c < 3072 ? 4 : c < 3584 ? 5 : c < 4096 ? 6 : 7; unsigned* s2 = DW(unsigned, WS_MISC) + 40 + sec; if (l == 0) { dbg_rec(s2, g0, z0, 0.05f); dbg_rec(s2, g1, z1, 0.05f); if (sec == 7) { unsigned* s3 = DW(unsigned, WS_MISC) + 48 + (c - 4096) / 256; dbg_rec(s3, g0, z0, 0.05f); dbg_rec(s3, g1, z1, 0.05f); } } }
        dbg_rec(slot, g0, z0, 0.05f); dbg_rec(slot, g1, z1, 0.05f);
    } else if (q == 1) {
        if (blockIdx.x < 16) {
        const int row = RND(M), ch = RND(512), b = row >> 13, s = row & 8191, t0 = s & ~63, g = ch >> 6, j = ch & 63;
        const bf16* bxg = DW(bf16, WS_BXG); const float* cw = (const float*)a.in[5] + l * 2048; const float* cb = (const float*)a.in[6] + l * 512;
        const bf16* wr = DW(bf16, WS_LRUW) + (size_t)(((l * 2 + 0) * 8 + g) * 64 + j) * 64; const bf16* wi = DW(bf16, WS_LRUW) + (size_t)(((l * 2 + 1) * 8 + g) * 64 + j) * 64;
        const float lm = ((const float*)a.in[11])[l * 512 + ch], ls8 = -8.0f * log1pf(expf(-lm));
        float h = 0.f, pp = 1.f;
        for (int t = t0; t <= s; ++t) { float ar = ((const float*)a.in[8])[(l * 8 + g) * 64 + j], ai = ((const float*)a.in[10])[(l * 8 + g) * 64 + j], xcm = 0.f;
            for (int k = 0; k < 64; ++k) { const int c2 = g * 64 + k; float xc = cb[c2];
                for (int tap = 0; tap < 4; ++tap) { const int tt = t - 3 + tap; if (tt >= 0) xc += dbf(bxg, ((size_t)b * SEQ + tt) * 1024 + c2) * cw[tap * 512 + c2]; }
                if (k == j) xcm = xc; const float xb = rbf(xc); ar += xb * bf2f(wr[k]); ai += xb * bf2f(wi[k]); }
            const float rg = dsig(ar), ig = dsig(ai), la = rg * ls8, av = expf(la), u = sqrtf(-expm1f(2.f * la)) * (ig * xcm); h = av * h + u; pp *= av; }
        dbg_rec(slot, DW(float, WS_HL)[(size_t)row * 512 + ch], h, 0.02f); dbg_rec(slot, DW(float, WS_PP)[(size_t)row * 512 + ch], pp, 0.02f); }
    } else if (q == 2) {
        if (blockIdx.x < 8) {
            const int row = RND(M), head = RND(8), d = RND(64), b = row >> 13, s = row & 8191, c = s >> 6, j0 = c >= 8 ? c - 8 : 0;
            const bf16* aqk = DW(bf16, WS_AQK); const bf16* avt = DW(bf16, WS_AVT); const float* rb = (const float*)a.in[4] + (l * 8 + head) * 320;
            float mx = -1e30f;
            for (int pass = 0; pass < 2; ++pass) { float den = 0.f, num = 0.f;
                for (int kp = j0 * 64; kp < (c + 1) * 64; ++kp) { float sc = 0.f; for (int k = 0; k < 64; ++k) sc += dbf(aqk, (size_t)row * 1024 + head * 64 + k) * dbf(aqk, ((size_t)b * SEQ + kp) * 1024 + 512 + head * 64 + k);
                    int dist = s - kp; dist = dist < -63 ? -63 : (dist > 256 ? 256 : dist); sc = sc / LOG2E + rb[dist + 63];
                    if (pass == 0) mx = fmaxf(mx, sc); else { const float e = expf(sc - mx); den += e; num += e * dbf(avt, (size_t)(head * 64 + d) * M + (size_t)b * SEQ + kp); } }
                if (pass == 1) dbg_rec(slot, dbf(DW(bf16, WS_YA), (size_t)row * 512 + head * 64 + d), num / den, 0.03f); }
        } else if (blockIdx.x < 24) {
            const int row = RND(M - 1) + 1, ch = RND(512), b = row >> 13, s = row & 8191, g = ch >> 6, j = ch & 63;
            if (s > 0) { const bf16* bxg = DW(bf16, WS_BXG); const float gp = dgelu(dbf(bxg, (size_t)(row - 1) * 1024 + 512 + ch)), gc = dgelu(dbf(bxg, (size_t)row * 1024 + 512 + ch));
              if (fabsf(gp) > 0.2f) { const float* cw = (const float*)a.in[5] + l * 2048; const float* cb = (const float*)a.in[6] + l * 512;
                const bf16* wr = DW(bf16, WS_LRUW) + (size_t)(((l * 2 + 0) * 8 + g) * 64 + j) * 64; const bf16* wi = DW(bf16, WS_LRUW) + (size_t)(((l * 2 + 1) * 8 + g) * 64 + j) * 64;
                const float lm = ((const float*)a.in[11])[l * 512 + ch], ls8 = -8.0f * log1pf(expf(-lm));
                float ar = ((const float*)a.in[8])[(l * 8 + g) * 64 + j], ai = ((const float*)a.in[10])[(l * 8 + g) * 64 + j], xcm = 0.f;
                for (int k = 0; k < 64; ++k) { const int c2 = g * 64 + k; float xc = cb[c2];
                    for (int tap = 0; tap < 4; ++tap) { const int tt = s - 3 + tap; if (tt >= 0) xc += dbf(bxg, ((size_t)b * SEQ + tt) * 1024 + c2) * cw[tap * 512 + c2]; }
                    if (k == j) xcm = xc; const float xb = rbf(xc); ar += xb * bf2f(wr[k]); ai += xb * bf2f(wi[k]); }
                const float la = dsig(ar) * ls8, av = expf(la), u = sqrtf(-expm1f(2.f * la)) * (dsig(ai) * xcm);
                const float hp = dbf(DW(bf16, WS_YB), (size_t)(row - 1) * 512 + ch) / gp;
                dbg_rec(slot, dbf(DW(bf16, WS_YB), (size_t)row * 512 + ch), (av * hp + u) * gc, 0.05f); } }
        } else if (blockIdx.x < 32) {
            const int row = RND(M), vj = RND(16), d = RND(64), b = row >> 13, s = row & 8191, kend = ((s >> 6) + 1) * 64;
            const int qcol = (vj >> 1) * 64, kcol = 512 + (vj >> 1) * 64, vcol = ((vj >> 2) * 2 + (vj & 1)) * 64;
            const bf16* cqk = DW(bf16, WS_CQK); const bf16* cv = DW(bf16, WS_CV);
            float mx = -1e30f;
            for (int pass = 0; pass < 2; ++pass) { float den = 0.f, num = 0.f;
                for (int kp = 0; kp < kend; ++kp) { float sc = 0.f; for (int k = 0; k < 64; ++k) sc += dbf(cqk, (size_t)row * 1024 + qcol + k) * dbf(cqk, ((size_t)b * SEQ + kp) * 1024 + kcol + k);
                    sc = sc / LOG2E;
                    if (pass == 0) mx = fmaxf(mx, sc); else { const float e = expf(sc - mx); den += e; num += e * dbf(cv, ((size_t)b * SEQ + kp) * 512 + vcol + d); } }
                if (pass == 1) dbg_rec(slot, dbf(DW(bf16, WS_CO), (size_t)row * 1024 + vj * 64 + d), num / den, 0.01f); }
        }
    } else if (q == 3) {
        const int row = RND(M), h = RND(4), e = RND(128); const bf16* co = DW(bf16, WS_CO) + (size_t)row * 1024; const float lamv = DW(float, WS_MISC)[l], oml = DW(float, WS_MISC)[2 + l];
        float ss = 0.f, oe = 0.f;
        for (int i = 0; i < 128; ++i) { const int vh = i >> 6, dd = i & 63; const float o = bf2f(co[(h * 4 + vh) * 64 + dd]) - lamv * bf2f(co[(h * 4 + 2 + vh) * 64 + dd]); ss += o * o; if (i == e) oe = o; }
        dbg_rec(slot, dbf(DW(bf16, WS_YC), (size_t)row * 512 + h * 128 + e), oe / sqrtf(ss / 128.f + LN_EPS) * ((const float*)a.in[13])[l * 128 + e] * oml, 0.02f);
        if (sid == 0) { const float* dl = (const float*)a.in[12] + l * 256; float s1 = 0.f, s2 = 0.f; for (int i = 0; i < 64; ++i) { s1 += dl[i] * dl[64 + i]; s2 += dl[128 + i] * dl[192 + i]; }
            const float li = 0.8f - 0.6f * expf(-0.3f * l); dbg_rec(slot, lamv, expf(s1) - expf(s2) + li, 1e-3f); dbg_rec(slot, oml, 1.f - li, 1e-3f); }
    } else if (q == 4) {
        const int row = RND(M), col = RND(1024); float tot = 0.f;
        for (int n = 0; n < 3; ++n) { const bf16* y = DW(bf16, n == 0 ? WS_YA : (n == 1 ? WS_YB : WS_YC)) + (size_t)row * 512; const bf16* w = DW(bf16, WS_WBR) + ((size_t)(l * 3 + n) * 1024 + col) * 512; float acc = 0.f;
            for (int k = 0; k < 512; ++k) acc += bf2f(y[k]) * bf2f(w[k]); tot += acc * dbf(DW(bf16, WS_GATES), (size_t)row * 3072 + n * 1024 + col); }
        dbg_rec(slot, dbf(DW(bf16, WS_MERGED), (size_t)row * 1024 + col), tot, 0.02f);
    } else if (q == 5) {
        const int row = RND(M), col = RND(1024); const bf16* mg = DW(bf16, WS_MERGED) + (size_t)row * 1024; const bf16* w = DW(bf16, WS_WOUT) + ((size_t)l * 1024 + col) * 1024; float acc = 0.f;
        for (int k = 0; k < 1024; ++k) acc += bf2f(mg[k]) * bf2f(w[k]);
        const float res = (l == 0 ? (const float*)a.in[0] : (const float*)a.out)[(size_t)row * 1024 + col];
        dbg_rec(slot, DW(float, WS_YF)[(size_t)row * 1024 + col], ALPHA * res + acc, 0.05f);
    } else if (q == 6) {
        const int row = RND(M), col = RND(1024); const float* y = DW(float, WS_YF) + (size_t)row * 1024; float mu = 0.f, var = 0.f;
        for (int k = 0; k < 1024; ++k) mu += y[k]; mu /= 1024.f; for (int k = 0; k < 1024; ++k) var += (y[k] - mu) * (y[k] - mu); var /= 1024.f;
        const float want = (y[col] - mu) / sqrtf(var + LN_EPS) * ((const float*)a.in[16])[l * 1024 + col] + ((const float*)a.in[17])[l * 1024 + col];
        dbg_rec(slot, a.out[(size_t)row * 1024 + col], want, 0.02f); dbg_rec(slot, dbf(DW(bf16, WS_HB), (size_t)row * 1024 + col), want, 0.05f);
    } else if (q == 7) {
        const int row = RND(M), col = RND(2048); const bf16* hb = DW(bf16, WS_HB) + (size_t)row * 1024; const bf16* w = DW(bf16, WS_WQ) + ((size_t)l * 2048 + col) * 1024; float acc = 0.f;
        for (int k = 0; k < 1024; ++k) acc += bf2f(hb[k]) * bf2f(w[k]);
        dbg_rec(slot, dbf(DW(bf16, WS_PQ), (size_t)row * 2048 + col), acc, 0.05f);
    } else if (q == 8) {
        unsigned rr = dh(blockIdx.x * 2654435761u + 977u * p + 5u); const int row = rr % M, hh = (rr >> 20) & 7;
        const bf16* pq = DW(bf16, WS_PQ) + (size_t)row * 2048 + hh * 256; const bf16* sk = DW(bf16, WS_SUBK) + (size_t)(l * 16 + hh * 2) * 128 * 128;
        { const int pp = tid >> 7, n = tid & 127; float acc = 0.f; for (int k = 0; k < 128; ++k) acc += bf2f(pq[pp * 128 + k]) * bf2f(sk[((size_t)pp * 128 + n) * 128 + k]); sh[tid] = acc; }
        __syncthreads();
        const int* ei = DW(int, WS_EIDX) + ((size_t)row * 8 + hh) * 16; const float* eg = DW(float, WS_EG) + ((size_t)row * 8 + hh) * 16;
        float fmin = 1e30f, fmax = -1e30f, gs = 0.f; for (int k = 0; k < 16; ++k) { const int e = ei[k]; const float f = sh[(e >> 7) & 127] + sh[128 + (e & 127)]; fmin = fminf(fmin, f); fmax = fmaxf(fmax, f); gs += eg[k]; }
        int cnt = 0; for (int i = tid; i < 16384; i += 256) cnt += (sh[i >> 7] + sh[128 + (i & 127)] > fmin + 2e-3f) ? 1 : 0;
        sh[512 + tid] = (float)cnt; __syncthreads();
        if (tid == 0) { float tot = 0.f; for (int i = 0; i < 256; ++i) tot += sh[512 + i]; dbg_rec(slot, tot > 15.5f ? 1.f : 0.f, 0.f, 1.f);
            dbg_rec(slot, gs, 1.f, 0.f); float den = 0.f; for (int k = 0; k < 16; ++k) { const int e = ei[k]; den += expf(sh[(e >> 7) & 127] + sh[128 + (e & 127)] - fmax); }
            for (int k = 0; k < 16; ++k) { const int e = ei[k]; dbg_rec(slot, eg[k], expf(sh[(e >> 7) & 127] + sh[128 + (e & 127)] - fmax) / den, 0.01f); }
            for (int k = 0; k < 16; ++k) for (int k2 = 0; k2 < k; ++k2) if (ei[k] == ei[k2]) dbg_rec(slot, 1.f, 0.f, 1.f); }
    } else if (q == 9) {
        unsigned rr = dh(blockIdx.x * 2654435761u + 31u * p + 9u); const int row = rr % M;
        const float* h1 = DW(float, WS_DBGH1) + (size_t)row * 1024; const int* ei = DW(int, WS_EIDX) + (size_t)row * 128; const float* eg = DW(float, WS_EG) + (size_t)row * 128;
        float y[4] = {0.f, 0.f, 0.f, 0.f};
        for (int e = 0; e < 128; ++e) { const size_t ex = (size_t)ei[e]; float part = 0.f; for (int k = tid; k < 1024; k += 256) part += h1[k] * dq8(DW(unsigned char, WS_U) + (size_t)l * 16384 * 1024, ex * 1024 + k);
            sh[tid] = part; __syncthreads(); if (tid < 64) { float s2 = sh[tid] + sh[tid + 64] + sh[tid + 128] + sh[tid + 192]; s2 = wave_sum(s2); if (tid == 0) sh[1024] = s2; } __syncthreads();
            const float w = eg[e] * dgelu(sh[1024] * DW(float, WS_SU)[l * 16384 + ex]) * DW(float, WS_SV)[l * 16384 + ex]; for (int i = 0; i < 4; ++i) y[i] += w * dq8(DW(unsigned char, WS_V) + (size_t)l * 16384 * 1024, ex * 1024 + tid + 256 * i); __syncthreads(); }
        float ps = 0.f; for (int i = 0; i < 4; ++i) { y[i] += ALPHA * h1[tid + 256 * i]; ps += y[i]; }
        sh[tid] = ps; __syncthreads(); if (tid == 0) { float t2 = 0.f; for (int i = 0; i < 256; ++i) t2 += sh[i]; sh[1025] = t2 / 1024.f; } __syncthreads(); const float mu = sh[1025];
        ps = 0.f; for (int i = 0; i < 4; ++i) ps += (y[i] - mu) * (y[i] - mu);
        __syncthreads(); sh[tid] = ps; __syncthreads(); if (tid == 0) { float t2 = 0.f; for (int i = 0; i < 256; ++i) t2 += sh[i]; sh[1026] = 1.f / sqrtf(t2 / 1024.f + LN_EPS); } __syncthreads();
        for (int i = 0; i < 4; ++i) { const int col = tid + 256 * i; dbg_rec(slot, a.out[(size_t)row * 1024 + col], (y[i] - mu) * sh[1026] * ((const float*)a.in[22])[l * 1024 + col] + ((const float*)a.in[23])[l * 1024 + col], 0.03f); }
    }
#undef RND
}
__global__ void dbg_scan(DArgs a) { const size_t i = (size_t)blockIdx.x * 256 + threadIdx.x; unsigned bad = 0; for (size_t j = i; j < (size_t)M * D; j += (size_t)gridDim.x * 256) { const float v = a.out[j]; if (!(v == v) || fabsf(v) > 1e30f) bad = 1; } if (bad) atomicMax(DW(unsigned, WS_MISC) + 15, 1u); }
__global__ void dbg_encode(DArgs a, float tol) {
    const unsigned* w = DW(unsigned, WS_MISC) + 16; int k = 0;
    for (int p = 0; p < 21; ++p) if (__uint_as_float(w[p]) > tol) { k = p + 1; break; }
    if (k == 2) { for (int s2 = 0; s2 < 8; ++s2) if (__uint_as_float(w[24 + s2]) > tol) { k = 50 + s2; break; } }
    if (k == 57) { int nf = 0, first = -1; for (int s3 = 0; s3 < 12; ++s3) if (__uint_as_float(w[32 + s3]) > tol) { ++nf; if (first < 0) first = s3; } k = 60 + first + 13 * (nf > 1 ? 1 : 0) + 13 * (nf == 12 ? 1 : 0); }
    if (k == 0 && DW(unsigned, WS_MISC)[15]) k = 40;
    if (k == 0) return;
    const float c = sqrtf((float)k);
    for (size_t j = (size_t)blockIdx.x * 256 + threadIdx.x; j < (size_t)M * D; j += (size_t)gridDim.x * 256) a.out[j] = c;
}
static void dbg_check(int p, const void* const* in, float* out, unsigned char* ws, const float* invf, hipStream_t stream) {
    DArgs d{}; for (int i = 0; i < 24; ++i) d.in[i] = in[i]; d.out = out; d.ws = ws; for (int i = 0; i < 32; ++i) d.invf[i] = invf[i]; d.p = p;
    hipLaunchKernelGGL(dbg_kernel, dim3(64), dim3(256), 0, stream, d);
}
static void dbg_final(const void* const* in, float* out, unsigned char* ws, hipStream_t stream) {
    DArgs d{}; for (int i = 0; i < 24; ++i) d.in[i] = in[i]; d.out = out; d.ws = ws; d.p = 0;
    hipLaunchKernelGGL(dbg_scan, dim3(1024), dim3(256), 0, stream, d);
    hipLaunchKernelGGL(dbg_encode, dim3(1024), dim3(256), 0, stream, d, 0.08f);
}
#endif
struct Args { const void* in[24]; float* out; unsigned char* ws; float invf[32]; int ph_lo, ph_hi, dbg, pad; };
constexpr int NPH = 1 + DEPTH * 10;

__global__ void __launch_bounds__(NWAVES * 64, 2) mk_fwd(Args args) {
    extern __shared__ __attribute__((aligned(16))) unsigned char lds[];
    LAS unsigned char* L = (LAS unsigned char*)lds;
    volatile LAS unsigned* MISC = (volatile LAS unsigned*)(L + MISC_OFF);
#define PH_IDS int tid = threadIdx.x; asm volatile("" : "+v"(tid)); const int lane = tid & 63, wave = __builtin_amdgcn_readfirstlane(tid >> 6); (void)lane; (void)wave;
    const int G = gridDim.x, bx = blockIdx.x, vcu = (G % 8 == 0) ? (bx % 8) * (G / 8) + bx / 8 : bx;
    gu32* ctl = (gu32*)(args.ws + WS_CTL);
    for (int u = threadIdx.x; u < (LDS_BYTES - LDSCTL_OFF) / 4; u += NWAVES * 64) ((LAS unsigned*)(L + LDSCTL_OFF))[u] = 0u;
    __syncthreads();
    XcdBarrier bar = xcd_barrier_post((unsigned*)(ctl + CW_BAR), MISC + 8);
    const int lo = args.ph_lo, hi = args.ph_hi;
#if MK_STAMP
    if (blockIdx.x == 0 && threadIdx.x == 0) ((unsigned long long*)(args.ws + WS_MISC + 1024))[0] = __builtin_amdgcn_s_memrealtime();
#endif
#ifndef MK_ONLYQ
#define MK_ONLYQ -1
#endif
#define IN(k) (lo <= (k) && (k) < hi)
#define INQ(q) ((MK_ONLYQ < 0 || MK_ONLYQ == (q)) && IN(pb + (q)))
#define REP(q) for (int rep_ = 0; rep_ < ((((MK_DUP) >> (q)) & 1) ? 2 : 1); ++rep_)
#if MK_STAMP
#define STAMP(k) do { if (blockIdx.x == 0 && threadIdx.x == 0) ((unsigned long long*)(args.ws + WS_MISC + 1024))[(k)] = __builtin_amdgcn_s_memrealtime(); } while (0)
#else
#define STAMP(k) do {} while (0)
#endif
#define SEAM(k) do { if (IN(k) && IN((k) + 1)) xcd_barrier(bar); STAMP((k) + 1); } while (0)
#define GT ((size_t)vcu * 512 + tid)
#define NGT ((size_t)G * 512)
#define GW (vcu * NWAVES + wave)
#define NGW (G * NWAVES)
#define WSP(T, off) ((T*)(args.ws + (off)))
#define x_in ((const float*)args.in[0])
#define WIN WSP(bf16, WS_WIN)
#define WBR WSP(bf16, WS_WBR)
#define WOUT WSP(bf16, WS_WOUT)
#define WQ WSP(bf16, WS_WQ)
#define SUBK WSP(bf16, WS_SUBK)
#define ROPEC WSP(float, WS_ROPEC)
#define ROPES WSP(float, WS_ROPES)
#define LRUW WSP(bf16, WS_LRUW)
#define MISCW WSP(float, WS_MISC)
#define UB WSP(unsigned char, WS_U)
#define VB WSP(unsigned char, WS_V)
#define SUB WSP(float, WS_SU)
#define SVB WSP(float, WS_SV)
#define HB WSP(bf16, WS_HB)
#define HL WSP(float, WS_HL)
#define PP WSP(float, WS_PP)
#define AQK WSP(bf16, WS_AQK)
#define AVT WSP(bf16, WS_AVT)
#define CQK WSP(bf16, WS_CQK)
#define CV WSP(bf16, WS_CV)
#define BXG WSP(bf16, WS_BXG)
#define GATES WSP(bf16, WS_GATES)
#define YA WSP(bf16, WS_YA)
#define YB WSP(bf16, WS_YB)
#define YC WSP(bf16, WS_YC)
#define CO WSP(bf16, WS_CO)
#define MERGEF WSP(float, WS_MERGEF)
#define MERGED WSP(bf16, WS_MERGED)
#define YF WSP(float, WS_YF)
#define PQ WSP(bf16, WS_PQ)
#define EIDX WSP(int, WS_EIDX)
#define EG WSP(float, WS_EG)
#define HF (args.out)
#define DBGH1 (args.dbg ? WSP(float, WS_DBGH1) : (float*)nullptr)

    if ((MK_ONLYQ < 0 || MK_ONLYQ == 100) && IN(0)) { PH_IDS
        LAS float* scr = (LAS float*)(L + RING_OFF + wave * 16384);
        constexpr int I_IN = 16 * 224, I_BR = 8 * 32, I_OUT = 16 * 32, I_Q = 16 * 64;
        constexpr int NITEMS = 2 * I_IN + 6 * I_BR + 2 * I_OUT + 2 * I_Q;
        for (int it = GW; it < NITEMS; it += NGW) {
            int r = it;
            if (r < 2 * I_IN) { const int l = r / I_IN; p0_transpose_item((const float*)args.in[2] + (size_t)l * 1024 * INC, 1024, INC, WIN + (size_t)l * INC * 1024, 2560, 3584, scr, r % I_IN, lane); continue; } r -= 2 * I_IN;
            if (r < 6 * I_BR) { const int q = r / I_BR; p0_transpose_item((const float*)args.in[14] + (size_t)q * 512 * 1024, 512, 1024, WBR + (size_t)q * 1024 * 512, 0, 0, scr, r % I_BR, lane); continue; } r -= 6 * I_BR;
            if (r < 2 * I_OUT) { const int l = r / I_OUT; p0_transpose_item((const float*)args.in[15] + (size_t)l * 1024 * 1024, 1024, 1024, WOUT + (size_t)l * 1024 * 1024, 0, 0, scr, r % I_OUT, lane); continue; } r -= 2 * I_OUT;
            { const int l = r / I_Q; p0_transpose_item((const float*)args.in[18] + (size_t)l * 1024 * 2048, 1024, 2048, WQ + (size_t)l * 2048 * 1024, 0, 0, scr, r % I_Q, lane); }
        }
        cvt_stream((const float*)args.in[19], SUBK, (size_t)2 * 8 * 2 * 128 * 128 / 8, GT, NGT);
        cvt_stream(x_in, HB, (size_t)M * D / 8, GT, NGT);
        for (int r = GW; r < 2 * 32768; r += NGW) { const int tsel = r >> 15, row = r & 32767;
            quant_row_fp8((const float*)args.in[tsel ? 21 : 20] + (size_t)row * 1024, (tsel ? VB : UB) + (size_t)row * 1024, (tsel ? SVB : SUB) + row, lane); }
        for (size_t i = GT; i < (size_t)2 * 2 * 8 * 4096; i += NGT) { const int k = i & 63, j = (i >> 6) & 63, g = (i >> 12) & 7, gate = (i >> 15) & 1, l = (int)(i >> 16);
            const float* w = (const float*)args.in[gate ? 9 : 7]; LRUW[i] = (bf16)f2bf(w[((size_t)(l * 8 + g) * 64 + k) * 64 + j]); }
        for (size_t i = GT; i < (size_t)M * 32; i += NGT) { const int row = (int)(i >> 5), fi = (int)(i & 31);
            const float ang = (float)((const int*)args.in[1])[row] * args.invf[fi];
            const double rev = (double)ang * 0.15915494309189535; const float fr = (float)(rev - __builtin_rint(rev));
            ROPEC[i] = __builtin_amdgcn_cosf(fr); ROPES[i] = __builtin_amdgcn_sinf(fr); }
        if (bx == 0 && tid < 2) { const float* dl = (const float*)args.in[12] + tid * 256; float s1 = 0.f, s2 = 0.f;
            for (int i = 0; i < 64; ++i) { s1 += dl[i] * dl[64 + i]; s2 += dl[128 + i] * dl[192 + i]; }
            const float li = tid == 0 ? 0.2f : 0.35550906759096926f;
            MISCW[tid] = expf(s1) - expf(s2) + li; MISCW[2 + tid] = 1.0f - li; }
    }
    SEAM(0);
    for (int l = 0; l < DEPTH; ++l) {
        const int pb = 1 + 10 * l;
        if (INQ(0)) REP(0) { PH_IDS
            { pg8::Gemm g{HB, WIN + (size_t)l * INC * 1024, M, INC, 1024}; pg8::InOrder S; S.init(G, bx);
              pg8::EpiIn E{AQK, BXG, CQK, CV, GATES, (const float*)args.in[3] + l * 3072, ROPEC, ROPES};
              pg8::gemm_phase<pg8::EpiIn, pg8::InOrder, PG8_ALIGN, PG8_SP2>(L + RING_OFF, g, S, E); }
            { pg8::Gemm g{WIN + (size_t)l * INC * 1024 + (size_t)1024 * 1024, HB, 512, M, 1024}; pg8::StaticOrder S; S.init(512, M, G, bx);
              pg8::EpiBf16<0> E{AVT, M, nullptr, 0, 0, 1.f};
              pg8::gemm_phase<pg8::EpiBf16<0>, pg8::StaticOrder, PG8_ALIGN, PG8_SP2>(L + RING_OFF, g, S, E); }
        }
        SEAM(pb + 0);
        if (INQ(1)) REP(1) { PH_IDS
            for (int u = vcu; u < 1024; u += G)
                b1_unit(l, u, L, BXG, LRUW, (const float*)args.in[5], (const float*)args.in[6], (const float*)args.in[8], (const float*)args.in[10], (const float*)args.in[11], HL, PP, tid, wave, lane);
        }
        SEAM(pb + 1);
        if (INQ(2)) REP(2) { PH_IDS
            for (int r2 = 0; r2 < ((((MK_DUP) >> 10) & 1) ? 2 : 1); ++r2) { LAS float* rbl = (LAS float*)(L + RING_OFF) + wave * 320;
              for (int i = lane; i < 320; i += 64) rbl[i] = ((const float*)args.in[4])[(l * 8 + wave) * 320 + i] * LOG2E;
              LDS_WAIT();
              for (int u = vcu; u < 256; u += G) band_unit(u, AQK, AVT, (const float*)rbl, YA, wave, lane); }
            for (int r2 = 0; r2 < ((((MK_DUP) >> 11) & 1) ? 2 : 1); ++r2) for (int u = vcu; u < 256; u += G) b3_unit(u, HL, PP, BXG, YB, tid);
            __syncthreads();
            const attn_body::AttnTensors AT{(const attn_body::bf16*)CQK, (const attn_body::bf16*)CQK, (const attn_body::bf16*)CV, (attn_body::bf16*)CO};
            const attn_body::StaticOrder S(G, bx);
            for (int r2 = 0; r2 < ((((MK_DUP) >> 12) & 1) ? 2 : 1); ++r2) attn_body::attn_phase<attn_body::StaticOrder>((char*)lds + RING_OFF, AT, S);
        }
        SEAM(pb + 2);
        if (INQ(3)) REP(3) { PH_IDS
            const float lamv = MISCW[l], oml = MISCW[2 + l];
            for (int m = GW; m < M; m += NGW) comb_row((size_t)m, CO, (const float*)args.in[13] + l * 128, lamv, oml, YC, lane);
        }
        SEAM(pb + 3);
        if (INQ(4)) REP(4) { PH_IDS
            pg8::Gemm g{YA, WBR + (size_t)l * 3 * 1024 * 512, 3 * M, 3072, 512}; pg8::MergeOrder S; S.init(G, bx); pg8::EpiMerge E{GATES, MERGED};
            pg8::gemm_phase<pg8::EpiMerge, pg8::MergeOrder, PG8_ALIGN, PG8_SP2>(L + RING_OFF, g, S, E);
        }
        SEAM(pb + 4);
        if (INQ(5)) REP(5) { PH_IDS
            pg8::Gemm g{MERGED, WOUT + (size_t)l * 1024 * 1024, M, 1024, 1024}; pg8::StaticOrder S; S.init(M, 1024, G, bx);
            pg8::EpiOut E{l == 0 ? x_in : HF, YF, ALPHA};
            pg8::gemm_phase<pg8::EpiOut, pg8::StaticOrder, false, PG8_SP2>(L + RING_OFF, g, S, E);
        }
        SEAM(pb + 5);
        if (INQ(6)) REP(6) { PH_IDS
            for (int m = GW; m < M; m += NGW) ln_row(YF + (size_t)m * D, (const float*)args.in[16] + l * D, (const float*)args.in[17] + l * D, HF + (size_t)m * D, HB + (size_t)m * D, args.dbg ? DBGH1 + (size_t)m * D : (float*)nullptr, lane);
        }
        SEAM(pb + 6);
        if (INQ(7)) REP(7) { PH_IDS
            pg8::Gemm g{HB, WQ + (size_t)l * 2048 * 1024, M, 2048, 1024}; pg8::StaticOrder S; S.init(M, 2048, G, bx);
            pg8::EpiBf16<0> E{PQ, 2048, nullptr, 0, 0, 1.f};
            pg8::gemm_phase<pg8::EpiBf16<0>, pg8::StaticOrder, PG8_ALIGN, PG8_SP2>(L + RING_OFF, g, S, E);
        }
        SEAM(pb + 7);
        if (INQ(8)) REP(8) { PH_IDS
            LAS unsigned* wl = (LAS unsigned*)(L + RING_OFF + wave * 8192);
            for (int u = GW; u < 4096; u += NGW) topk_unit(u, PQ, SUBK + (size_t)l * 8 * 2 * 128 * 128, EIDX, EG, wl, lane);
        }
        SEAM(pb + 8);
        if (INQ(9)) REP(9) { PH_IDS
            for (int m = GW; m < M; m += NGW) peer_row((size_t)m, HF, EIDX, EG, UB + (size_t)l * 16384 * 1024, VB + (size_t)l * 16384 * 1024, SUB + l * 16384, SVB + l * 16384, (const float*)args.in[22] + l * D, (const float*)args.in[23] + l * D, (((MK_DUP) >> 9) & 1) && rep_ == 0 ? WSP(float, WS_YF) : HF, (((MK_DUP) >> 9) & 1) && rep_ == 0 ? WSP(bf16, WS_GATES + 64 * MiB) : HB, lane);
        }
        SEAM(pb + 9);
    }
#undef IN
#undef INQ
#undef SEAM
}

#if MK_STAMP
__global__ void probe_encode(float* out, unsigned char* ws, unsigned maskA, unsigned maskB) {
    const unsigned long long* st = (const unsigned long long*)(ws + WS_MISC + 1024); float tA = 0.f;
    for (int p = 0; p < NPH; ++p) { const float d = (float)(st[p + 1] - st[p]) * 0.01f; if ((maskA >> p) & 1u) tA += d; }
    const float c = logf(tA + 1.f); (void)maskB;
    for (size_t j = (size_t)blockIdx.x * 256 + threadIdx.x; j < (size_t)M * D; j += (size_t)gridDim.x * 256) out[j] = c;
}
#endif
extern "C" void kernel_launch(void* const* d_in, const int* in_sizes, int n_in, void* d_out, int out_size, void* d_ws, size_t ws_size, hipStream_t stream) {
    static int grid = 0;
    if (grid == 0) {
        if (n_in != 24 || out_size != M * D || ws_size < WS_END) { fprintf(stderr, "kernel_launch: unexpected shapes (n_in %d out %d ws %zu)\n", n_in, out_size, ws_size); grid = -1; return; }
        int dev = 0, cus = 0;
        if (hipGetDevice(&dev) != hipSuccess || hipDeviceGetAttribute(&cus, hipDeviceAttributeMultiprocessorCount, dev) != hipSuccess) { grid = -1; return; }
        if (hipFuncSetAttribute((const void*)mk_fwd, hipFuncAttributeMaxDynamicSharedMemorySize, LDS_BYTES) != hipSuccess) { grid = -1; return; }
        (void)hipGetLastError();
        grid = cus;
        if (grid != 256) { fprintf(stderr, "kernel_launch: built for 256 CUs, found %d\n", cus); grid = -1; return; }
    }
    if (grid < 0) return;
    if (hipMemsetAsync((char*)d_ws + WS_CTL, 0, CTL_ZERO_BYTES, stream) != hipSuccess) return;
#if MK_DEBUG
    (void)hipMemsetAsync((char*)d_ws + WS_MISC + 60, 0, 196, stream);
#endif
    Args a{};
    for (int i = 0; i < 24; ++i) a.in[i] = d_in[i];
    a.out = (float*)d_out; a.ws = (unsigned char*)d_ws;
    for (int i = 0; i < 32; ++i) a.invf[i] = (float)pow(10000.0, -(double)(2 * i) / 64.0);
    a.dbg = MK_DEBUG;
#if MK_N_LAUNCHES == 1
    a.ph_lo = 0; a.ph_hi = NPH;
    hipLaunchKernelGGL(mk_fwd, dim3(grid), dim3(NWAVES * 64), LDS_BYTES, stream, a);
#if MK_STAMP
    hipLaunchKernelGGL(probe_encode, dim3(1024), dim3(256), 0, stream, (float*)d_out, (unsigned char*)d_ws, (unsigned)MK_STAMP_A, (unsigned)MK_STAMP_B);
#endif
#else
    for (int p = 0; p < NPH; ++p) { a.ph_lo = p; a.ph_hi = p + 1;
        hipLaunchKernelGGL(mk_fwd, dim3(grid), dim3(NWAVES * 64), LDS_BYTES, stream, a);
#if MK_DEBUG
        dbg_check(p, a.in, a.out, a.ws, a.invf, stream);
#endif
    }
#if MK_DEBUG
    dbg_final(a.in, a.out, a.ws, stream);
#endif
#endif
}
```

```cpp
#ifndef MK_N_LAUNCHES
#define MK_N_LAUNCHES 1
#endif
#ifndef MK_DEBUG
#define MK_DEBUG 0
#endif
#ifndef MK_STAMP
#define MK_STAMP 0
#endif
#ifndef MK_STAMP_A
#define MK_STAMP_A 0
#endif
#ifndef MK_STAMP_B
#define MK_STAMP_B 0
#endif
#ifndef MK_DUP
#define MK_DUP 0
#endif
#include <hip/hip_runtime.h>
#include <cstdio>
#include <cstdint>
namespace pg8 {
#define PG8_LAS __attribute__((address_space(3)))
typedef unsigned short bf16_t;
typedef short bf16x8 __attribute__((ext_vector_type(8)));
typedef float f32x4 __attribute__((ext_vector_type(4)));
typedef unsigned u32x4 __attribute__((ext_vector_type(4)));
constexpr int BM = 256, BK = 64, HALF = 128, HTB = HALF * BK * 2  , STAGE_BYTES = 8 * HTB, NXCD = 8, WGM = 8;

__host__ __device__ __forceinline__ int lds_byte(int r, int c) { const int st = (r >> 4) * 2 + (c >> 5), rr = r & 15, cc = c & 31, ob = rr * 64 + cc * 2; return st * 1024 + (ob ^ (((ob >> 9) & 1) << 5)); }
__host__ __device__ __forceinline__ void stage_rc(int b, int& R, int& C) { const int st = b / 1024, sb = b % 1024, swz = sb ^ (((sb >> 9) & 1) << 5); R = (st >> 1) * 16 + swz / 64; C = (st & 1) * 32 + (swz % 64) / 2; }
__host__ __device__ __forceinline__ int perm32(int rho) { const int n = rho >> 4, i = rho & 15; return 8 * (i >> 2) + 4 * n + (i & 3); }

struct Unit { int pm, pn; };
struct Gemm { const bf16_t* A; const bf16_t* Bt; int M, N, K; };

struct StaticOrder {
    int nM, nN, nwg, G, c;
    __host__ __device__ void init(int M, int N, int G_, int c_) { nM = M / BM; nN = N / BM; nwg = nM * nN; G = G_; c = c_; }
    __host__ __device__ bool next(int i, Unit& u) const {
        const long L = (long)i * G + c; if (L >= nwg) return false;
        int wgid = (int)L; { const int q = nwg / NXCD, r = nwg % NXCD, xcd = wgid % NXCD, off = wgid / NXCD; wgid = (xcd < r ? xcd * (q + 1) : r * (q + 1) + (xcd - r) * q) + off; }
        const int nig = WGM * nN, gid = wgid / nig, fm = gid * WGM, gsz = (nM - fm) < WGM ? (nM - fm) : WGM;
        u.pm = fm + ((wgid % nig) % gsz); u.pn = (wgid % nig) / gsz; return true;
    }
    __device__ __forceinline__ void a_ready(const Unit&) const {}
    __device__ __forceinline__ void done(const Unit&) const {}
};

typedef float f32x2c __attribute__((ext_vector_type(2))); typedef __bf16 bf16x2c __attribute__((ext_vector_type(2)));
__device__ __forceinline__ unsigned cvt_pk_bf16(float lo, float hi) { f32x2c v = {lo, hi}; bf16x2c b = __builtin_convertvector(v, bf16x2c); return __builtin_bit_cast(unsigned, b); }
typedef float f32x2 __attribute__((ext_vector_type(2)));
__device__ __forceinline__ f32x2 gelu_pk(f32x2 v) {
    const f32x2 av = __builtin_elementwise_abs(v), d = av * 0.2316418882f + 1.0f;
    f32x2 t; t.x = __builtin_amdgcn_rcpf(d.x); t.y = __builtin_amdgcn_rcpf(d.y);
    f32x2 q = t * 0.5307027145f + (-0.7265760135f); q = q * t + 0.7107068705f; q = q * t + (-0.142248368f); q = q * t + 0.127414796f; q = q * t;
    const f32x2 s = (v * v) * (-0.72134752044f);
    f32x2 e; e.x = __builtin_amdgcn_exp2f(s.x); e.y = __builtin_amdgcn_exp2f(s.y);
    const f32x2 m = v * (q * e), r = v - m;
    f32x2 o; o.x = v.x < 0.f ? m.x : r.x; o.y = v.y < 0.f ? m.y : r.y; return o;
}

template <int ACT  > struct EpiBf16 {
    static constexpr bool PERM = true, AFTER_DRAIN = false; static_assert(ACT == 0 || ACT == 1, "EpiBf16: ACT is 0 (none) or 1 (gelu_pk)");
    bf16_t* O; int ldc; const float* bias; int split_cols; size_t split_stride; float scale0;
    __device__ __forceinline__ void operator()(const f32x4 (&acc)[2][2][4][2], const Unit& u, int wr, int wc, int fr, int fq) const {
        const int row0 = u.pm * BM + wr * 64 + fr; int colt = u.pn * BM; bf16_t* base = O;
        float sc = 1.f; if (split_cols) { const int t = colt / split_cols; base += (size_t)t * split_stride; colt -= t * split_cols; if (t == 0) sc = scale0; }
        const int col0 = colt + wc * 32 + 8 * fq, bcol0 = u.pn * BM + wc * 32 + 8 * fq;
        f32x4 bv[2][2];
#pragma unroll
        for (int bj = 0; bj < 2; ++bj)
#pragma unroll
            for (int n = 0; n < 2; ++n) bv[bj][n] = bias ? *(const f32x4*)(bias + bcol0 + bj * HALF + 4 * n) : (f32x4){0.f, 0.f, 0.f, 0.f};
#pragma unroll
        for (int ai = 0; ai < 2; ++ai)
#pragma unroll
            for (int m = 0; m < 4; ++m) { bf16_t* rowp = base + (size_t)(row0 + ai * HALF + m * 16) * ldc + col0;
#pragma unroll
                for (int bj = 0; bj < 2; ++bj) { f32x4 v0 = acc[ai][bj][m][0] + bv[bj][0], v1 = acc[ai][bj][m][1] + bv[bj][1];
                    if (ACT == 1) { f32x2 a = gelu_pk((f32x2){v0[0], v0[1]}), b = gelu_pk((f32x2){v0[2], v0[3]}), c = gelu_pk((f32x2){v1[0], v1[1]}), d = gelu_pk((f32x2){v1[2], v1[3]});
                        v0 = (f32x4){a.x, a.y, b.x, b.y}; v1 = (f32x4){c.x, c.y, d.x, d.y}; }
                    v0 = v0 * sc; v1 = v1 * sc; u32x4 w; w.x = cvt_pk_bf16(v0[0], v0[1]); w.y = cvt_pk_bf16(v0[2], v0[3]); w.z = cvt_pk_bf16(v1[0], v1[1]); w.w = cvt_pk_bf16(v1[2], v1[3]);
                    *(u32x4*)(rowp + bj * HALF) = w; } }
    }
};


template <class Epi, class Sched, bool ALIGN_EPI = false, bool SP2 = false>
__device__ __forceinline__ void gemm_phase(PG8_LAS unsigned char* lds, const Gemm g_in, const Sched& S, const Epi& E) {
    Gemm g = g_in; asm volatile("" : "+s"(g.A), "+s"(g.Bt));
    int tid_ = threadIdx.x; asm volatile("" : "+v"(tid_));
    const int tid = tid_, wid = __builtin_amdgcn_readfirstlane(tid >> 6), lane = tid & 63, wr = wid >> 2, wc = wid & 3, fr = lane & 15, fq = lane >> 4;
    const int K = g.K, nt = K / BK;
    unsigned voffA[2], voffB[2];
#pragma unroll
    for (int i = 0; i < 2; ++i) { int R, C; stage_rc(tid * 16 + i * 8192, R, C); const int Rb = Epi::PERM ? ((R & ~31) + perm32(R & 31)) : R;
        voffA[i] = (unsigned)(R * K + C) * 2u; voffB[i] = (unsigned)(Rb * K + C) * 2u; }
    const size_t kstep = (size_t)(BK * 2);
    const size_t hstep = (size_t)HALF * K * 2;
    const size_t tstep = 2 * hstep;
    const unsigned ldsw = (unsigned)wid * 1024u;
    const int aoff = lds_byte(wr * 64 + fr, fq * 8), boff = lds_byte(wc * 32 + fr, fq * 8);
#define PG8_SA(b, h) (((b) * 2 + (h)) * HTB)
#define PG8_SB(b, h) ((4 + (b) * 2 + (h)) * HTB)
#define PG8_STAGE(bufoff, gbase, voff) do { _Pragma("unroll") for (int _i = 0; _i < 2; ++_i) \
        __builtin_amdgcn_global_load_lds((const unsigned*)((const char*)(gbase) + (voff)[_i]), (PG8_LAS unsigned*)(lds + (bufoff) + ldsw + _i * 8192), 16, 0, 0); } while (0)
#define PG8_LDA(dst, b, h) do { _Pragma("unroll") for (int m = 0; m < 4; ++m) _Pragma("unroll") for (int k = 0; k < 2; ++k) dst[m][k] = *(const PG8_LAS bf16x8*)(lds + PG8_SA(b, h) + aoff + m * 2048 + k * 1024); } while (0)
#define PG8_LDB(dst, b, h) do { _Pragma("unroll") for (int n = 0; n < 2; ++n) _Pragma("unroll") for (int k = 0; k < 2; ++k) dst[n][k] = *(const PG8_LAS bf16x8*)(lds + PG8_SB(b, h) + boff + n * 2048 + k * 1024); } while (0)
#define PG8_MMA(ai, bj, At, Bt) do { __builtin_amdgcn_s_setprio(1); _Pragma("unroll") for (int m = 0; m < 4; ++m) _Pragma("unroll") for (int n = 0; n < 2; ++n) _Pragma("unroll") for (int k = 0; k < 2; ++k) \
        acc[ai][bj][m][n] = __builtin_amdgcn_mfma_f32_16x16x32_bf16(Bt[n][k], At[m][k], acc[ai][bj][m][n], 0, 0, 0); __builtin_amdgcn_s_setprio(0); } while (0)
#define PG8_WAIT_V(n) asm volatile("s_waitcnt vmcnt(" #n ")" ::: "memory")
#define PG8_WAIT_L(n) asm volatile("s_waitcnt lgkmcnt(" #n ")" ::: "memory")
#define PG8_BAR __builtin_amdgcn_s_barrier()
#define PG8_SCHED __builtin_amdgcn_sched_barrier(0)
    Unit cur, nxt; int ui = 0;
    if (!S.next(0, cur)) return;
    f32x4 acc[2][2][4][2];
#pragma unroll
    for (int a = 0; a < 2; ++a)
#pragma unroll
        for (int b = 0; b < 2; ++b)
#pragma unroll
            for (int m = 0; m < 4; ++m)
#pragma unroll
                for (int n = 0; n < 2; ++n) acc[a][b][m][n] = (f32x4){0.f, 0.f, 0.f, 0.f};
    bf16x8 At[4][2], B0[2][2], B1[2][2];
    const char* cA = (const char*)g.A + (size_t)cur.pm * tstep; const char* cB = (const char*)g.Bt + (size_t)cur.pn * tstep;
    S.a_ready(cur);
    if constexpr (SP2) {
        PG8_STAGE(PG8_SB(0, 0), cB, voffB); PG8_STAGE(PG8_SB(0, 1), cB + hstep, voffB); PG8_STAGE(PG8_SA(0, 0), cA, voffA); PG8_STAGE(PG8_SA(0, 1), cA + hstep, voffA);
        if (wr == 1) PG8_BAR;
        PG8_WAIT_V(2); PG8_BAR;
        PG8_STAGE(PG8_SB(1, 0), cB + kstep, voffB); PG8_STAGE(PG8_SA(1, 0), cA + kstep, voffA); PG8_STAGE(PG8_SB(1, 1), cB + hstep + kstep, voffB);
        PG8_WAIT_V(6); PG8_BAR;
    } else {
        PG8_STAGE(PG8_SB(0, 0), cB, voffB); PG8_STAGE(PG8_SA(0, 0), cA, voffA); PG8_STAGE(PG8_SB(0, 1), cB + hstep, voffB); PG8_STAGE(PG8_SA(0, 1), cA + hstep, voffA);
        if (wr == 1) PG8_BAR;
        PG8_WAIT_V(4); PG8_BAR;
        PG8_STAGE(PG8_SB(1, 0), cB + kstep, voffB); PG8_STAGE(PG8_SA(1, 0), cA + kstep, voffA); PG8_STAGE(PG8_SB(1, 1), cB + hstep + kstep, voffB);
        PG8_WAIT_V(6); PG8_BAR;
    }
    for (;;) {
        const bool has_next = S.next(ui + 1, nxt);
        const char* nA = has_next ? (const char*)g.A + (size_t)nxt.pm * tstep : cA; const char* nB = has_next ? (const char*)g.Bt + (size_t)nxt.pn * tstep : cB;
        for (int t = 0; t < nt; t += 2) {
            const bool last = (t == nt - 2);
            const char* a1 = cA + (size_t)(t + 1) * kstep;
            const char* a2 = last ? nA : cA + (size_t)(t + 2) * kstep; const char* b2 = last ? nB : cB + (size_t)(t + 2) * kstep;
            const char* a3 = a2 + kstep; const char* b3 = b2 + kstep;
            if (last && has_next) S.a_ready(nxt);
            if constexpr (SP2) {
            PG8_LDB(B0, 0, 0); PG8_LDB(B1, 0, 1); PG8_SCHED; PG8_LDA(At, 0, 0); PG8_STAGE(PG8_SA(1, 1), a1 + hstep, voffA);
            PG8_WAIT_V(8); PG8_WAIT_L(0); PG8_BAR; PG8_MMA(0, 0, At, B0); PG8_MMA(0, 1, At, B1); PG8_BAR; PG8_SCHED;
            PG8_LDA(At, 0, 1); PG8_STAGE(PG8_SB(0, 0), b2, voffB); PG8_STAGE(PG8_SB(0, 1), b2 + hstep, voffB); PG8_STAGE(PG8_SA(0, 0), a2, voffA);
            PG8_WAIT_V(8); PG8_WAIT_L(0); PG8_BAR; PG8_MMA(1, 0, At, B0); PG8_MMA(1, 1, At, B1); PG8_BAR; PG8_SCHED;
            PG8_LDB(B0, 1, 0); PG8_LDB(B1, 1, 1); PG8_SCHED; PG8_LDA(At, 1, 0); PG8_STAGE(PG8_SA(0, 1), a2 + hstep, voffA);
            PG8_WAIT_V(8); PG8_WAIT_L(0); PG8_BAR; PG8_MMA(0, 0, At, B0); PG8_MMA(0, 1, At, B1); PG8_BAR; PG8_SCHED;
            PG8_LDA(At, 1, 1); PG8_STAGE(PG8_SB(1, 0), b3, voffB); PG8_STAGE(PG8_SB(1, 1), b3 + hstep, voffB); PG8_STAGE(PG8_SA(1, 0), a3, voffA);
            PG8_WAIT_V(8); PG8_WAIT_L(0); PG8_BAR; PG8_MMA(1, 0, At, B0); PG8_MMA(1, 1, At, B1); PG8_BAR; PG8_SCHED;
            } else {
            PG8_LDB(B0, 0, 0); PG8_SCHED; PG8_LDA(At, 0, 0); PG8_STAGE(PG8_SA(1, 1), a1 + hstep, voffA);
            PG8_WAIT_L(8); PG8_BAR; PG8_WAIT_L(0); PG8_MMA(0, 0, At, B0); PG8_BAR; PG8_SCHED;
            PG8_LDB(B1, 0, 1); PG8_STAGE(PG8_SB(0, 0), b2, voffB);
            PG8_BAR; PG8_WAIT_L(0); PG8_MMA(0, 1, At, B1); PG8_BAR;
            PG8_LDA(At, 0, 1); PG8_STAGE(PG8_SA(0, 0), a2, voffA);
            PG8_BAR; PG8_WAIT_L(0); PG8_MMA(1, 0, At, B0); PG8_BAR; PG8_SCHED;
            PG8_STAGE(PG8_SB(0, 1), b2 + hstep, voffB);
            PG8_WAIT_V(6); PG8_BAR; PG8_MMA(1, 1, At, B1); PG8_BAR;
            PG8_LDB(B0, 1, 0); PG8_SCHED; PG8_LDA(At, 1, 0); PG8_STAGE(PG8_SA(0, 1), a2 + hstep, voffA);
            PG8_WAIT_L(8); PG8_BAR; PG8_WAIT_L(0); PG8_MMA(0, 0, At, B0); PG8_BAR; PG8_SCHED;
            PG8_LDB(B1, 1, 1); PG8_STAGE(PG8_SB(1, 0), b3, voffB);
            PG8_BAR; PG8_WAIT_L(0); PG8_MMA(0, 1, At, B1); PG8_BAR;
            PG8_LDA(At, 1, 1); PG8_STAGE(PG8_SA(1, 0), a3, voffA);
            PG8_BAR; PG8_WAIT_L(0); PG8_MMA(1, 0, At, B0); PG8_BAR; PG8_SCHED;
            PG8_STAGE(PG8_SB(1, 1), b3 + hstep, voffB);
            PG8_WAIT_V(6); PG8_BAR; PG8_MMA(1, 1, At, B1); PG8_BAR;
            }
        }
        if constexpr (ALIGN_EPI) { if (wr == 0) PG8_BAR; }
        if constexpr (!Epi::AFTER_DRAIN) { E(acc, cur, wr, wc, fr, fq); S.done(cur); }
        if (!has_next) break;
#pragma unroll
        for (int a = 0; a < 2; ++a)
#pragma unroll
            for (int b = 0; b < 2; ++b)
#pragma unroll
                for (int m = 0; m < 4; ++m)
#pragma unroll
                    for (int n = 0; n < 2; ++n) acc[a][b][m][n] = (f32x4){0.f, 0.f, 0.f, 0.f};
        cur = nxt; cA = nA; cB = nB; ++ui;
        if constexpr (ALIGN_EPI) { if (wr == 1) PG8_BAR; }
    }
    PG8_WAIT_V(0);
    if constexpr (!ALIGN_EPI) { if (wr == 0) PG8_BAR; }
    PG8_BAR;
    if constexpr (Epi::AFTER_DRAIN) { E.fused(acc, cur, wr, wc, fr, fq, lds, wid, lane); S.done(cur); }
#undef PG8_SA
#undef PG8_SB
#undef PG8_STAGE
#undef PG8_LDA
#undef PG8_LDB
#undef PG8_MMA
#undef PG8_WAIT_V
#undef PG8_WAIT_L
#undef PG8_BAR
#undef PG8_SCHED
}
}

#ifndef PG8_SP2
#define PG8_SP2 true
#endif
#ifndef PG8_ALIGN
#define PG8_ALIGN true
#endif
namespace pg8 {
constexpr float C2S = 0.125f * 1.4426950408889634f;
__device__ __forceinline__ float sigm(float x) { return __builtin_amdgcn_rcpf(1.0f + __builtin_amdgcn_exp2f(-1.4426950408889634f * x)); }
__device__ __forceinline__ void st8(bf16_t* p, f32x4 v0, f32x4 v1) { u32x4 w; w.x = cvt_pk_bf16(v0[0], v0[1]); w.y = cvt_pk_bf16(v0[2], v0[3]); w.z = cvt_pk_bf16(v1[0], v1[1]); w.w = cvt_pk_bf16(v1[2], v1[3]); *(u32x4*)p = w; }

struct EpiIn {
    static constexpr bool PERM = true, AFTER_DRAIN = false;
    bf16_t *AQK, *BXG, *CQK, *CV, *GATES; const float* gbias; const float* rc; const float* rs;
    __device__ __forceinline__ void operator()(const f32x4 (&acc)[2][2][4][2], const Unit& u, int wr, int wc, int fr, int fq) const {
        const int pn = u.pn;
        bf16_t* base; int ldc, colt, mode;
        if (pn < 2)       { base = AQK; ldc = 1024; colt = pn * 256; mode = 1; }
        else if (pn < 4)  { base = AQK; ldc = 1024; colt = 512 + (pn - 2) * 256; mode = 0; }
        else if (pn < 10) { base = BXG; ldc = 1024; colt = (pn - 6) * 256; mode = 0; }
        else if (pn < 12) { base = CQK; ldc = 1024; colt = (pn - 10) * 256; mode = 3; }
        else if (pn < 14) { base = CQK; ldc = 1024; colt = 512 + (pn - 12) * 256; mode = 2; }
        else if (pn < 16) { base = CV; ldc = 512; colt = (pn - 14) * 256; mode = 0; }
        else              { base = GATES; ldc = 3072; colt = (pn - 16) * 256; mode = 4; }
        const int row0 = u.pm * BM + wr * 64 + fr, cl = wc * 32 + 8 * fq;
        const float sc = (mode & 1) ? C2S : 1.f;
        if (mode == 4) {
            f32x4 bv[2][2];
#pragma unroll
            for (int bj = 0; bj < 2; ++bj)
#pragma unroll
                for (int n = 0; n < 2; ++n) bv[bj][n] = *(const f32x4*)(gbias + colt + bj * HALF + cl + 4 * n);
#pragma unroll
            for (int ai = 0; ai < 2; ++ai)
#pragma unroll
                for (int m = 0; m < 4; ++m) { bf16_t* rowp = base + (size_t)(row0 + ai * HALF + m * 16) * ldc + colt + cl;
#pragma unroll
                    for (int bj = 0; bj < 2; ++bj) { f32x4 v0 = acc[ai][bj][m][0] + bv[bj][0], v1 = acc[ai][bj][m][1] + bv[bj][1];
#pragma unroll
                        for (int e = 0; e < 4; ++e) { v0[e] = sigm(v0[e]); v1[e] = sigm(v1[e]); }
                        st8(rowp + bj * HALF, v0, v1); }
                    asm volatile("" ::: "memory"); }
        } else if (mode >= 2) {
            const int i0 = (wc & 1) * 16 + 4 * fq;
#pragma unroll
            for (int ai = 0; ai < 2; ++ai)
#pragma unroll
                for (int m = 0; m < 4; ++m) { const int row = row0 + ai * HALF + m * 16; bf16_t* rowp = base + (size_t)row * ldc + colt + cl;
                    const f32x4 cs = *(const f32x4*)(rc + (size_t)row * 32 + i0), sn = *(const f32x4*)(rs + (size_t)row * 32 + i0);
#pragma unroll
                    for (int bj = 0; bj < 2; ++bj) { const f32x4 a0 = acc[ai][bj][m][0], a1 = acc[ai][bj][m][1]; f32x4 v0, v1;
                        v0[0] = (a0[0] * cs[0] - a0[1] * sn[0]) * sc; v0[1] = (a0[1] * cs[0] + a0[0] * sn[0]) * sc;
                        v0[2] = (a0[2] * cs[1] - a0[3] * sn[1]) * sc; v0[3] = (a0[3] * cs[1] + a0[2] * sn[1]) * sc;
                        v1[0] = (a1[0] * cs[2] - a1[1] * sn[2]) * sc; v1[1] = (a1[1] * cs[2] + a1[0] * sn[2]) * sc;
                        v1[2] = (a1[2] * cs[3] - a1[3] * sn[3]) * sc; v1[3] = (a1[3] * cs[3] + a1[2] * sn[3]) * sc;
                        st8(rowp + bj * HALF, v0, v1); }
                    asm volatile("" ::: "memory"); }
        } else {
#pragma unroll
            for (int ai = 0; ai < 2; ++ai)
#pragma unroll
                for (int m = 0; m < 4; ++m) { bf16_t* rowp = base + (size_t)(row0 + ai * HALF + m * 16) * ldc + colt + cl;
#pragma unroll
                    for (int bj = 0; bj < 2; ++bj) st8(rowp + bj * HALF, acc[ai][bj][m][0] * sc, acc[ai][bj][m][1] * sc); }
        }
    }
};
struct InOrder {
    StaticOrder S;
    __device__ void init(int G, int c) { S.init(16384, 26 * 256, G, c); }
    __device__ bool next(int i, Unit& u) const { if (!S.next(i, u)) return false; if (u.pn >= 4) u.pn += 2; return true; }
    __device__ __forceinline__ void a_ready(const Unit&) const {}
    __device__ __forceinline__ void done(const Unit&) const {}
};
struct MergeOrder {
    StaticOrder S;
    __device__ void init(int G, int c) { S.init(16384, 1024, G, c); }
    __device__ bool next(int i, Unit& u) const { const int n = i % 3; if (!S.next(i / 3, u)) return false; u.pm += n * 64; u.pn += n * 4; return true; }
    __device__ __forceinline__ void a_ready(const Unit&) const {}
    __device__ __forceinline__ void done(const Unit&) const {}
};
struct EpiMerge {
    static constexpr bool PERM = true, AFTER_DRAIN = false;
    const bf16_t* gates; bf16_t* merged;
    __device__ __forceinline__ void operator()(const f32x4 (&acc)[2][2][4][2], const Unit& u, int wr, int wc, int fr, int fq) const {
        const int nb = u.pm >> 6, pm = u.pm & 63, pn = u.pn & 3;
        const int row0 = pm * BM + wr * 64 + fr, col0 = pn * BM + wc * 32 + 8 * fq;
#pragma unroll
        for (int ai = 0; ai < 2; ++ai)
#pragma unroll
            for (int m = 0; m < 4; ++m) { const size_t row = (size_t)(row0 + ai * HALF + m * 16);
#pragma unroll
                for (int bj = 0; bj < 2; ++bj) { const int col = col0 + bj * HALF;
                    const u32x4 gw = *(const u32x4*)(gates + row * 3072 + nb * 1024 + col);
                    f32x4 g0, g1;
                    g0[0] = __uint_as_float(gw.x << 16); g0[1] = __uint_as_float(gw.x & 0xffff0000u); g0[2] = __uint_as_float(gw.y << 16); g0[3] = __uint_as_float(gw.y & 0xffff0000u);
                    g1[0] = __uint_as_float(gw.z << 16); g1[1] = __uint_as_float(gw.z & 0xffff0000u); g1[2] = __uint_as_float(gw.w << 16); g1[3] = __uint_as_float(gw.w & 0xffff0000u);
                    f32x4 v0 = acc[ai][bj][m][0] * g0, v1 = acc[ai][bj][m][1] * g1;
                    bf16_t* mp = merged + row * 1024 + col;
                    if (nb > 0) { const u32x4 pw = *(const u32x4*)mp;
                        v0[0] += __uint_as_float(pw.x << 16); v0[1] += __uint_as_float(pw.x & 0xffff0000u); v0[2] += __uint_as_float(pw.y << 16); v0[3] += __uint_as_float(pw.y & 0xffff0000u);
                        v1[0] += __uint_as_float(pw.z << 16); v1[1] += __uint_as_float(pw.z & 0xffff0000u); v1[2] += __uint_as_float(pw.w << 16); v1[3] += __uint_as_float(pw.w & 0xffff0000u); }
                    st8(mp, v0, v1); }
                if (m & 1) asm volatile("" ::: "memory"); }
    }
};
struct EpiOut {
    static constexpr bool PERM = true, AFTER_DRAIN = false;
    const float* resid; float* yf; float alpha;
    __device__ __forceinline__ void operator()(const f32x4 (&acc)[2][2][4][2], const Unit& u, int wr, int wc, int fr, int fq) const {
        const int row0 = u.pm * BM + wr * 64 + fr, col0 = u.pn * BM + wc * 32 + 8 * fq;
#pragma unroll
        for (int ai = 0; ai < 2; ++ai)
#pragma unroll
            for (int m = 0; m < 4; ++m) { const size_t row = (size_t)(row0 + ai * HALF + m * 16);
#pragma unroll
                for (int bj = 0; bj < 2; ++bj) { const size_t o = row * 1024 + col0 + bj * HALF;
                    const f32x4 r0 = *(const f32x4*)(resid + o), r1 = *(const f32x4*)(resid + o + 4);
                    *(f32x4*)(yf + o) = r0 * alpha + acc[ai][bj][m][0]; *(f32x4*)(yf + o + 4) = r1 * alpha + acc[ai][bj][m][1]; }
                asm volatile("" ::: "memory"); }
    }
};
}
#include <hip/hip_bf16.h>
#include <cmath>
namespace attn_body {
using bf16=__hip_bfloat16;
using bf16x8=__attribute__((ext_vector_type(8)))short;
using s16x4=__attribute__((ext_vector_type(4)))short;
using f32x16=__attribute__((ext_vector_type(16)))float;
using u32x4=__attribute__((ext_vector_type(4)))unsigned;
constexpr int BATCH=2,NHEAD=16,SEQ=8192,D=64;
constexpr int QP=1024,KP=1024,VP=512,OP=1024;
constexpr int NW=8,QBLK=32,QB=QBLK*NW,KVBLK=64,NQB=SEQ/QB;
constexpr int ATTN_UNIT_ROWS=QB;
__device__ __forceinline__ int crow(int r,int hi){return (r&3)+8*(r>>2)+4*hi;}
#define SBAR() __builtin_amdgcn_sched_barrier(0)
__device__ __forceinline__ void cmask(f32x16&p0,f32x16&p1,int jb,int qrel,int hi){
  const float NEG=-INFINITY; (void)hi;
  if(jb>(qrel>>6)){
  #pragma unroll
  for(int r=0;r<16;++r){p0[r]=NEG;p1[r]=NEG;} }
}

constexpr int NSLOT=3, SLOTB=8192;
constexpr int LDS_K=0, LDS_V=NSLOT*SLOTB, LDS_WS=2*NSLOT*SLOTB, LDS_OST=LDS_WS+NW*64*4, LDS_BYTES=LDS_OST+NW*4096;
constexpr float C2=0.125f*1.4426950408889634f;
__device__ __forceinline__ void glds16(const void*gsrc,unsigned lds_dst){unsigned keep;
  asm volatile("s_mov_b32 %0, m0\n\ts_mov_b32 m0, %2\n\ts_nop 0\n\tglobal_load_lds_dwordx4 %1, off\n\ts_mov_b32 m0, %0":"=&s"(keep):"v"(gsrc),"s"(lds_dst):"memory");}
__device__ __forceinline__ float max3f(float a,float b,float c){float r;asm("v_max3_f32 %0, %1, %2, %3":"=v"(r):"v"(a),"v"(b),"v"(c));return r;}
__device__ __forceinline__ float max2f(float a,float b){float r;asm("v_max_f32_e32 %0, %1, %2":"=v"(r):"v"(a),"v"(b));return r;}
__device__ __forceinline__ float fadd_s(float a,float b){float r;asm("v_add_f32_e32 %0, %1, %2":"=v"(r):"v"(a),"v"(b));return r;}
__device__ __forceinline__ float fsub_s(float a,float b){float r;asm("v_sub_f32_e32 %0, %1, %2":"=v"(r):"v"(a),"v"(b));return r;}
typedef float f32x2_t __attribute__((ext_vector_type(2))); typedef __bf16 bf16x2_t __attribute__((ext_vector_type(2)));
__device__ __forceinline__ unsigned cvtpk_s(float lo,float hi){f32x2_t v={lo,hi};bf16x2_t b=__builtin_convertvector(v,bf16x2_t);return __builtin_bit_cast(unsigned,b);}
#define WAIT_BAR(N) asm volatile("s_waitcnt vmcnt(" #N ") lgkmcnt(0)\n\ts_barrier":::"memory")

__device__ __forceinline__ void qkt(f32x16&p0,f32x16&p1,const char*Kslot,const bf16x8*qr,const f32x16&negm,int r32,int hi){
  const char*kb=Kslot+hi*1024+r32*16;
  #pragma unroll
  for(int d0=0;d0<4;++d0){
    const bf16x8 b0=*reinterpret_cast<const bf16x8*>(kb+d0*2048);
    const bf16x8 b1=*reinterpret_cast<const bf16x8*>(kb+d0*2048+512);
    if(d0==0){p0=__builtin_amdgcn_mfma_f32_32x32x16_bf16(b0,qr[0],negm,0,0,0);p1=__builtin_amdgcn_mfma_f32_32x32x16_bf16(b1,qr[0],negm,0,0,0);}
    else{p0=__builtin_amdgcn_mfma_f32_32x32x16_bf16(b0,qr[d0],p0,0,0,0);p1=__builtin_amdgcn_mfma_f32_32x32x16_bf16(b1,qr[d0],p1,0,0,0);}}
}
typedef __attribute__((address_space(3))) const char* lds_cptr;
typedef short v4i16_t __attribute__((ext_vector_type(4)));
__device__ __forceinline__ void kload8(bf16x8*kf,lds_cptr kp){
  kf[0]=*(const __attribute__((address_space(3))) bf16x8*)(kp);      kf[1]=*(const __attribute__((address_space(3))) bf16x8*)(kp+512);
  kf[2]=*(const __attribute__((address_space(3))) bf16x8*)(kp+2048); kf[3]=*(const __attribute__((address_space(3))) bf16x8*)(kp+2560);
  kf[4]=*(const __attribute__((address_space(3))) bf16x8*)(kp+4096); kf[5]=*(const __attribute__((address_space(3))) bf16x8*)(kp+4608);
  kf[6]=*(const __attribute__((address_space(3))) bf16x8*)(kp+6144); kf[7]=*(const __attribute__((address_space(3))) bf16x8*)(kp+6656);
}
__device__ __forceinline__ void kload2(bf16x8*kf,lds_cptr kp,int j){ kf[2*j]=*(const __attribute__((address_space(3))) bf16x8*)(kp+j*2048); kf[2*j+1]=*(const __attribute__((address_space(3))) bf16x8*)(kp+j*2048+512); }
__device__ __forceinline__ s16x4 vtr(lds_cptr p){ return __builtin_bit_cast(s16x4,__builtin_amdgcn_ds_read_tr16_b64_v4i16((__attribute__((address_space(3))) v4i16_t*)p)); }
__device__ __forceinline__ float rowmax(const f32x16&p0,const f32x16&p1){
  float a=max3f(p0[0],p0[1],p1[0]),b=max3f(p0[2],p0[3],p1[1]);a=max3f(a,p1[2],p1[3]);
  #pragma unroll
  for(int r=4;r<16;r+=4){a=max3f(a,p0[r],p0[r+1]);b=max3f(b,p0[r+2],p0[r+3]);a=max3f(a,p1[r],p1[r+1]);b=max3f(b,p1[r+2],p1[r+3]);}
  const float m=max2f(a,b);
  auto rr=__builtin_amdgcn_permlane32_swap(__float_as_uint(m),__float_as_uint(m),false,false);
  return max2f(__uint_as_float(rr[0]),__uint_as_float(rr[1]));
}
__device__ __forceinline__ void pv(f32x16*o,int vb,bf16x8 pa0,bf16x8 pa1,bf16x8 pa2,bf16x8 pa3){
  #pragma unroll
  for(int d0=0;d0<2;++d0){s16x4 lo[4],hi[4];
    #pragma unroll
    for(int ks=0;ks<4;++ks){
      asm volatile("ds_read_b64_tr_b16 %0,%1 offset:%c2":"=&v"(lo[ks]):"v"(vb),"i"(d0*4096+ks*1024):"memory");
      asm volatile("ds_read_b64_tr_b16 %0,%1 offset:%c2":"=&v"(hi[ks]):"v"(vb),"i"(d0*4096+ks*1024+512):"memory");}
    asm volatile("s_waitcnt lgkmcnt(0)":::"memory");SBAR();
    #define PK(k) (bf16x8){lo[k][0],lo[k][1],lo[k][2],lo[k][3],hi[k][0],hi[k][1],hi[k][2],hi[k][3]}
    o[d0]=__builtin_amdgcn_mfma_f32_32x32x16_bf16(pa0,PK(0),o[d0],0,0,0);
    o[d0]=__builtin_amdgcn_mfma_f32_32x32x16_bf16(pa1,PK(1),o[d0],0,0,0);
    o[d0]=__builtin_amdgcn_mfma_f32_32x32x16_bf16(pa2,PK(2),o[d0],0,0,0);
    o[d0]=__builtin_amdgcn_mfma_f32_32x32x16_bf16(pa3,PK(3),o[d0],0,0,0);
    #undef PK
  }
}

#ifndef ATTN_STORE16
#define ATTN_STORE16(p,v) (*(u32x4*)(p)=(v))
#endif
template<int THRL> __device__ __forceinline__ void attn_unit(int b,int h,int qb,const bf16*Q,const bf16*__restrict__ K,const bf16*__restrict__ V,bf16*O,char*shm){
  const int qcol=(h>>1)*64, kcol=512+(h>>1)*64, vcol=((h>>2)*2+(h&1))*64, ocol=h*64;
  int tid_=threadIdx.x; asm volatile("":"+v"(tid_)); const int tid=tid_,lane=tid&63,r32=lane&31,hi=lane>>5; const int wid=__builtin_amdgcn_readfirstlane(tid>>6);
  const long rowbase=(long)b*SEQ; const int q0=qb*QB;
  const bf16*Qw=Q+(rowbase+q0+wid*QBLK)*QP+qcol;
  const bf16*Kh=K+rowbase*KP+kcol,*Vh=V+rowbase*VP+vcol;
  const unsigned lds0=(unsigned)(uintptr_t)shm;
  float*wsf=(float*)(shm+LDS_WS)+wid*64;
  const bf16*ksrc=Kh+(long)lane*KP+wid*8;
  const bf16*vsrc=Vh+(long)(16*(wid&3)+(lane>>2))*VP+(wid>>2)*32+(lane&3)*8;
  const unsigned kdst=lds0+LDS_K+wid*1024, vdst=lds0+LDS_V+wid*1024;
  #define DMA_K(t,slot) glds16(ksrc+(long)(t)*KVBLK*KP,(unsigned)__builtin_amdgcn_readfirstlane(kdst+(slot)))
  #define DMA_V(t,slot) glds16(vsrc+(long)(t)*KVBLK*VP,(unsigned)__builtin_amdgcn_readfirstlane(vdst+(slot)))
  const int vb0=(int)(lds0+LDS_V)+((lane>>4)&1)*32+(lane&3)*8+(4*hi+((lane&15)>>2))*64;
  const char*Kbase=shm+LDS_K; bf16x8 kf[8];
  const lds_cptr shm3=(lds_cptr)shm; const lds_cptr kp0=shm3+LDS_K+hi*1024+r32*16; const lds_cptr vp0=shm3+LDS_V+((lane>>4)&1)*32+(lane&3)*8+(4*hi+((lane&15)>>2))*64;
  const int NT=(q0+QB)/KVBLK;
  DMA_K(0,0);DMA_V(0,0);DMA_K(1,SLOTB);
  bf16x8 qr[4];
  #pragma unroll
  for(int d0=0;d0<4;++d0)qr[d0]=*reinterpret_cast<const bf16x8*>(&Qw[(long)r32*QP+d0*16+hi*8]);
  float mhat=0.f,l_reg=0.f;f32x16 o[2];o[0]=f32x16{};o[1]=f32x16{};f32x16 negm=f32x16{};asm volatile("":"+v"(negm));
  const int qrel=wid*QBLK+r32;
  #define CMASK(P0,P1,t) do{int jb_=(t)-(NT-4); if(jb_>=0)cmask(P0,P1,jb_,qrel,hi);}while(0)
  bool resc=false;
  #define START(P0,P1) do{ const float rm=rowmax(P0,P1); resc=false; \
    { const float dl=rm; mhat=fadd_s(mhat,dl); \
      _Pragma("unroll") for(int r=0;r<16;++r){P0[r]=fsub_s(P0[r],dl);P1[r]=fsub_s(P1[r],dl);} \
      _Pragma("unroll") for(int r=0;r<16;++r)negm[r]=-mhat; asm volatile("":"+v"(negm)); } \
    _Pragma("unroll") for(int r=0;r<16;++r)P0[r]=__builtin_amdgcn_exp2f(P0[r]); }while(0)
  #define RESC() do{ if(resc){ asm volatile("s_waitcnt lgkmcnt(0)":::"memory"); \
      _Pragma("unroll") for(int d_=0;d_<2;++d_) _Pragma("unroll") for(int r=0;r<16;++r)o[d_][r]*=wsf[crow(r,hi)]; } }while(0)
  f32x16 pA0,pA1,pB0,pB1;
  int sl_prev=0,sl_cur=0,sl_next=SLOTB;
  #define ROT() do{sl_prev=sl_cur;sl_cur=sl_next;sl_next=(sl_next==(NSLOT-1)*SLOTB)?0:sl_next+SLOTB;}while(0)
  DMA_K(2,2*SLOTB);
  WAIT_BAR(3);
  qkt(pA0,pA1,Kbase,qr,negm,r32,hi);asm volatile("s_nop 15\n\ts_nop 7":"+v"(pA0),"+v"(pA1));CMASK(pA0,pA1,0);
  START(pA0,pA1);
  _Pragma("unroll") for(int r=0;r<16;++r)pA1[r]=__builtin_amdgcn_exp2f(pA1[r]);
  WAIT_BAR(0);
  DMA_K(3,0);DMA_V(1,SLOTB);
  ROT();
  kload8(kf,kp0+sl_cur);
  WAIT_BAR(2);
  s16x4 vlo[8],vhi[8]; u32x4 pw0,pw1,pw2,pw3;
  #define PKW(P,B) cvtpk_s(P[B],P[B+1])
  #define PAF(k) __builtin_bit_cast(bf16x8,pw##k)
  #define VFR(i) (bf16x8){vlo[i][0],vlo[i][1],vlo[i][2],vlo[i][3],vhi[i][0],vhi[i][1],vhi[i][2],vhi[i][3]}
  #define PIN(x) asm volatile("":"+v"(x))
  #define MX3(a,b,c) __builtin_fmaxf(__builtin_fmaxf((a),(b)),(c))
  #define GAPA(MF,A0,A1,A2,A3,W0,W1,PW) do{ MF; sacc+=A0; sacc+=A1; sacc+=A2; sacc+=A3; PIN(sacc); W0; W1; PIN(PW); SBAR(); }while(0)
  #define EX(v) __builtin_amdgcn_exp2f(v)
  #define GAPB(MF,X,B) do{ MF; X[B]=EX(X[B]); X[B+1]=EX(X[B+1]); X[B+2]=EX(X[B+2]); X[B+3]=EX(X[B+3]); PIN(X); SBAR(); }while(0)
  #define VRD(i) do{ vlo[i]=vtr(vp_+(((i)>>2)*4096+((i)&3)*1024)); vhi[i]=vtr(vp_+(((i)>>2)*4096+((i)&3)*1024+512)); }while(0)
  #define KRD(G,j) do{ if(G){ kload2(kf,kp0+sl_next,j); SBAR(); } }while(0)
  #define STEP(C0,C1,P0,P1,t,GK,GV,GL) do{ SBAR(); \
    const lds_cptr vp_=vp0+sl_prev; \
    VRD(0); SBAR(); float sacc=(P0[0]+P0[1]); \
    GAPA(C0=__builtin_amdgcn_mfma_f32_32x32x16_bf16(kf[0],qr[0],negm,0,0,0), P0[2],P0[3],P0[4],P0[5],     pw0[0]=PKW(P0,0), pw0[1]=PKW(P0,2), pw0); \
    VRD(4); SBAR(); GAPA(C1=__builtin_amdgcn_mfma_f32_32x32x16_bf16(kf[1],qr[0],negm,0,0,0), P0[6],P0[7],P0[8],P0[9],     pw0[2]=PKW(P0,4), pw0[3]=PKW(P0,6), pw0); \
    VRD(1); SBAR(); GAPA(C0=__builtin_amdgcn_mfma_f32_32x32x16_bf16(kf[2],qr[1],C0,0,0,0),   P0[10],P0[11],P0[12],P0[13], pw1[0]=PKW(P0,8), pw1[1]=PKW(P0,10), pw1); \
    VRD(5); SBAR(); GAPA(C1=__builtin_amdgcn_mfma_f32_32x32x16_bf16(kf[3],qr[1],C1,0,0,0),   P0[14],P0[15],P1[0],P1[1],   pw1[2]=PKW(P0,12),pw1[3]=PKW(P0,14), pw1); \
    VRD(2); SBAR(); GAPA(C0=__builtin_amdgcn_mfma_f32_32x32x16_bf16(kf[4],qr[2],C0,0,0,0),   P1[2],P1[3],P1[4],P1[5],     pw2[0]=PKW(P1,0), pw2[1]=PKW(P1,2), pw2); \
    VRD(6); SBAR(); GAPA(C1=__builtin_amdgcn_mfma_f32_32x32x16_bf16(kf[5],qr[2],C1,0,0,0),   P1[6],P1[7],P1[8],P1[9],     pw2[2]=PKW(P1,4), pw2[3]=PKW(P1,6), pw2); \
    VRD(3); SBAR(); GAPA(C0=__builtin_amdgcn_mfma_f32_32x32x16_bf16(kf[6],qr[3],C0,0,0,0),   P1[10],P1[11],P1[12],P1[13], pw3[0]=PKW(P1,8), pw3[1]=PKW(P1,10), pw3); \
    VRD(7); SBAR(); GAPA(C1=__builtin_amdgcn_mfma_f32_32x32x16_bf16(kf[7],qr[3],C1,0,0,0),   P1[14],P1[15],0.f,0.f,       pw3[2]=PKW(P1,12),pw3[3]=PKW(P1,14), pw3); \
    l_reg+=sacc; \
    if(GK){DMA_K((t)+3,sl_cur);} if(GV){DMA_V((t)+1,sl_next);} \
    CMASK(C0,C1,t); \
    { float a=MX3(C0[0],C0[1],C1[0]),b=MX3(C0[2],C0[3],C1[1]); a=MX3(a,C1[2],C1[3]); \
      _Pragma("unroll") for(int r=4;r<16;r+=4){a=MX3(a,C0[r],C0[r+1]);b=MX3(b,C0[r+2],C0[r+3]);a=MX3(a,C1[r],C1[r+1]);b=MX3(b,C1[r+2],C1[r+3]);} \
      float rm=__builtin_fmaxf(a,b); { auto rr=__builtin_amdgcn_permlane32_swap(__float_as_uint(rm),__float_as_uint(rm),false,false); rm=__builtin_fmaxf(__uint_as_float(rr[0]),__uint_as_float(rr[1])); } \
      resc=false; \
      if(__builtin_expect(__any(rm>(float)THRL),0)){ const float dl=__builtin_fmaxf(rm,0.f); mhat+=dl; \
        _Pragma("unroll") for(int r=0;r<16;++r){C0[r]-=dl;C1[r]-=dl;} \
        _Pragma("unroll") for(int r=0;r<16;++r)negm[r]=-mhat; asm volatile("":"+v"(negm)); \
        const float f=__builtin_amdgcn_exp2f(-dl); l_reg*=f; if(hi==0)wsf[r32]=f; resc=true; } } \
    SBAR(); \
    GAPB(o[0]=__builtin_amdgcn_mfma_f32_32x32x16_bf16(PAF(0),VFR(0),o[0],0,0,0), C0,0); \
    GAPB(o[1]=__builtin_amdgcn_mfma_f32_32x32x16_bf16(PAF(0),VFR(4),o[1],0,0,0), C0,4); \
    KRD(GL,0); GAPB(o[0]=__builtin_amdgcn_mfma_f32_32x32x16_bf16(PAF(1),VFR(1),o[0],0,0,0), C0,8); \
    KRD(GL,1); GAPB(o[1]=__builtin_amdgcn_mfma_f32_32x32x16_bf16(PAF(1),VFR(5),o[1],0,0,0), C0,12); \
    KRD(GL,2); GAPB(o[0]=__builtin_amdgcn_mfma_f32_32x32x16_bf16(PAF(2),VFR(2),o[0],0,0,0), C1,0); \
    KRD(GL,3); GAPB(o[1]=__builtin_amdgcn_mfma_f32_32x32x16_bf16(PAF(2),VFR(6),o[1],0,0,0), C1,4); \
    GAPB(o[0]=__builtin_amdgcn_mfma_f32_32x32x16_bf16(PAF(3),VFR(3),o[0],0,0,0), C1,8); \
    GAPB(o[1]=__builtin_amdgcn_mfma_f32_32x32x16_bf16(PAF(3),VFR(7),o[1],0,0,0), C1,12); \
    }while(0)
  int t=1;
  #undef CMASK
  #define CMASK(P0,P1,t) do{}while(0)
  for(;t+5<NT;t+=2){
    STEP(pB0,pB1,pA0,pA1,t,true,true,true);     WAIT_BAR(2); RESC(); ROT();
    STEP(pA0,pA1,pB0,pB1,t+1,true,true,true);   WAIT_BAR(2); RESC(); ROT();
  }
  #undef CMASK
  #define CMASK(P0,P1,t) do{int jb_=(t)-(NT-4); if(jb_>=0)cmask(P0,P1,jb_,qrel,hi);}while(0)
  #define ENDW(tt) do{ if((tt)+3<NT){WAIT_BAR(2);} else if((tt)+2<NT){WAIT_BAR(1);} else {WAIT_BAR(0);} }while(0)
  for(;t+1<NT;t+=2){
    STEP(pB0,pB1,pA0,pA1,t,(t+3<NT),(t+1<NT),(t+1<NT));       ENDW(t);   RESC(); ROT();
    STEP(pA0,pA1,pB0,pB1,t+1,(t+4<NT),(t+2<NT),(t+2<NT));     ENDW(t+1); RESC(); ROT();
  }
  STEP(pB0,pB1,pA0,pA1,NT-1,false,false,false); RESC();
  { float sacc=pB0[0]+pB0[1]; _Pragma("unroll") for(int r=2;r<16;++r)sacc+=pB0[r]; _Pragma("unroll") for(int r=0;r<16;++r)sacc+=pB1[r]; l_reg+=sacc;
    pw0=(u32x4){PKW(pB0,0),PKW(pB0,2),PKW(pB0,4),PKW(pB0,6)};pw1=(u32x4){PKW(pB0,8),PKW(pB0,10),PKW(pB0,12),PKW(pB0,14)};pw2=(u32x4){PKW(pB1,0),PKW(pB1,2),PKW(pB1,4),PKW(pB1,6)};pw3=(u32x4){PKW(pB1,8),PKW(pB1,10),PKW(pB1,12),PKW(pB1,14)};
    SBAR(); pv(o,vb0+sl_cur,PAF(0),PAF(1),PAF(2),PAF(3)); }
  #undef PKW
  #undef PAF
  #undef VFR
  #undef PIN
  #undef MX3
  #undef GAPA
  #undef GAPB
  #undef EX
  #undef VRD
  #undef KRD
  #undef STEP
  #undef ENDW
  {auto rr=__builtin_amdgcn_permlane32_swap(__float_as_uint(l_reg),__float_as_uint(l_reg),false,false);l_reg=__uint_as_float(rr[0])+__uint_as_float(rr[1]);}
  if(hi==0)wsf[32+r32]=l_reg;asm volatile("s_waitcnt lgkmcnt(0)":::"memory");
  float rli[16];
  #pragma unroll
  for(int r=0;r<16;++r)rli[r]=__builtin_amdgcn_rcpf(wsf[32+crow(r,hi)]);
  bf16*Ow=O+(rowbase+q0+wid*QBLK)*OP+ocol;
  { bf16*stg=(bf16*)(shm+LDS_OST)+wid*2048;
    #pragma unroll
    for(int r=0;r<16;++r){const int orow=crow(r,hi);
      #pragma unroll
      for(int d0=0;d0<2;++d0)stg[orow*64+d0*32+r32]=__float2bfloat16(o[d0][r]*rli[r]);}
    asm volatile("s_waitcnt lgkmcnt(0)":::"memory");
    #pragma unroll
    for(int i=0;i<4;++i){const int row=i*8+(lane>>3),ch=lane&7; const u32x4 v=*(const u32x4*)(stg+row*64+ch*8); ATTN_STORE16(Ow+(long)row*OP+ch*8,v);} }
  asm volatile("s_waitcnt lgkmcnt(0)\n\ts_barrier":::"memory");
  #undef DMA_K
  #undef DMA_V
  #undef CMASK
  #undef START
  #undef RESC
  #undef ROT
}
constexpr int ATTN_LDS_BYTES=LDS_BYTES;
struct AttnTensors { const bf16* Q; const bf16* K; const bf16* V; bf16* O; };
struct AttnUnit { int bh; int qb; };
struct StaticOrder {
  int vcu;
  __device__ __forceinline__ explicit StaticOrder(int grid,int block):vcu((block%8)*(grid/8)+block/8){}
  __device__ __forceinline__ bool next(int i,AttnUnit&u)const{ if(i>=4)return false; const int s=vcu&7; u.bh=vcu>>3; u.qb=(i==0)?s:(i==1)?15-s:(i==2)?16+s:31-s; return true; }
  __device__ __forceinline__ void a_ready(const AttnUnit&)const{}
  __device__ __forceinline__ void done(const AttnUnit&)const{}
};
template<class Sched,int THRL=8> __device__ __forceinline__ void attn_phase(char*lds,const AttnTensors&T,const Sched&S){
  AttnUnit u;
  for(int i=0;S.next(i,u);++i){ S.a_ready(u); attn_unit<THRL>(u.bh/NHEAD,u.bh%NHEAD,u.qb,T.Q,T.K,T.V,T.O,lds); S.done(u); }
}
#undef SBAR
#undef WAIT_BAR
}
#define GAS __attribute__((address_space(1)))
#define LAS __attribute__((address_space(3)))
typedef unsigned short bf16;
typedef unsigned v4u __attribute__((ext_vector_type(4)));
typedef float f32x4 __attribute__((ext_vector_type(4)));
typedef short bf16x8 __attribute__((ext_vector_type(8)));
typedef GAS unsigned gu32;
typedef GAS unsigned long long gu64;
#define RLX_AGENT __ATOMIC_RELAXED, __HIP_MEMORY_SCOPE_AGENT
#define LDS_WAIT() asm volatile("s_waitcnt lgkmcnt(0)" ::: "memory")
#define VM_WAIT() asm volatile("s_waitcnt vmcnt(0)" ::: "memory")
__device__ __forceinline__ unsigned long long rt() { return __builtin_amdgcn_s_memrealtime(); }
__device__ __forceinline__ unsigned f2bf(float f) { unsigned u = __builtin_bit_cast(unsigned, f); return (u + 0x7fffu + ((u >> 16) & 1u)) >> 16; }
__device__ __forceinline__ unsigned pk2(float lo, float hi) { return f2bf(lo) | (f2bf(hi) << 16); }

#define XB_TMO      128
#define XB_XCNT(j)  (256  + 64 * (j))
#define XB_XSUB(j)  (1280 + 64 * (j))
#define XB_XGEN(j)  (2304 + 64 * (j))
#define XB_TOP      3328
#define XB_TOPGEN   3392
#define XCD_BAR_WORDS 3456
#define XB_SPIN_CAP (1u << 18)

__device__ __forceinline__ unsigned xb_ld(unsigned* p)              { return __hip_atomic_load(p, __ATOMIC_RELAXED, __HIP_MEMORY_SCOPE_AGENT); }
__device__ __forceinline__ unsigned xb_add(unsigned* p, unsigned v) { return __hip_atomic_fetch_add(p, v, __ATOMIC_RELAXED, __HIP_MEMORY_SCOPE_AGENT); }
__device__ __forceinline__ unsigned xb_xcc_id() { return (unsigned)__builtin_amdgcn_s_getreg((3 << 11) | 20) & 0xFu; }
#define XB_SPIN(cond, bar) do { unsigned _sp = 0; while (cond) { __builtin_amdgcn_s_sleep(1); \
    if ((++_sp & 255u) == 0u) { if (xb_ld(&(bar)[XB_TMO])) break; if (_sp > XB_SPIN_CAP) { atomicAdd(&(bar)[XB_TMO], 1u); break; } } } } while (0)

struct XcdBarrier {
    unsigned* bar; unsigned x;
    volatile LAS unsigned* st;
};

__device__ __forceinline__ XcdBarrier xcd_barrier_post(unsigned* bar, volatile LAS unsigned* st) {
    XcdBarrier b; b.bar = bar; b.x = xb_xcc_id(); b.st = st;
    if (threadIdx.x == 0) (void)xb_add(&bar[XB_XCNT(b.x)], 1u);
    return b;
}
__device__ __forceinline__ void xcd_barrier_complete(unsigned* bar, unsigned x, unsigned& nloc, unsigned& nx) {
    const unsigned G = gridDim.x * gridDim.y * gridDim.z;
    unsigned sum, cnt, mine, sp = 0u;
    for (;;) {
        sum = 0u; cnt = 0u; mine = 0u;
#pragma unroll
        for (unsigned j = 0; j < 16; ++j) { const unsigned c = xb_ld(&bar[XB_XCNT(j)]); sum += c; cnt += (c > 0u) ? 1u : 0u; mine = (j == x) ? c : mine; }
        if (sum == G) break;
        __builtin_amdgcn_s_sleep(1);
        if ((++sp & 255u) == 0u) { if (xb_ld(&bar[XB_TMO])) break; if (sp > XB_SPIN_CAP) { atomicAdd(&bar[XB_TMO], 1u); break; } }
    }
    nloc = mine > 0u ? mine : 1u; nx = cnt > 0u ? cnt : 1u;
}

__device__ __forceinline__ void xcd_barrier(const XcdBarrier& b) {
    asm volatile("s_waitcnt vmcnt(0)" ::: "memory");
    __syncthreads();
    if (threadIdx.x == 0) {
        unsigned* bar = b.bar;
        __builtin_amdgcn_s_waitcnt(0);
        unsigned nloc = b.st[0], nx = b.st[1];
        if (nloc == 0u) { xcd_barrier_complete(bar, b.x, nloc, nx); b.st[0] = nloc; b.st[1] = nx; }
        const unsigned old = xb_add(&bar[XB_XSUB(b.x)], 1u);
        const unsigned gen = old / nloc;
        if (old + 1u == (gen + 1u) * nloc) {
            __builtin_amdgcn_fence(__ATOMIC_RELEASE, "agent");
            asm volatile("s_waitcnt vmcnt(0)" ::: "memory");
            const unsigned og = xb_add(&bar[XB_TOP], 1u);
            const unsigned tg = og / nx;
            if (og + 1u == (tg + 1u) * nx) xb_add(&bar[XB_TOPGEN], 1u);
            else XB_SPIN(xb_ld(&bar[XB_TOPGEN]) == tg, bar);
            __builtin_amdgcn_fence(__ATOMIC_ACQUIRE, "agent");
            xb_add(&bar[XB_XGEN(b.x)], 1u);
            asm volatile("s_waitcnt vmcnt(0)" ::: "memory");
        } else {
            XB_SPIN(xb_ld(&bar[XB_XGEN(b.x)]) == gen, bar);
            __builtin_amdgcn_fence(__ATOMIC_ACQUIRE, "agent");
            asm volatile("s_waitcnt vmcnt(0)" ::: "memory");
        }
    }
    __syncthreads();
}
constexpr int NWAVES = 8;
constexpr int BATCH = 2, SEQ = 8192, D = 1024, M = BATCH * SEQ, DEPTH = 2, INC = 7168;
constexpr float LN_EPS = 1e-5f, ALPHA = 1.4142135623730951f, LOG2E = 1.4426950408889634f;
constexpr size_t MiB = 1u << 20;
constexpr size_t WS_CTL = 0, CTL_ZERO_BYTES = 1 * MiB;
constexpr size_t WS_WIN = 2 * MiB;
constexpr size_t WS_WBR = 30 * MiB;
constexpr size_t WS_WOUT = 36 * MiB;
constexpr size_t WS_WQ = 40 * MiB;
constexpr size_t WS_SUBK = 48 * MiB;
constexpr size_t WS_ROPEC = 49 * MiB, WS_ROPES = 51 * MiB;
constexpr size_t WS_LRUW = 53 * MiB;
constexpr size_t WS_MISC = 54 * MiB;
constexpr size_t WS_U = 56 * MiB, WS_V = 88 * MiB;
constexpr size_t WS_SU = 55 * MiB, WS_SV = 55 * MiB + 131072;
constexpr size_t WS_HB = 120 * MiB;
constexpr size_t WS_HL = WS_HB, WS_PP = 152 * MiB;
constexpr size_t WS_AQK = 184 * MiB;
constexpr size_t WS_AVT = 216 * MiB;
constexpr size_t WS_CQK = 232 * MiB;
constexpr size_t WS_CV = 264 * MiB;
constexpr size_t WS_BXG = 280 * MiB;
constexpr size_t WS_GATES = 312 * MiB;
constexpr size_t WS_YA = 408 * MiB, WS_YB = 424 * MiB, WS_YC = 440 * MiB;
constexpr size_t WS_CO = 456 * MiB;
constexpr size_t WS_END = 488 * MiB;
constexpr size_t WS_MERGEF = 184 * MiB;
constexpr size_t WS_MERGED = 248 * MiB;
constexpr size_t WS_YF = 312 * MiB;
constexpr size_t WS_PQ = 184 * MiB;
constexpr size_t WS_EIDX = 248 * MiB, WS_EG = 256 * MiB;
constexpr size_t WS_DBGH1 = 376 * MiB;
constexpr int CW_BAR = 4096;

constexpr int RING_OFF = 0, RING_BYTES = 131072;
constexpr int LDSCTL_OFF = RING_BYTES, MISC_OFF = LDSCTL_OFF + 320;
constexpr int LDS_BYTES = 147456;

typedef unsigned short bf16;
__device__ __forceinline__ float bf2f(unsigned short b) { return __uint_as_float((unsigned)b << 16); }
__device__ __forceinline__ float gelu_tanh(float x) {
    const float t = 1.5957691216057308f * (x + 0.044715f * x * x * x);
    return x * __builtin_amdgcn_rcpf(1.0f + __builtin_amdgcn_exp2f(-LOG2E * t));
}
__device__ __forceinline__ float wave_sum(float v) {
#pragma unroll
    for (int o = 1; o < 64; o <<= 1) v += __shfl_xor(v, o);
    return v;
}
typedef __bf16 bf16x2v __attribute__((ext_vector_type(2)));
__device__ __forceinline__ float dot2bf(unsigned a, unsigned b, float acc) { return __builtin_amdgcn_fdot2_f32_bf16(__builtin_bit_cast(bf16x2v, a), __builtin_bit_cast(bf16x2v, b), acc, false); }
typedef float f32x16 __attribute__((ext_vector_type(16)));
typedef unsigned u32x2e __attribute__((ext_vector_type(2)));
typedef int i32x4e __attribute__((ext_vector_type(4)));
#define MFMA32(a, b, c) __builtin_amdgcn_mfma_f32_32x32x16_bf16(a, b, c, 0, 0, 0)
#define MFMA16(a, b, c) __builtin_amdgcn_mfma_f32_16x16x32_bf16(a, b, c, 0, 0, 0)

__device__ __forceinline__ void p0_transpose_item(const float* W, int K, int N, bf16* WT, int perm_lo, int perm_hi, LAS float* scr, int item, int lane) {
    const int nblk = N / 32, kb = item / nblk, nb = item % nblk, k0 = 64 * kb, n0 = 32 * nb;
#pragma unroll 8
    for (int i = 0; i < 32; ++i) { const int kk = 2 * i + (lane >> 5); scr[kk * 33 + (lane & 31)] = W[(size_t)(k0 + kk) * N + n0 + (lane & 31)]; }
    LDS_WAIT(); asm volatile("" ::: "memory");
    const int c = lane & 7;
#pragma unroll
    for (int j = 0; j < 4; ++j) { const int n = (lane >> 3) + 8 * j; const LAS float* s = scr + (8 * c) * 33 + n;
        v4u o; o.x = pk2(s[0 * 33], s[1 * 33]); o.y = pk2(s[2 * 33], s[3 * 33]); o.z = pk2(s[4 * 33], s[5 * 33]); o.w = pk2(s[6 * 33], s[7 * 33]);
        int dn = n0 + n; if (dn >= perm_lo && dn < perm_hi) dn = (dn & ~63) + 2 * (dn & 31) + ((dn >> 5) & 1);
        *(GAS v4u*)(WT + (size_t)dn * K + k0 + 8 * c) = o; }
    LDS_WAIT(); asm volatile("" ::: "memory");
}
__device__ __forceinline__ void cvt_stream(const float* src, bf16* dst, size_t n8, size_t gt, size_t ngt) {
    for (size_t i = gt; i < n8; i += ngt) { const f32x4 a = *(const GAS f32x4*)(src + 8 * i), b = *(const GAS f32x4*)(src + 8 * i + 4);
        v4u o; o.x = pk2(a.x, a.y); o.y = pk2(a.z, a.w); o.z = pk2(b.x, b.y); o.w = pk2(b.z, b.w); *(GAS v4u*)(dst + 8 * i) = o; }
}
typedef float f32x2q __attribute__((ext_vector_type(2)));
__device__ __forceinline__ void quant_row_fp8(const float* src, unsigned char* dst, float* scale, int lane) {
    f32x4 v[4]; float am = 0.f;
#pragma unroll
    for (int j = 0; j < 4; ++j) { v[j] = *(const GAS f32x4*)(src + 16 * lane + 4 * j); am = fmaxf(am, fmaxf(fmaxf(fabsf(v[j].x), fabsf(v[j].y)), fmaxf(fabsf(v[j].z), fabsf(v[j].w)))); }
#pragma unroll
    for (int o = 1; o < 64; o <<= 1) am = fmaxf(am, __shfl_xor(am, o));
    const float sc = am > 0.f ? am * (1.0f / 448.0f) : 1.0f, inv = 1.0f / sc;
    v4u w; unsigned ww[4];
#pragma unroll
    for (int j = 0; j < 4; ++j) { int t = __builtin_amdgcn_cvt_pk_fp8_f32(v[j].x * inv, v[j].y * inv, 0, false); t = __builtin_amdgcn_cvt_pk_fp8_f32(v[j].z * inv, v[j].w * inv, t, true); ww[j] = (unsigned)t; }
    w.x = ww[0]; w.y = ww[1]; w.z = ww[2]; w.w = ww[3];
    *(GAS v4u*)(dst + 16 * lane) = w;
    if (lane == 0) *scale = sc;
}
__device__ __forceinline__ void b1_unit(int l, int unit, LAS unsigned char* lds, const bf16* BXG, const bf16* LRUW, const float* conv_w, const float* conv_b,
                                        const float* b_r, const float* b_i, const float* lam, float* HL, float* PP, int tid, int wid, int lane) {
    const int b = unit >> 9, c = (unit >> 2) & 127, qt = unit & 3;
    LAS float* XC = (LAS float*)lds;
    LAS float* IG = (LAS float*)(lds + 32768);
    LAS bf16* XB = (LAS bf16*)(lds + 65536);
    {
        const int ch = tid & 127, tq = tid >> 7, gc = qt * 128 + ch, s0 = c * 64 + tq * 16;
        const float w0 = conv_w[(l * 4 + 0) * 512 + gc], w1 = conv_w[(l * 4 + 1) * 512 + gc], w2 = conv_w[(l * 4 + 2) * 512 + gc], w3 = conv_w[(l * 4 + 3) * 512 + gc], cb = conv_b[l * 512 + gc];
        const bf16* bx = BXG + (size_t)b * SEQ * 1024 + gc;
        float xm3 = (s0 >= 3) ? bf2f(bx[(size_t)(s0 - 3) * 1024]) : 0.f, xm2 = (s0 >= 2) ? bf2f(bx[(size_t)(s0 - 2) * 1024]) : 0.f, xm1 = (s0 >= 1) ? bf2f(bx[(size_t)(s0 - 1) * 1024]) : 0.f;
#pragma unroll 4
        for (int t = 0; t < 16; ++t) { const float x0 = bf2f(bx[(size_t)(s0 + t) * 1024]); const float xc = cb + xm3 * w0 + xm2 * w1 + xm1 * w2 + x0 * w3;
            XC[(tq * 16 + t) * 128 + ch] = xc; XB[(tq * 16 + t) * 136 + ch] = (bf16)f2bf(xc); xm3 = xm2; xm2 = xm1; xm1 = x0; }
    }
    __syncthreads();
    const int blk = wid & 1, gate = (wid >> 1) & 1, th = wid >> 2, g = qt * 2 + blk, fr = lane & 15, fq = lane >> 4;
    f32x4 acc[2][4];
#pragma unroll
    for (int mt = 0; mt < 2; ++mt)
#pragma unroll
        for (int nt = 0; nt < 4; ++nt) acc[mt][nt] = (f32x4){0.f, 0.f, 0.f, 0.f};
    {
        const bf16* wb = LRUW + (size_t)(((l * 2 + gate) * 8 + g) * 64) * 64;
#pragma unroll
        for (int ks = 0; ks < 2; ++ks) { bf16x8 af[2], bfr[4];
#pragma unroll
            for (int mt = 0; mt < 2; ++mt) af[mt] = *(const LAS bf16x8*)(XB + (th * 32 + mt * 16 + fr) * 136 + blk * 64 + ks * 32 + 8 * fq);
#pragma unroll
            for (int nt = 0; nt < 4; ++nt) bfr[nt] = *(const GAS bf16x8*)(wb + (nt * 16 + fr) * 64 + ks * 32 + 8 * fq);
#pragma unroll
            for (int mt = 0; mt < 2; ++mt)
#pragma unroll
                for (int nt = 0; nt < 4; ++nt) acc[mt][nt] = MFMA16(af[mt], bfr[nt], acc[mt][nt]); }
    }
    const float* bias = (gate ? b_i : b_r) + (l * 8 + g) * 64;
#pragma unroll
    for (int nt = 0; nt < 4; ++nt) { const float bj = bias[nt * 16 + fr];
#pragma unroll
        for (int mt = 0; mt < 2; ++mt)
#pragma unroll
            for (int e = 0; e < 4; ++e) acc[mt][nt][e] = pg8::sigm(acc[mt][nt][e] + bj); }
    if (gate == 1) {
#pragma unroll
        for (int nt = 0; nt < 4; ++nt)
#pragma unroll
            for (int mt = 0; mt < 2; ++mt)
#pragma unroll
                for (int e = 0; e < 4; ++e) IG[(th * 32 + mt * 16 + 4 * fq + e) * 128 + blk * 64 + nt * 16 + fr] = acc[mt][nt][e];
    }
    __syncthreads();
    if (gate == 0) {
#pragma unroll
        for (int nt = 0; nt < 4; ++nt) { const float lm = lam[l * 512 + g * 64 + nt * 16 + fr];
            const float ls8 = -8.0f * log1pf(expf(-lm));
#pragma unroll
            for (int mt = 0; mt < 2; ++mt)
#pragma unroll
                for (int e = 0; e < 4; ++e) { const int o = (th * 32 + mt * 16 + 4 * fq + e) * 128 + blk * 64 + nt * 16 + fr;
                    const float la = acc[mt][nt][e] * ls8, a = expf(la), mult = sqrtf(-expm1f(2.0f * la));
                    const float u = mult * (IG[o] * XC[o]); IG[o] = a; XC[o] = u; } }
    }
    __syncthreads();
    if (tid < 128) { float h = 0.f, p = 1.f; const size_t o0 = ((size_t)b * SEQ + c * 64) * 512 + qt * 128 + tid;
#pragma unroll 8
        for (int t = 0; t < 64; ++t) { const float a = IG[t * 128 + tid], u = XC[t * 128 + tid]; h = a * h + u; p *= a; HL[o0 + (size_t)t * 512] = h; PP[o0 + (size_t)t * 512] = p; } }
    __syncthreads();
}
__device__ __forceinline__ void b3_unit(int unit, const float* HL, const float* PP, const bf16* BXG, bf16* YB, int tid) {
    const int b = unit >> 7, c = unit & 127; float hin = 0.f;
    const size_t base = (size_t)b * SEQ * 512 + tid;
#pragma unroll 4
    for (int cc = 0; cc < c; ++cc) { const size_t o = base + (size_t)(cc * 64 + 63) * 512; hin = PP[o] * hin + HL[o]; }
#pragma unroll 4
    for (int t = 0; t < 64; ++t) { const size_t row = (size_t)b * SEQ + c * 64 + t; const float h = HL[row * 512 + tid] + PP[row * 512 + tid] * hin;
        YB[row * 512 + tid] = (bf16)f2bf(h * gelu_tanh(bf2f(BXG[row * 1024 + 512 + tid]))); }
}
struct BandCtx { const bf16* kbase; const bf16* vbase; const float* rb; int qpos, hi; };
__device__ __forceinline__ void band_ldk(bf16x8 (&kf)[8], const BandCtx& cx, int j) {
    const bf16* kp = cx.kbase + (size_t)j * 64 * 1024;
#pragma unroll
    for (int ks = 0; ks < 4; ++ks) { kf[ks] = *(const GAS bf16x8*)(kp + ks * 16); kf[4 + ks] = *(const GAS bf16x8*)(kp + 32 * 1024 + ks * 16); }
}
__device__ __forceinline__ void band_tile(const bf16x8 (&kf)[8], bf16x8 (&kn)[8], bool has_next, const bf16x8 (&qf)[4], const BandCtx& cx, int j, f32x16& o0, f32x16& o1, float& mrun, float& lsum) {
    bf16x8 vf[8];
    { const bf16* vp = cx.vbase + (size_t)j * 64;
#pragma unroll
      for (int t4 = 0; t4 < 4; ++t4) { vf[t4] = *(const GAS bf16x8*)(vp + t4 * 16); vf[4 + t4] = *(const GAS bf16x8*)(vp + (size_t)32 * M + t4 * 16); } }
    if (has_next) band_ldk(kn, cx, j + 1);
    f32x16 s0 = {}, s1 = {};
#pragma unroll
    for (int ks = 0; ks < 4; ++ks) { s0 = MFMA32(kf[ks], qf[ks], s0); s1 = MFMA32(kf[4 + ks], qf[ks], s1); }
    float mx = -1e30f;
#pragma unroll
    for (int r = 0; r < 16; ++r) { const int kpos = j * 64 + (r & 3) + 4 * ((r >> 2) & 1) + 8 * cx.hi + 16 * (r >> 3);
        int d0 = cx.qpos - kpos, d1 = d0 - 32; d0 = d0 < -63 ? -63 : (d0 > 256 ? 256 : d0); d1 = d1 < -63 ? -63 : (d1 > 256 ? 256 : d1);
        s0[r] += cx.rb[d0 + 63]; s1[r] += cx.rb[d1 + 63]; mx = fmaxf(mx, fmaxf(s0[r], s1[r])); }
    mx = fmaxf(mx, __shfl_xor(mx, 32));
    const float mnew = fmaxf(mrun, mx), al = __builtin_amdgcn_exp2f(mrun - mnew); mrun = mnew;
    float ps = 0.f;
#pragma unroll
    for (int r = 0; r < 16; ++r) { s0[r] = __builtin_amdgcn_exp2f(s0[r] - mnew); s1[r] = __builtin_amdgcn_exp2f(s1[r] - mnew); ps += s0[r] + s1[r]; }
    lsum = lsum * al + ps;
#pragma unroll
    for (int r = 0; r < 16; ++r) { o0[r] *= al; o1[r] *= al; }
#pragma unroll
    for (int kb = 0; kb < 2; ++kb)
#pragma unroll
        for (int s2 = 0; s2 < 2; ++s2) { const f32x16& sv = kb ? s1 : s0; pg8::u32x4 pw;
            pw.x = pg8::cvt_pk_bf16(sv[8 * s2 + 0], sv[8 * s2 + 1]); pw.y = pg8::cvt_pk_bf16(sv[8 * s2 + 2], sv[8 * s2 + 3]);
            pw.z = pg8::cvt_pk_bf16(sv[8 * s2 + 4], sv[8 * s2 + 5]); pw.w = pg8::cvt_pk_bf16(sv[8 * s2 + 6], sv[8 * s2 + 7]);
            const bf16x8 pf = __builtin_bit_cast(bf16x8, pw);
            o0 = MFMA32(vf[kb * 2 + s2], pf, o0); o1 = MFMA32(vf[4 + kb * 2 + s2], pf, o1); }
}
__device__ __forceinline__ void band_unit(int unit, const bf16* AQK, const bf16* AVT, const float* rbl  , bf16* YA, int head, int lane) {
    const int b = unit >> 7, c = unit & 127, r32 = lane & 31, hi = lane >> 5;
    const int kap = (r32 & ~12) | ((r32 & 4) << 1) | ((r32 & 8) >> 1);
    const int j0 = c >= 8 ? c - 8 : 0;
    for (int qh = 0; qh < 2; ++qh) {
        const size_t qrow = (size_t)b * SEQ + c * 64 + qh * 32 + r32;
        BandCtx cx; cx.kbase = AQK + ((size_t)b * SEQ + kap) * 1024 + 512 + head * 64 + hi * 8; cx.vbase = AVT + ((size_t)(head * 64 + r32)) * M + (size_t)b * SEQ + 8 * hi;
        cx.rb = rbl; cx.qpos = c * 64 + qh * 32 + r32; cx.hi = hi;
        bf16x8 qf[4];
#pragma unroll
        for (int ks = 0; ks < 4; ++ks) qf[ks] = *(const GAS bf16x8*)(AQK + qrow * 1024 + head * 64 + ks * 16 + hi * 8);
        f32x16 o0 = {}, o1 = {}; float mrun = -1e30f, lsum = 0.f;
        bf16x8 kA[8], kB[8];
        band_ldk(kA, cx, j0);
        int j = j0;
        for (; j + 1 <= c; j += 2) { band_tile(kA, kB, true, qf, cx, j, o0, o1, mrun, lsum); band_tile(kB, kA, j + 2 <= c, qf, cx, j + 1, o0, o1, mrun, lsum); }
        if (j <= c) band_tile(kA, kB, false, qf, cx, j, o0, o1, mrun, lsum);
        lsum += __shfl_xor(lsum, 32);
        const float rl = 1.0f / lsum;
        bf16* yp = YA + qrow * 512 + head * 64 + 4 * hi;
#pragma unroll
        for (int g4 = 0; g4 < 4; ++g4) {
            u32x2e w0, w1; w0.x = pg8::cvt_pk_bf16(o0[4 * g4] * rl, o0[4 * g4 + 1] * rl); w0.y = pg8::cvt_pk_bf16(o0[4 * g4 + 2] * rl, o0[4 * g4 + 3] * rl);
            w1.x = pg8::cvt_pk_bf16(o1[4 * g4] * rl, o1[4 * g4 + 1] * rl); w1.y = pg8::cvt_pk_bf16(o1[4 * g4 + 2] * rl, o1[4 * g4 + 3] * rl);
            *(GAS u32x2e*)(yp + 8 * g4) = w0; *(GAS u32x2e*)(yp + 32 + 8 * g4) = w1; }
    }
}
__device__ __forceinline__ void comb_row(size_t row, const bf16* CO, const float* subg, float lamv, float oml, bf16* YC, int lane) {
    const pg8::u32x4 a = *(const GAS pg8::u32x4*)(CO + row * 1024 + 16 * lane), bq = *(const GAS pg8::u32x4*)(CO + row * 1024 + 16 * lane + 8);
    float v[16]; const unsigned w[8] = {a.x, a.y, a.z, a.w, bq.x, bq.y, bq.z, bq.w};
#pragma unroll
    for (int i = 0; i < 8; ++i) { v[2 * i] = __uint_as_float(w[i] << 16); v[2 * i + 1] = __uint_as_float(w[i] & 0xffff0000u); }
    float ss = 0.f;
#pragma unroll
    for (int i = 0; i < 16; ++i) { const float o2 = __shfl_xor(v[i], 8); v[i] = v[i] - lamv * o2; ss += v[i] * v[i]; }
    ss += __shfl_xor(ss, 1); ss += __shfl_xor(ss, 2); ss += __shfl_xor(ss, 4);
    const float rs = 1.0f / sqrtf(ss * (1.0f / 128.0f) + LN_EPS) * oml;
    if ((lane & 8) == 0) { const int h = lane >> 4, e0 = (lane & 7) * 16;
        unsigned ow[8];
#pragma unroll
        for (int i = 0; i < 8; ++i) ow[i] = pk2(v[2 * i] * rs * subg[e0 + 2 * i], v[2 * i + 1] * rs * subg[e0 + 2 * i + 1]);
        bf16* yp = YC + row * 512 + h * 128 + e0;
        *(GAS pg8::u32x4*)yp = (pg8::u32x4){ow[0], ow[1], ow[2], ow[3]}; *(GAS pg8::u32x4*)(yp + 8) = (pg8::u32x4){ow[4], ow[5], ow[6], ow[7]}; }
}
__device__ __forceinline__ void ln_row(const float* yrow, const float* g, const float* bta, float* hf, bf16* hb, float* dbg, int lane) {
    const GAS f32x4* xr = (const GAS f32x4*)yrow + lane;
    f32x4 v[4]; float s = 0.f;
#pragma unroll
    for (int j = 0; j < 4; ++j) { v[j] = xr[64 * j]; s += (v[j].x + v[j].y) + (v[j].z + v[j].w); }
    const float mean = wave_sum(s) * (1.f / D); float s2 = 0.f;
#pragma unroll
    for (int j = 0; j < 4; ++j) { v[j] = v[j] - mean; s2 += (v[j].x * v[j].x + v[j].y * v[j].y) + (v[j].z * v[j].z + v[j].w * v[j].w); }
    const float rstd = 1.f / sqrtf(wave_sum(s2) * (1.f / D) + LN_EPS);
#pragma unroll
    for (int j = 0; j < 4; ++j) { const f32x4 gg = *(const GAS f32x4*)(g + 4 * lane + 256 * j), bb = *(const GAS f32x4*)(bta + 4 * lane + 256 * j);
        const f32x4 o = v[j] * rstd * gg + bb;
        *((GAS f32x4*)hf + lane + 64 * j) = o; if (dbg) *((GAS f32x4*)dbg + lane + 64 * j) = o;
        *((GAS unsigned long long*)hb + lane + 64 * j) = (unsigned long long)pk2(o.x, o.y) | ((unsigned long long)pk2(o.z, o.w) << 32); }
}
__device__ __forceinline__ unsigned ordkey(float f) { unsigned u = __float_as_uint(f); return u ^ ((unsigned)((int)u >> 31) | 0x80000000u); }
__device__ __forceinline__ float ordval(unsigned k) { return __uint_as_float(k ^ ((k & 0x80000000u) ? 0x80000000u : 0xffffffffu)); }
#define CEX(a, b) do { const unsigned hi_ = (a) > (b) ? (a) : (b), lo_ = (a) > (b) ? (b) : (a); (a) = hi_; (b) = lo_; } while (0)
#define BSORT16(T) do { _Pragma("unroll") for (int k_ = 2; k_ <= 16; k_ <<= 1) _Pragma("unroll") for (int j_ = k_ >> 1; j_ > 0; j_ >>= 1) _Pragma("unroll") for (int i_ = 0; i_ < 16; ++i_) { const int l_ = i_ ^ j_; \
    if (l_ > i_) { if ((i_ & k_) == 0) CEX(T[i_], T[l_]); else CEX(T[l_], T[i_]); } } } while (0)
#define TOP16MERGE(L, T) do { _Pragma("unroll") for (int i_ = 0; i_ < 16; ++i_) L[i_] = L[i_] > T[15 - i_] ? L[i_] : T[15 - i_]; \
    _Pragma("unroll") for (int st_ = 8; st_ >= 1; st_ >>= 1) _Pragma("unroll") for (int i_ = 0; i_ < 16; ++i_) if ((i_ & st_) == 0) CEX(L[i_], L[i_ + st_]); } while (0)
#define INS16FROM(L, x, P0) do { _Pragma("unroll") for (int i_ = (P0); i_ < 16; ++i_) { const unsigned h_ = L[i_] > x ? L[i_] : x; x = L[i_] > x ? x : L[i_]; L[i_] = h_; } } while (0)
#define INS16(L, x) do { _Pragma("unroll") for (int i_ = 0; i_ < 16; ++i_) { const unsigned h_ = L[i_] > x ? L[i_] : x; x = L[i_] > x ? x : L[i_]; L[i_] = h_; } } while (0)
__device__ __forceinline__ void topk_unit(int tt, int hh, const bf16* PQ, LAS const unsigned char* KL  , int* EIDX, float* EG, LAS unsigned* wl  , int lane) {
    const int r32 = lane & 31, hi = lane >> 5;
    const size_t trow = (size_t)tt * 32 + r32;
    unsigned S[2][16];
#pragma unroll
    for (int p = 0; p < 2; ++p) {
        bf16x8 qf[8];
#pragma unroll
        for (int ks = 0; ks < 8; ++ks) qf[ks] = *(const GAS bf16x8*)(PQ + trow * 2048 + (hh * 2 + p) * 128 + ks * 16 + hi * 8);
        unsigned L[16];
#pragma unroll
        for (int i = 0; i < 16; ++i) L[i] = 0u;
#pragma unroll
        for (int rt = 0; rt < 4; ++rt) { f32x16 acc = {}; const int row = rt * 32 + r32; LAS const unsigned char* kr = KL + p * 32768 + row * 256;
#pragma unroll
            for (int ks = 0; ks < 8; ++ks) { const bf16x8 kf = *(LAS const bf16x8*)(kr + (((2 * ks + hi) ^ (row & 15)) << 4)); acc = MFMA32(kf, qf[ks], acc); }
            unsigned T[16];
#pragma unroll
            for (int r = 0; r < 16; ++r) { const int n = rt * 32 + (r & 3) + 8 * (r >> 2) + 4 * hi; T[r] = (ordkey(acc[r]) & ~127u) | (unsigned)n; }
            BSORT16(T);
            if (rt == 0) {
#pragma unroll
                for (int i = 0; i < 16; ++i) L[i] = T[i];
            } else { TOP16MERGE(L, T); }
            asm volatile("" ::: "memory"); }
        unsigned Mx[16];
#pragma unroll
        for (int i = 0; i < 16; ++i) { const unsigned o = (unsigned)__shfl_xor((int)L[15 - i], 32); Mx[i] = L[i] > o ? L[i] : o; }
#pragma unroll
        for (int st = 8; st >= 1; st >>= 1)
#pragma unroll
            for (int i = 0; i < 16; ++i) if ((i & st) == 0) { const unsigned a = Mx[i], b2 = Mx[i + st]; Mx[i] = a > b2 ? a : b2; Mx[i + st] = a > b2 ? b2 : a; }
#pragma unroll
        for (int i = 0; i < 16; ++i) { S[p][i] = Mx[i]; wl[(p * 16 + i) * 64 + lane] = Mx[i]; }
    }
    unsigned F[16];
#pragma unroll
    for (int i = 0; i < 16; ++i) F[i] = 0u;
#pragma unroll
    for (int i = 0; i < 16; ++i)
#pragma unroll
        for (int j = 0; j < 16; ++j) if ((i + 1) * (j + 1) <= 16) { const float sm = ordval(S[0][i] & ~127u) + ordval(S[1][j] & ~127u); unsigned x = (ordkey(sm) & ~255u) | (unsigned)(255 - (i * 16 + j)); INS16FROM(F, x, (i + 1) * (j + 1) - 1); }
    LDS_WAIT();
    float fs[16]; int ex[16]; float mx = -1e30f;
#pragma unroll
    for (int k = 0; k < 16; ++k) { const unsigned cd = 255u - (F[k] & 255u); const int i = (int)(cd >> 4), j = (int)(cd & 15u); const unsigned k0 = wl[i * 64 + lane], k1 = wl[(16 + j) * 64 + lane];
        fs[k] = ordval(k0 & ~127u) + ordval(k1 & ~127u); ex[k] = (int)((k0 & 127u) * 128u + (k1 & 127u)); mx = fmaxf(mx, fs[k]); }
    float sum = 0.f;
#pragma unroll
    for (int k = 0; k < 16; ++k) { fs[k] = __builtin_amdgcn_exp2f((fs[k] - mx) * LOG2E); sum += fs[k]; }
    const float rs = 1.0f / sum;
    if (hi == 0) { int* ep = EIDX + (trow * 8 + hh) * 16; float* gp = EG + (trow * 8 + hh) * 16;
#pragma unroll
        for (int q4 = 0; q4 < 4; ++q4) { *(GAS i32x4e*)(ep + 4 * q4) = (i32x4e){ex[4 * q4], ex[4 * q4 + 1], ex[4 * q4 + 2], ex[4 * q4 + 3]};
            *(GAS f32x4*)(gp + 4 * q4) = (f32x4){fs[4 * q4] * rs, fs[4 * q4 + 1] * rs, fs[4 * q4 + 2] * rs, fs[4 * q4 + 3] * rs}; } }
    LDS_WAIT();
}
__device__ __forceinline__ void deq16(const pg8::u32x4 w, float (&f)[16]) {
    const unsigned ww[4] = {w.x, w.y, w.z, w.w};
#pragma unroll
    for (int j = 0; j < 4; ++j) { const f32x2q a = __builtin_amdgcn_cvt_pk_f32_fp8((int)ww[j], false), b = __builtin_amdgcn_cvt_pk_f32_fp8((int)ww[j], true); f[4 * j] = a.x; f[4 * j + 1] = a.y; f[4 * j + 2] = b.x; f[4 * j + 3] = b.y; }
}
__device__ __forceinline__ void peer_row(size_t t, const float* hin, const int* EIDX, const float* EG, const unsigned char* U, const unsigned char* V, const float* SU, const float* SV,
                                         const float* g2, const float* b2, float* hf, bf16* hb, int lane) {
    float x[16];
#pragma unroll
    for (int j = 0; j < 4; ++j) { const f32x4 v = *(const GAS f32x4*)(hin + t * 1024 + 16 * lane + 4 * j); x[4 * j] = v.x; x[4 * j + 1] = v.y; x[4 * j + 2] = v.z; x[4 * j + 3] = v.w; }
    float o[16];
#pragma unroll
    for (int i = 0; i < 16; ++i) o[i] = 0.f;
    const int ei0 = EIDX[t * 128 + lane], ei1 = EIDX[t * 128 + 64 + lane];
    const float gs0 = EG[t * 128 + lane] * SV[ei0], gs1 = EG[t * 128 + 64 + lane] * SV[ei1];
    const float su0 = SU[ei0], su1 = SU[ei1];
    const int b5 = lane >> 5, b4 = (lane >> 4) & 1, b3 = (lane >> 3) & 1, b2_ = (lane >> 2) & 1, eloc = b5 * 8 + b4 * 4 + b3 * 2 + b2_;
    for (int grp = 0; grp < 8; ++grp) {
        const int src = grp < 4 ? ei0 : ei1; const float gsrc = grp < 4 ? gs0 : gs1, susrc = grp < 4 ? su0 : su1; const int l0 = (grp & 3) * 16;
        pg8::u32x4 ua[16], va[16];
#pragma unroll
        for (int e = 0; e < 16; ++e) { const int idx = __builtin_amdgcn_readlane(src, l0 + e); ua[e] = *(const GAS pg8::u32x4*)(U + (size_t)idx * 1024 + 16 * lane); va[e] = *(const GAS pg8::u32x4*)(V + (size_t)idx * 1024 + 16 * lane); }
        float p[16];
#pragma unroll
        for (int e = 0; e < 16; ++e) { float f[16]; deq16(ua[e], f); float a = 0.f;
#pragma unroll
            for (int i = 0; i < 16; ++i) a += f[i] * x[i];
            p[e] = a; }
        float q8[8], q4[4], q2[2], s;
#pragma unroll
        for (int i = 0; i < 8; ++i) { const float keep = b5 ? p[i + 8] : p[i], send = b5 ? p[i] : p[i + 8]; q8[i] = keep + __shfl_xor(send, 32); }
#pragma unroll
        for (int i = 0; i < 4; ++i) { const float keep = b4 ? q8[i + 4] : q8[i], send = b4 ? q8[i] : q8[i + 4]; q4[i] = keep + __shfl_xor(send, 16); }
#pragma unroll
        for (int i = 0; i < 2; ++i) { const float keep = b3 ? q4[i + 2] : q4[i], send = b3 ? q4[i] : q4[i + 2]; q2[i] = keep + __shfl_xor(send, 8); }
        { const float keep = b2_ ? q2[1] : q2[0], send = b2_ ? q2[0] : q2[1]; s = keep + __shfl_xor(send, 4); }
        s += __shfl_xor(s, 2); s += __shfl_xor(s, 1);
        const float w = gelu_tanh(s * __shfl(susrc, l0 + eloc)) * __shfl(gsrc, l0 + eloc);
#pragma unroll
        for (int e = 0; e < 16; ++e) { const float we = __builtin_bit_cast(float, __builtin_amdgcn_readlane(__builtin_bit_cast(int, w), e * 4)); float f[16]; deq16(va[e], f);
#pragma unroll
            for (int i = 0; i < 16; ++i) o[i] += we * f[i]; }
    }
    float y[16]; float sm = 0.f;
#pragma unroll
    for (int i = 0; i < 16; ++i) { y[i] = ALPHA * x[i] + o[i]; sm += y[i]; }
    const float mean = wave_sum(sm) * (1.f / D); float s2 = 0.f;
#pragma unroll
    for (int i = 0; i < 16; ++i) { y[i] -= mean; s2 += y[i] * y[i]; }
    const float rstd = 1.f / sqrtf(wave_sum(s2) * (1.f / D) + LN_EPS);
    unsigned ow[8];
#pragma unroll
    for (int j = 0; j < 4; ++j) { const f32x4 gg = *(const GAS f32x4*)(g2 + 16 * lane + 4 * j), bb = *(const GAS f32x4*)(b2 + 16 * lane + 4 * j);
        f32x4 ov; ov.x = y[4 * j] * rstd * gg.x + bb.x; ov.y = y[4 * j + 1] * rstd * gg.y + bb.y; ov.z = y[4 * j + 2] * rstd * gg.z + bb.z; ov.w = y[4 * j + 3] * rstd * gg.w + bb.w;
        *(GAS f32x4*)(hf + t * 1024 + 16 * lane + 4 * j) = ov; ow[2 * j] = pk2(ov.x, ov.y); ow[2 * j + 1] = pk2(ov.z, ov.w); }
    *(GAS pg8::u32x4*)(hb + t * 1024 + 16 * lane) = (pg8::u32x4){ow[0], ow[1], ow[2], ow[3]}; *(GAS pg8::u32x4*)(hb + t * 1024 + 16 * lane + 8) = (pg8::u32x4){ow[4], ow[5], ow[6], ow[7]};
}
#if MK_DEBUG
struct Args;
#define DBG_WORDS 64
__device__ __forceinline__ unsigned dh(unsigned x) { x ^= x >> 16; x *= 0x7feb352dU; x ^= x >> 15; x *= 0x846ca68bU; x ^= x >> 16; return x; }
__device__ __forceinline__ void dbg_rec(unsigned* slot, float got, float want, float fl) {
    float e = fabsf(got - want) / (fabsf(want) + fl); if (!(e == e) || e > 1e30f) e = 1e30f; atomicMax(slot, __float_as_uint(e));
}
__device__ __forceinline__ float dbf(const bf16* p, size_t i) { return bf2f(p[i]); }
__device__ __forceinline__ float rbf(float x) { return bf2f((bf16)f2bf(x)); }
__device__ __forceinline__ float dsig(float x) { return 1.0f / (1.0f + expf(-x)); }
__device__ __forceinline__ float dgelu(float x) { return 0.5f * x * (1.0f + tanhf(0.7978845608028654f * (x + 0.044715f * x * x * x))); }
__device__ __forceinline__ float dq8(const unsigned char* p, size_t i) { const int w = *(const int*)(p + (i & ~(size_t)3)); const int b = (int)(i & 3); return b == 0 ? __builtin_amdgcn_cvt_f32_fp8(w, 0) : b == 1 ? __builtin_amdgcn_cvt_f32_fp8(w, 1) : b == 2 ? __builtin_amdgcn_cvt_f32_fp8(w, 2) : __builtin_amdgcn_cvt_f32_fp8(w, 3); }
struct DArgs { const void* in[24]; float* out; unsigned char* ws; float invf[32]; int p, pad; };
#define DW(T, off) ((T*)(a.ws + (off)))
__global__ void __launch_bounds__(256) dbg_kernel(DArgs a) {
    __shared__ float sh[1024 + 256 + 64];
    const int p = a.p, l = p == 0 ? 0 : (p - 1) / 10, q = p == 0 ? 100 : (p - 1) % 10, tid = threadIdx.x;
    unsigned* slot = DW(unsigned, WS_MISC) + 16 + p;
    const unsigned sid = blockIdx.x * 256 + tid; unsigned r = dh(sid * 2654435761u + 77u * p + 1u);
#define RND(n) ((r = dh(r + 0x9e3779b9u)) % (unsigned)(n))
    const bf16* WINl = DW(bf16, WS_WIN) + (size_t)l * INC * 1024;
    if (q == 100) {
        { const int ll = RND(2), n = RND(INC), k = RND(1024); int dn = n; if (n >= 2560 && n < 3584) dn = (n & ~63) + 2 * (n & 31) + ((n >> 5) & 1);
          dbg_rec(slot, dbf(DW(bf16, WS_WIN), ((size_t)ll * INC + dn) * 1024 + k), rbf(((const float*)a.in[2])[((size_t)ll * 1024 + k) * INC + n]), 1e-3f); }
        { const int qq = RND(6), n = RND(1024), k = RND(512); dbg_rec(slot, dbf(DW(bf16, WS_WBR), ((size_t)qq * 1024 + n) * 512 + k), rbf(((const float*)a.in[14])[((size_t)qq * 512 + k) * 1024 + n]), 1e-3f); }
        { const int ll = RND(2), n = RND(1024), k = RND(1024); dbg_rec(slot, dbf(DW(bf16, WS_WOUT), ((size_t)ll * 1024 + n) * 1024 + k), rbf(((const float*)a.in[15])[((size_t)ll * 1024 + k) * 1024 + n]), 1e-3f); }
        { const int ll = RND(2), n = RND(2048), k = RND(1024); dbg_rec(slot, dbf(DW(bf16, WS_WQ), ((size_t)ll * 2048 + n) * 1024 + k), rbf(((const float*)a.in[18])[((size_t)ll * 1024 + k) * 2048 + n]), 1e-3f); }
        { const size_t i = RND(524288); dbg_rec(slot, dbf(DW(bf16, WS_SUBK), i), rbf(((const float*)a.in[19])[i]), 1e-3f); }
        { const size_t i = (size_t)RND(16384) * 1024 + RND(1024); const size_t i2 = i + (size_t)RND(2) * 16384 * 1024; dbg_rec(slot, dq8(DW(unsigned char, WS_U), i2) * DW(float, WS_SU)[i2 >> 10], ((const float*)a.in[20])[i2], 0.01f); dbg_rec(slot, dq8(DW(unsigned char, WS_V), i2) * DW(float, WS_SV)[i2 >> 10], ((const float*)a.in[21])[i2], 0.1f);
          dbg_rec(slot, dbf(DW(bf16, WS_HB), i), rbf(((const float*)a.in[0])[i]), 1e-3f); }
        { const int row = RND(M), fi = RND(32); const float ang = (float)((const int*)a.in[1])[row] * a.invf[fi]; const double rev = (double)ang * 0.15915494309189535; const float fr = (float)(rev - rint(rev)) * 6.283185307179586f;
          dbg_rec(slot, DW(float, WS_ROPEC)[row * 32 + fi], cosf(fr), 0.05f); dbg_rec(slot, DW(float, WS_ROPES)[row * 32 + fi], sinf(fr), 0.05f); }
        { const int i = RND(131072); const int k = i & 63, j = (i >> 6) & 63, g = (i >> 12) & 7, gate = (i >> 15) & 1, ll = i >> 16;
          dbg_rec(slot, dbf(DW(bf16, WS_LRUW), i), rbf(((const float*)a.in[gate ? 9 : 7])[((size_t)(ll * 8 + g) * 64 + k) * 64 + j]), 1e-3f); }
    } else if (q == 0) {
        const int row = RND(M); int c = RND(INC) & ~1;
        const bf16* hb = DW(bf16, WS_HB) + (size_t)row * 1024; float z0 = 0.f, z1 = 0.f;
        for (int k = 0; k < 1024; ++k) { const float h = bf2f(hb[k]); z0 += h * dbf(WINl, (size_t)c * 1024 + k); z1 += h * dbf(WINl, (size_t)(c + 1) * 1024 + k); }
        float g0, g1; const float C2S = 0.125f * LOG2E;
        if (c < 512) { g0 = dbf(DW(bf16, WS_AQK), (size_t)row * 1024 + c); g1 = dbf(DW(bf16, WS_AQK), (size_t)row * 1024 + c + 1); z0 *= C2S; z1 *= C2S; }
        else if (c < 1024) { g0 = dbf(DW(bf16, WS_AQK), (size_t)row * 1024 + c); g1 = dbf(DW(bf16, WS_AQK), (size_t)row * 1024 + c + 1); }
        else if (c < 1536) { g0 = dbf(DW(bf16, WS_AVT), (size_t)(c - 1024) * M + row); g1 = dbf(DW(bf16, WS_AVT), (size_t)(c - 1023) * M + row); }
        else if (c < 2560) { g0 = dbf(DW(bf16, WS_BXG), (size_t)row * 1024 + c - 1536); g1 = dbf(DW(bf16, WS_BXG), (size_t)row * 1024 + c - 1535); }
        else if (c < 3584) { const int i = (c & 63) >> 1; const float cs = DW(float, WS_ROPEC)[row * 32 + i], sn = DW(float, WS_ROPES)[row * 32 + i]; const float sc = c < 3072 ? C2S : 1.f;
            const float o0 = (z0 * cs - z1 * sn) * sc, o1 = (z1 * cs + z0 * sn) * sc; z0 = o0; z1 = o1;
            g0 = dbf(DW(bf16, WS_CQK), (size_t)row * 1024 + c - 2560); g1 = dbf(DW(bf16, WS_CQK), (size_t)row * 1024 + c - 2559); }
        else if (c < 4096) { g0 = dbf(DW(bf16, WS_CV), (size_t)row * 512 + c - 3584); g1 = dbf(DW(bf16, WS_CV), (size_t)row * 512 + c - 3583); }
        else { const float* gb = (const float*)a.in[3] + l * 3072; z0 = dsig(z0 + gb[c - 4096]); z1 = dsig(z1 + gb[c - 4095]); g0 = dbf(DW(bf16, WS_GATES), (size_t)row * 3072 + c - 4096); g1 = dbf(DW(bf16, WS_GATES), (size_t)row * 3072 + c - 4095); }
        { const int sec = c < 512 ? 0 : c < 1024 ? 1 : c < 1536 ? 2 : c < 2560 ? 3 : c < 3072 ? 4 : c < 3584 ? 5 : c < 4096 ? 6 : 7; unsigned* s2 = DW(unsigned, WS_MISC) + 40 + sec; if (l == 0) { dbg_rec(s2, g0, z0, 0.05f); dbg_rec(s2, g1, z1, 0.05f); if (sec == 7) { unsigned* s3 = DW(unsigned, WS_MISC) + 48 + (c - 4096) / 256; dbg_rec(s3, g0, z0, 0.05f); dbg_rec(s3, g1, z1, 0.05f); } } }
        dbg_rec(slot, g0, z0, 0.05f); dbg_rec(slot, g1, z1, 0.05f);
    } else if (q == 1) {
        if (blockIdx.x < 16) {
        const int row = RND(M), ch = RND(512), b = row >> 13, s = row & 8191, t0 = s & ~63, g = ch >> 6, j = ch & 63;
        const bf16* bxg = DW(bf16, WS_BXG); const float* cw = (const float*)a.in[5] + l * 2048; const float* cb = (const float*)a.in[6] + l * 512;
        const bf16* wr = DW(bf16, WS_LRUW) + (size_t)(((l * 2 + 0) * 8 + g) * 64 + j) * 64; const bf16* wi = DW(bf16, WS_LRUW) + (size_t)(((l * 2 + 1) * 8 + g) * 64 + j) * 64;
        const float lm = ((const float*)a.in[11])[l * 512 + ch], ls8 = -8.0f * log1pf(expf(-lm));
        float h = 0.f, pp = 1.f;
        for (int t = t0; t <= s; ++t) { float ar = ((const float*)a.in[8])[(l * 8 + g) * 64 + j], ai = ((const float*)a.in[10])[(l * 8 + g) * 64 + j], xcm = 0.f;
            for (int k = 0; k < 64; ++k) { const int c2 = g * 64 + k; float xc = cb[c2];
                for (int tap = 0; tap < 4; ++tap) { const int tt = t - 3 + tap; if (tt >= 0) xc += dbf(bxg, ((size_t)b * SEQ + tt) * 1024 + c2) * cw[tap * 512 + c2]; }
                if (k == j) xcm = xc; const float xb = rbf(xc); ar += xb * bf2f(wr[k]); ai += xb * bf2f(wi[k]); }
            const float rg = dsig(ar), ig = dsig(ai), la = rg * ls8, av = expf(la), u = sqrtf(-expm1f(2.f * la)) * (ig * xcm); h = av * h + u; pp *= av; }
        dbg_rec(slot, DW(float, WS_HL)[(size_t)row * 512 + ch], h, 0.02f); dbg_rec(slot, DW(float, WS_PP)[(size_t)row * 512 + ch], pp, 0.02f); }
    } else if (q == 2) {
        if (blockIdx.x < 8) {
            const int row = RND(M), head = RND(8), d = RND(64), b = row >> 13, s = row & 8191, c = s >> 6, j0 = c >= 8 ? c - 8 : 0;
            const bf16* aqk = DW(bf16, WS_AQK); const bf16* avt = DW(bf16, WS_AVT); const float* rb = (const float*)a.in[4] + (l * 8 + head) * 320;
            float mx = -1e30f;
            for (int pass = 0; pass < 2; ++pass) { float den = 0.f, num = 0.f;
                for (int kp = j0 * 64; kp < (c + 1) * 64; ++kp) { float sc = 0.f; for (int k = 0; k < 64; ++k) sc += dbf(aqk, (size_t)row * 1024 + head * 64 + k) * dbf(aqk, ((size_t)b * SEQ + kp) * 1024 + 512 + head * 64 + k);
                    int dist = s - kp; dist = dist < -63 ? -63 : (dist > 256 ? 256 : dist); sc = sc / LOG2E + rb[dist + 63];
                    if (pass == 0) mx = fmaxf(mx, sc); else { const float e = expf(sc - mx); den += e; num += e * dbf(avt, (size_t)(head * 64 + d) * M + (size_t)b * SEQ + kp); } }
                if (pass == 1) dbg_rec(slot, dbf(DW(bf16, WS_YA), (size_t)row * 512 + head * 64 + d), num / den, 0.03f); }
        } else if (blockIdx.x < 24) {
            const int row = RND(M - 1) + 1, ch = RND(512), b = row >> 13, s = row & 8191, g = ch >> 6, j = ch & 63;
            if (s > 0) { const bf16* bxg = DW(bf16, WS_BXG); const float gp = dgelu(dbf(bxg, (size_t)(row - 1) * 1024 + 512 + ch)), gc = dgelu(dbf(bxg, (size_t)row * 1024 + 512 + ch));
              if (fabsf(gp) > 0.2f) { const float* cw = (const float*)a.in[5] + l * 2048; const float* cb = (const float*)a.in[6] + l * 512;
                const bf16* wr = DW(bf16, WS_LRUW) + (size_t)(((l * 2 + 0) * 8 + g) * 64 + j) * 64; const bf16* wi = DW(bf16, WS_LRUW) + (size_t)(((l * 2 + 1) * 8 + g) * 64 + j) * 64;
                const float lm = ((const float*)a.in[11])[l * 512 + ch], ls8 = -8.0f * log1pf(expf(-lm));
                float ar = ((const float*)a.in[8])[(l * 8 + g) * 64 + j], ai = ((const float*)a.in[10])[(l * 8 + g) * 64 + j], xcm = 0.f;
                for (int k = 0; k < 64; ++k) { const int c2 = g * 64 + k; float xc = cb[c2];
                    for (int tap = 0; tap < 4; ++tap) { const int tt = s - 3 + tap; if (tt >= 0) xc += dbf(bxg, ((size_t)b * SEQ + tt) * 1024 + c2) * cw[tap * 512 + c2]; }
                    if (k == j) xcm = xc; const float xb = rbf(xc); ar += xb * bf2f(wr[k]); ai += xb * bf2f(wi[k]); }
                const float la = dsig(ar) * ls8, av = expf(la), u = sqrtf(-expm1f(2.f * la)) * (dsig(ai) * xcm);
                const float hp = dbf(DW(bf16, WS_YB), (size_t)(row - 1) * 512 + ch) / gp;
                dbg_rec(slot, dbf(DW(bf16, WS_YB), (size_t)row * 512 + ch), (av * hp + u) * gc, 0.05f); } }
        } else if (blockIdx.x < 32) {
            const int row = RND(M), vj = RND(16), d = RND(64), b = row >> 13, s = row & 8191, kend = ((s >> 6) + 1) * 64;
            const int qcol = (vj >> 1) * 64, kcol = 512 + (vj >> 1) * 64, vcol = ((vj >> 2) * 2 + (vj & 1)) * 64;
            const bf16* cqk = DW(bf16, WS_CQK); const bf16* cv = DW(bf16, WS_CV);
            float mx = -1e30f;
            for (int pass = 0; pass < 2; ++pass) { float den = 0.f, num = 0.f;
                for (int kp = 0; kp < kend; ++kp) { float sc = 0.f; for (int k = 0; k < 64; ++k) sc += dbf(cqk, (size_t)row * 1024 + qcol + k) * dbf(cqk, ((size_t)b * SEQ + kp) * 1024 + kcol + k);
                    sc = sc / LOG2E;
                    if (pass == 0) mx = fmaxf(mx, sc); else { const float e = expf(sc - mx); den += e; num += e * dbf(cv, ((size_t)b * SEQ + kp) * 512 + vcol + d); } }
                if (pass == 1) dbg_rec(slot, dbf(DW(bf16, WS_CO), (size_t)row * 1024 + vj * 64 + d), num / den, 0.01f); }
        }
    } else if (q == 3) {
        const int row = RND(M), h = RND(4), e = RND(128); const bf16* co = DW(bf16, WS_CO) + (size_t)row * 1024; const float lamv = DW(float, WS_MISC)[l], oml = DW(float, WS_MISC)[2 + l];
        float ss = 0.f, oe = 0.f;
        for (int i = 0; i < 128; ++i) { const int vh = i >> 6, dd = i & 63; const float o = bf2f(co[(h * 4 + vh) * 64 + dd]) - lamv * bf2f(co[(h * 4 + 2 + vh) * 64 + dd]); ss += o * o; if (i == e) oe = o; }
        dbg_rec(slot, dbf(DW(bf16, WS_YC), (size_t)row * 512 + h * 128 + e), oe / sqrtf(ss / 128.f + LN_EPS) * ((const float*)a.in[13])[l * 128 + e] * oml, 0.02f);
        if (sid == 0) { const float* dl = (const float*)a.in[12] + l * 256; float s1 = 0.f, s2 = 0.f; for (int i = 0; i < 64; ++i) { s1 += dl[i] * dl[64 + i]; s2 += dl[128 + i] * dl[192 + i]; }
            const float li = 0.8f - 0.6f * expf(-0.3f * l); dbg_rec(slot, lamv, expf(s1) - expf(s2) + li, 1e-3f); dbg_rec(slot, oml, 1.f - li, 1e-3f); }
    } else if (q == 4) {
        const int row = RND(M), col = RND(1024); float tot = 0.f;
        for (int n = 0; n < 3; ++n) { const bf16* y = DW(bf16, n == 0 ? WS_YA : (n == 1 ? WS_YB : WS_YC)) + (size_t)row * 512; const bf16* w = DW(bf16, WS_WBR) + ((size_t)(l * 3 + n) * 1024 + col) * 512; float acc = 0.f;
            for (int k = 0; k < 512; ++k) acc += bf2f(y[k]) * bf2f(w[k]); tot += acc * dbf(DW(bf16, WS_GATES), (size_t)row * 3072 + n * 1024 + col); }
        dbg_rec(slot, dbf(DW(bf16, WS_MERGED), (size_t)row * 1024 + col), tot, 0.02f);
    } else if (q == 5) {
        const int row = RND(M), col = RND(1024); const bf16* mg = DW(bf16, WS_MERGED) + (size_t)row * 1024; const bf16* w = DW(bf16, WS_WOUT) + ((size_t)l * 1024 + col) * 1024; float acc = 0.f;
        for (int k = 0; k < 1024; ++k) acc += bf2f(mg[k]) * bf2f(w[k]);
        const float res = (l == 0 ? (const float*)a.in[0] : (const float*)a.out)[(size_t)row * 1024 + col];
        dbg_rec(slot, DW(float, WS_YF)[(size_t)row * 1024 + col], ALPHA * res + acc, 0.05f);
    } else if (q == 6) {
        const int row = RND(M), col = RND(1024); const float* y = DW(float, WS_YF) + (size_t)row * 1024; float mu = 0.f, var = 0.f;
        for (int k = 0; k < 1024; ++k) mu += y[k]; mu /= 1024.f; for (int k = 0; k < 1024; ++k) var += (y[k] - mu) * (y[k] - mu); var /= 1024.f;
        const float want = (y[col] - mu) / sqrtf(var + LN_EPS) * ((const float*)a.in[16])[l * 1024 + col] + ((const float*)a.in[17])[l * 1024 + col];
        dbg_rec(slot, a.out[(size_t)row * 1024 + col], want, 0.02f); dbg_rec(slot, dbf(DW(bf16, WS_HB), (size_t)row * 1024 + col), want, 0.05f);
    } else if (q == 7) {
        const int row = RND(M), col = RND(2048); const bf16* hb = DW(bf16, WS_HB) + (size_t)row * 1024; const bf16* w = DW(bf16, WS_WQ) + ((size_t)l * 2048 + col) * 1024; float acc = 0.f;
        for (int k = 0; k < 1024; ++k) acc += bf2f(hb[k]) * bf2f(w[k]);
        dbg_rec(slot, dbf(DW(bf16, WS_PQ), (size_t)row * 2048 + col), acc, 0.05f);
    } else if (q == 8) {
        unsigned rr = dh(blockIdx.x * 2654435761u + 977u * p + 5u); const int row = rr % M, hh = (rr >> 20) & 7;
        const bf16* pq = DW(bf16, WS_PQ) + (size_t)row * 2048 + hh * 256; const bf16* sk = DW(bf16, WS_SUBK) + (size_t)(l * 16 + hh * 2) * 128 * 128;
        { const int pp = tid >> 7, n = tid & 127; float acc = 0.f; for (int k = 0; k < 128; ++k) acc += bf2f(pq[pp * 128 + k]) * bf2f(sk[((size_t)pp * 128 + n) * 128 + k]); sh[tid] = acc; }
        __syncthreads();
        const int* ei = DW(int, WS_EIDX) + ((size_t)row * 8 + hh) * 16; const float* eg = DW(float, WS_EG) + ((size_t)row * 8 + hh) * 16;
        float fmin = 1e30f, fmax = -1e30f, gs = 0.f; for (int k = 0; k < 16; ++k) { const int e = ei[k]; const float f = sh[(e >> 7) & 127] + sh[128 + (e & 127)]; fmin = fminf(fmin, f); fmax = fmaxf(fmax, f); gs += eg[k]; }
        int cnt = 0; for (int i = tid; i < 16384; i += 256) cnt += (sh[i >> 7] + sh[128 + (i & 127)] > fmin + 2e-3f) ? 1 : 0;
        sh[512 + tid] = (float)cnt; __syncthreads();
        if (tid == 0) { float tot = 0.f; for (int i = 0; i < 256; ++i) tot += sh[512 + i]; dbg_rec(slot, tot > 15.5f ? 1.f : 0.f, 0.f, 1.f);
            dbg_rec(slot, gs, 1.f, 0.f); float den = 0.f; for (int k = 0; k < 16; ++k) { const int e = ei[k]; den += expf(sh[(e >> 7) & 127] + sh[128 + (e & 127)] - fmax); }
            for (int k = 0; k < 16; ++k) { const int e = ei[k]; dbg_rec(slot, eg[k], expf(sh[(e >> 7) & 127] + sh[128 + (e & 127)] - fmax) / den, 0.01f); }
            for (int k = 0; k < 16; ++k) for (int k2 = 0; k2 < k; ++k2) if (ei[k] == ei[k2]) dbg_rec(slot, 1.f, 0.f, 1.f); }
    } else if (q == 9) {
        unsigned rr = dh(blockIdx.x * 2654435761u + 31u * p + 9u); const int row = rr % M;
        const float* h1 = DW(float, WS_DBGH1) + (size_t)row * 1024; const int* ei = DW(int, WS_EIDX) + (size_t)row * 128; const float* eg = DW(float, WS_EG) + (size_t)row * 128;
        float y[4] = {0.f, 0.f, 0.f, 0.f};
        for (int e = 0; e < 128; ++e) { const size_t ex = (size_t)ei[e]; float part = 0.f; for (int k = tid; k < 1024; k += 256) part += h1[k] * dq8(DW(unsigned char, WS_U) + (size_t)l * 16384 * 1024, ex * 1024 + k);
            sh[tid] = part; __syncthreads(); if (tid < 64) { float s2 = sh[tid] + sh[tid + 64] + sh[tid + 128] + sh[tid + 192]; s2 = wave_sum(s2); if (tid == 0) sh[1024] = s2; } __syncthreads();
            const float w = eg[e] * dgelu(sh[1024] * DW(float, WS_SU)[l * 16384 + ex]) * DW(float, WS_SV)[l * 16384 + ex]; for (int i = 0; i < 4; ++i) y[i] += w * dq8(DW(unsigned char, WS_V) + (size_t)l * 16384 * 1024, ex * 1024 + tid + 256 * i); __syncthreads(); }
        float ps = 0.f; for (int i = 0; i < 4; ++i) { y[i] += ALPHA * h1[tid + 256 * i]; ps += y[i]; }
        sh[tid] = ps; __syncthreads(); if (tid == 0) { float t2 = 0.f; for (int i = 0; i < 256; ++i) t2 += sh[i]; sh[1025] = t2 / 1024.f; } __syncthreads(); const float mu = sh[1025];
        ps = 0.f; for (int i = 0; i < 4; ++i) ps += (y[i] - mu) * (y[i] - mu);
        __syncthreads(); sh[tid] = ps; __syncthreads(); if (tid == 0) { float t2 = 0.f; for (int i = 0; i < 256; ++i) t2 += sh[i]; sh[1026] = 1.f / sqrtf(t2 / 1024.f + LN_EPS); } __syncthreads();
        for (int i = 0; i < 4; ++i) { const int col = tid + 256 * i; dbg_rec(slot, a.out[(size_t)row * 1024 + col], (y[i] - mu) * sh[1026] * ((const float*)a.in[22])[l * 1024 + col] + ((const float*)a.in[23])[l * 1024 + col], 0.03f); }
    }
#undef RND
}
__global__ void dbg_scan(DArgs a) { const size_t i = (size_t)blockIdx.x * 256 + threadIdx.x; unsigned bad = 0; for (size_t j = i; j < (size_t)M * D; j += (size_t)gridDim.x * 256) { const float v = a.out[j]; if (!(v == v) || fabsf(v) > 1e30f) bad = 1; } if (bad) atomicMax(DW(unsigned, WS_MISC) + 15, 1u); }
__global__ void dbg_encode(DArgs a, float tol) {
    const unsigned* w = DW(unsigned, WS_MISC) + 16; int k = 0;
    for (int p = 0; p < 21; ++p) if (__uint_as_float(w[p]) > tol) { k = p + 1; break; }
    if (k == 2) { for (int s2 = 0; s2 < 8; ++s2) if (__uint_as_float(w[24 + s2]) > tol) { k = 50 + s2; break; } }
    if (k == 57) { int nf = 0, first = -1; for (int s3 = 0; s3 < 12; ++s3) if (__uint_as_float(w[32 + s3]) > tol) { ++nf; if (first < 0) first = s3; } k = 60 + first + 13 * (nf > 1 ? 1 : 0) + 13 * (nf == 12 ? 1 : 0); }
    if (k == 0 && DW(unsigned, WS_MISC)[15]) k = 40;
    if (k == 0) return;
    const float c = sqrtf((float)k);
    for (size_t j = (size_t)blockIdx.x * 256 + threadIdx.x; j < (size_t)M * D; j += (size_t)gridDim.x * 256) a.out[j] = c;
}
static void dbg_check(int p, const void* const* in, float* out, unsigned char* ws, const float* invf, hipStream_t stream) {
    DArgs d{}; for (int i = 0; i < 24; ++i) d.in[i] = in[i]; d.out = out; d.ws = ws; for (int i = 0; i < 32; ++i) d.invf[i] = invf[i]; d.p = p;
    hipLaunchKernelGGL(dbg_kernel, dim3(64), dim3(256), 0, stream, d);
}
static void dbg_final(const void* const* in, float* out, unsigned char* ws, hipStream_t stream) {
    DArgs d{}; for (int i = 0; i < 24; ++i) d.in[i] = in[i]; d.out = out; d.ws = ws; d.p = 0;
    hipLaunchKernelGGL(dbg_scan, dim3(1024), dim3(256), 0, stream, d);
    hipLaunchKernelGGL(dbg_encode, dim3(1024), dim3(256), 0, stream, d, 0.08f);
}
#endif
struct Args { const void* in[24]; float* out; unsigned char* ws; float invf[32]; int ph_lo, ph_hi, dbg, pad; };
constexpr int NPH = 1 + DEPTH * 10;

__global__ void __launch_bounds__(NWAVES * 64, 2) mk_fwd(Args args) {
    extern __shared__ __attribute__((aligned(16))) unsigned char lds[];
    LAS unsigned char* L = (LAS unsigned char*)lds;
    volatile LAS unsigned* MISC = (volatile LAS unsigned*)(L + MISC_OFF);
#define PH_IDS int tid = threadIdx.x; asm volatile("" : "+v"(tid)); const int lane = tid & 63, wave = __builtin_amdgcn_readfirstlane(tid >> 6); (void)lane; (void)wave;
    const int G = gridDim.x, bx = blockIdx.x, vcu = (G % 8 == 0) ? (bx % 8) * (G / 8) + bx / 8 : bx;
    gu32* ctl = (gu32*)(args.ws + WS_CTL);
    for (int u = threadIdx.x; u < (LDS_BYTES - LDSCTL_OFF) / 4; u += NWAVES * 64) ((LAS unsigned*)(L + LDSCTL_OFF))[u] = 0u;
    __syncthreads();
    XcdBarrier bar = xcd_barrier_post((unsigned*)(ctl + CW_BAR), MISC + 8);
    const int lo = args.ph_lo, hi = args.ph_hi;
#if MK_STAMP
    if (blockIdx.x == 0 && threadIdx.x == 0) ((unsigned long long*)(args.ws + WS_MISC + 1024))[0] = __builtin_amdgcn_s_memrealtime();
#endif
#ifndef MK_ONLYQ
#define MK_ONLYQ -1
#endif
#define IN(k) (lo <= (k) && (k) < hi)
#define INQ(q) ((MK_ONLYQ < 0 || MK_ONLYQ == (q)) && IN(pb + (q)))
#define REP(q) for (int rep_ = 0; rep_ < ((((MK_DUP) >> (q)) & 1) ? 2 : 1); ++rep_)
#if MK_STAMP
#define STAMP(k) do { if (blockIdx.x == 0 && threadIdx.x == 0) ((unsigned long long*)(args.ws + WS_MISC + 1024))[(k)] = __builtin_amdgcn_s_memrealtime(); } while (0)
#else
#define STAMP(k) do {} while (0)
#endif
#define SEAM(k) do { if (IN(k) && IN((k) + 1)) xcd_barrier(bar); STAMP((k) + 1); } while (0)
#define GT ((size_t)vcu * 512 + tid)
#define NGT ((size_t)G * 512)
#define GW (vcu * NWAVES + wave)
#define NGW (G * NWAVES)
#define WSP(T, off) ((T*)(args.ws + (off)))
#define x_in ((const float*)args.in[0])
#define WIN WSP(bf16, WS_WIN)
#define WBR WSP(bf16, WS_WBR)
#define WOUT WSP(bf16, WS_WOUT)
#define WQ WSP(bf16, WS_WQ)
#define SUBK WSP(bf16, WS_SUBK)
#define ROPEC WSP(float, WS_ROPEC)
#define ROPES WSP(float, WS_ROPES)
#define LRUW WSP(bf16, WS_LRUW)
#define MISCW WSP(float, WS_MISC)
#define UB WSP(unsigned char, WS_U)
#define VB WSP(unsigned char, WS_V)
#define SUB WSP(float, WS_SU)
#define SVB WSP(float, WS_SV)
#define HB WSP(bf16, WS_HB)
#define HL WSP(float, WS_HL)
#define PP WSP(float, WS_PP)
#define AQK WSP(bf16, WS_AQK)
#define AVT WSP(bf16, WS_AVT)
#define CQK WSP(bf16, WS_CQK)
#define CV WSP(bf16, WS_CV)
#define BXG WSP(bf16, WS_BXG)
#define GATES WSP(bf16, WS_GATES)
#define YA WSP(bf16, WS_YA)
#define YB WSP(bf16, WS_YB)
#define YC WSP(bf16, WS_YC)
#define CO WSP(bf16, WS_CO)
#define MERGEF WSP(float, WS_MERGEF)
#define MERGED WSP(bf16, WS_MERGED)
#define YF WSP(float, WS_YF)
#define PQ WSP(bf16, WS_PQ)
#define EIDX WSP(int, WS_EIDX)
#define EG WSP(float, WS_EG)
#define HF (args.out)
#define DBGH1 (args.dbg ? WSP(float, WS_DBGH1) : (float*)nullptr)

    if ((MK_ONLYQ < 0 || MK_ONLYQ == 100) && IN(0)) for (int rep_ = 0; rep_ < ((((MK_DUP) >> 13) & 1) ? 2 : 1); ++rep_) { PH_IDS
        LAS float* scr = (LAS float*)(L + RING_OFF + wave * 16384);
        constexpr int I_IN = 16 * 224, I_BR = 8 * 32, I_OUT = 16 * 32, I_Q = 16 * 64;
        constexpr int NITEMS = 2 * I_IN + 6 * I_BR + 2 * I_OUT + 2 * I_Q;
        for (int it = GW; it < NITEMS; it += NGW) {
            int r = it;
            if (r < 2 * I_IN) { const int l = r / I_IN; p0_transpose_item((const float*)args.in[2] + (size_t)l * 1024 * INC, 1024, INC, WIN + (size_t)l * INC * 1024, 2560, 3584, scr, r % I_IN, lane); continue; } r -= 2 * I_IN;
            if (r < 6 * I_BR) { const int q = r / I_BR; p0_transpose_item((const float*)args.in[14] + (size_t)q * 512 * 1024, 512, 1024, WBR + (size_t)q * 1024 * 512, 0, 0, scr, r % I_BR, lane); continue; } r -= 6 * I_BR;
            if (r < 2 * I_OUT) { const int l = r / I_OUT; p0_transpose_item((const float*)args.in[15] + (size_t)l * 1024 * 1024, 1024, 1024, WOUT + (size_t)l * 1024 * 1024, 0, 0, scr, r % I_OUT, lane); continue; } r -= 2 * I_OUT;
            { const int l = r / I_Q; p0_transpose_item((const float*)args.in[18] + (size_t)l * 1024 * 2048, 1024, 2048, WQ + (size_t)l * 2048 * 1024, 0, 0, scr, r % I_Q, lane); }
        }
        cvt_stream((const float*)args.in[19], SUBK, (size_t)2 * 8 * 2 * 128 * 128 / 8, GT, NGT);
        cvt_stream(x_in, HB, (size_t)M * D / 8, GT, NGT);
        for (int r = GW; r < 2 * 32768; r += NGW) { const int tsel = r >> 15, row = r & 32767;
            quant_row_fp8((const float*)args.in[tsel ? 21 : 20] + (size_t)row * 1024, (tsel ? VB : UB) + (size_t)row * 1024, (tsel ? SVB : SUB) + row, lane); }
        for (size_t i = GT; i < (size_t)2 * 2 * 8 * 4096; i += NGT) { const int k = i & 63, j = (i >> 6) & 63, g = (i >> 12) & 7, gate = (i >> 15) & 1, l = (int)(i >> 16);
            const float* w = (const float*)args.in[gate ? 9 : 7]; LRUW[i] = (bf16)f2bf(w[((size_t)(l * 8 + g) * 64 + k) * 64 + j]); }
        for (size_t i = GT; i < (size_t)M * 32; i += NGT) { const int row = (int)(i >> 5), fi = (int)(i & 31);
            const float ang = (float)((const int*)args.in[1])[row] * args.invf[fi];
            const double rev = (double)ang * 0.15915494309189535; const float fr = (float)(rev - __builtin_rint(rev));
            ROPEC[i] = __builtin_amdgcn_cosf(fr); ROPES[i] = __builtin_amdgcn_sinf(fr); }
        if (bx == 0 && tid < 2) { const float* dl = (const float*)args.in[12] + tid * 256; float s1 = 0.f, s2 = 0.f;
            for (int i = 0; i < 64; ++i) { s1 += dl[i] * dl[64 + i]; s2 += dl[128 + i] * dl[192 + i]; }
            const float li = tid == 0 ? 0.2f : 0.35550906759096926f;
            MISCW[tid] = expf(s1) - expf(s2) + li; MISCW[2 + tid] = 1.0f - li; }
    }
    SEAM(0);
    for (int l = 0; l < DEPTH; ++l) {
        const int pb = 1 + 10 * l;
        if (INQ(0)) REP(0) { PH_IDS
            { pg8::Gemm g{HB, WIN + (size_t)l * INC * 1024, M, INC, 1024}; pg8::InOrder S; S.init(G, bx);
              pg8::EpiIn E{AQK, BXG, CQK, CV, GATES, (const float*)args.in[3] + l * 3072, ROPEC, ROPES};
              pg8::gemm_phase<pg8::EpiIn, pg8::InOrder, PG8_ALIGN, PG8_SP2>(L + RING_OFF, g, S, E); }
            { pg8::Gemm g{WIN + (size_t)l * INC * 1024 + (size_t)1024 * 1024, HB, 512, M, 1024}; pg8::StaticOrder S; S.init(512, M, G, (bx + G / 2) % G);
              pg8::EpiBf16<0> E{AVT, M, nullptr, 0, 0, 1.f};
              pg8::gemm_phase<pg8::EpiBf16<0>, pg8::StaticOrder, PG8_ALIGN, PG8_SP2>(L + RING_OFF, g, S, E); }
        }
        SEAM(pb + 0);
        if (INQ(1)) REP(1) { PH_IDS
            for (int u = vcu; u < 1024; u += G)
                b1_unit(l, u, L, BXG, LRUW, (const float*)args.in[5], (const float*)args.in[6], (const float*)args.in[8], (const float*)args.in[10], (const float*)args.in[11], HL, PP, tid, wave, lane);
        }
        SEAM(pb + 1);
        if (INQ(2)) REP(2) { PH_IDS
            for (int r2 = 0; r2 < ((((MK_DUP) >> 10) & 1) ? 2 : 1); ++r2) { LAS float* rbl = (LAS float*)(L + RING_OFF) + wave * 320;
              for (int i = lane; i < 320; i += 64) rbl[i] = ((const float*)args.in[4])[(l * 8 + wave) * 320 + i] * LOG2E;
              LDS_WAIT();
              for (int u = vcu; u < 256; u += G) band_unit(u, AQK, AVT, (const float*)rbl, YA, wave, lane); }
            for (int r2 = 0; r2 < ((((MK_DUP) >> 11) & 1) ? 2 : 1); ++r2) for (int u = vcu; u < 256; u += G) b3_unit(u, HL, PP, BXG, YB, tid);
            __syncthreads();
            const attn_body::AttnTensors AT{(const attn_body::bf16*)CQK, (const attn_body::bf16*)CQK, (const attn_body::bf16*)CV, (attn_body::bf16*)CO};
            const attn_body::StaticOrder S(G, bx);
            for (int r2 = 0; r2 < ((((MK_DUP) >> 12) & 1) ? 2 : 1); ++r2) attn_body::attn_phase<attn_body::StaticOrder>((char*)lds + RING_OFF, AT, S);
        }
        SEAM(pb + 2);
        if (INQ(3)) REP(3) { PH_IDS
            const float lamv = MISCW[l], oml = MISCW[2 + l];
            for (int m = GW; m < M; m += NGW) comb_row((size_t)m, CO, (const float*)args.in[13] + l * 128, lamv, oml, YC, lane);
        }
        SEAM(pb + 3);
        if (INQ(4)) REP(4) { PH_IDS
            pg8::Gemm g{YA, WBR + (size_t)l * 3 * 1024 * 512, 3 * M, 3072, 512}; pg8::MergeOrder S; S.init(G, bx); pg8::EpiMerge E{GATES, MERGED};
            pg8::gemm_phase<pg8::EpiMerge, pg8::MergeOrder, PG8_ALIGN, PG8_SP2>(L + RING_OFF, g, S, E);
        }
        SEAM(pb + 4);
        if (INQ(5)) REP(5) { PH_IDS
            pg8::Gemm g{MERGED, WOUT + (size_t)l * 1024 * 1024, M, 1024, 1024}; pg8::StaticOrder S; S.init(M, 1024, G, bx);
            pg8::EpiOut E{l == 0 ? x_in : HF, YF, ALPHA};
            pg8::gemm_phase<pg8::EpiOut, pg8::StaticOrder, false, PG8_SP2>(L + RING_OFF, g, S, E);
        }
        SEAM(pb + 5);
        if (INQ(6)) REP(6) { PH_IDS
            for (int m = GW; m < M; m += NGW) ln_row(YF + (size_t)m * D, (const float*)args.in[16] + l * D, (const float*)args.in[17] + l * D, HF + (size_t)m * D, HB + (size_t)m * D, args.dbg ? DBGH1 + (size_t)m * D : (float*)nullptr, lane);
        }
        SEAM(pb + 6);
        if (INQ(7)) REP(7) { PH_IDS
            pg8::Gemm g{HB, WQ + (size_t)l * 2048 * 1024, M, 2048, 1024}; pg8::StaticOrder S; S.init(M, 2048, G, bx);
            pg8::EpiBf16<0> E{PQ, 2048, nullptr, 0, 0, 1.f};
            pg8::gemm_phase<pg8::EpiBf16<0>, pg8::StaticOrder, PG8_ALIGN, PG8_SP2>(L + RING_OFF, g, S, E);
        }
        SEAM(pb + 7);
        if (INQ(8)) REP(8) { PH_IDS
            const int hh = vcu & 7; LAS unsigned char* KL = L + RING_OFF + 65536; LAS unsigned* wl = (LAS unsigned*)(L + RING_OFF + wave * 8192);
            { const bf16* ks = SUBK + (size_t)(l * 8 + hh) * 2 * 128 * 128;
#pragma unroll
              for (int i = 0; i < 8; ++i) { const int ci = tid + 512 * i, row = ci >> 4, c = ci & 15; const pg8::u32x4 v = *(const GAS pg8::u32x4*)(ks + (size_t)ci * 8);
                  *(LAS pg8::u32x4*)(KL + (ci >> 11) * 32768 + (row & 127) * 256 + ((c ^ (row & 15)) << 4)) = v; } }
            __syncthreads();
            if (G == 256) { for (int j = wave; j < 16; j += 8) topk_unit((vcu >> 3) + 32 * j, hh, PQ, KL, EIDX, EG, wl, lane); }
            __syncthreads();
        }
        SEAM(pb + 8);
        if (INQ(9)) REP(9) { PH_IDS
            for (int m = GW; m < M; m += NGW) peer_row((size_t)m, HF, EIDX, EG, UB + (size_t)l * 16384 * 1024, VB + (size_t)l * 16384 * 1024, SUB + l * 16384, SVB + l * 16384, (const float*)args.in[22] + l * D, (const float*)args.in[23] + l * D, (((MK_DUP) >> 9) & 1) && rep_ == 0 ? WSP(float, WS_YF) : HF, (((MK_DUP) >> 9) & 1) && rep_ == 0 ? WSP(bf16, WS_GATES + 64 * MiB) : HB, lane);
        }
        SEAM(pb + 9);
    }
#undef IN
#undef INQ
#undef SEAM
}

#if MK_STAMP
__global__ void probe_encode(float* out, unsigned char* ws, unsigned maskA, unsigned maskB) {
    const unsigned long long* st = (const unsigned long long*)(ws + WS_MISC + 1024); float tA = 0.f;
    for (int p = 0; p < NPH; ++p) { const float d = (float)(st[p + 1] - st[p]) * 0.01f; if ((maskA >> p) & 1u) tA += d; }
    const float c = logf(tA + 1.f); (void)maskB;
    for (size_t j = (size_t)blockIdx.x * 256 + threadIdx.x; j < (size_t)M * D; j += (size_t)gridDim.x * 256) out[j] = c;
}
#endif
extern "C" void kernel_launch(void* const* d_in, const int* in_sizes, int n_in, void* d_out, int out_size, void* d_ws, size_t ws_size, hipStream_t stream) {
    static int grid = 0;
    if (grid == 0) {
        if (n_in != 24 || out_size != M * D || ws_size < WS_END) { fprintf(stderr, "kernel_launch: unexpected shapes (n_in %d out %d ws %zu)\n", n_in, out_size, ws_size); grid = -1; return; }
        int dev = 0, cus = 0;
        if (hipGetDevice(&dev) != hipSuccess || hipDeviceGetAttribute(&cus, hipDeviceAttributeMultiprocessorCount, dev) != hipSuccess) { grid = -1; return; }
        if (hipFuncSetAttribute((const void*)mk_fwd, hipFuncAttributeMaxDynamicSharedMemorySize, LDS_BYTES) != hipSuccess) { grid = -1; return; }
        (void)hipGetLastError();
        grid = cus;
        if (grid != 256) { fprintf(stderr, "kernel_launch: built for 256 CUs, found %d\n", cus); grid = -1; return; }
    }
    if (grid < 0) return;
    if (hipMemsetAsync((char*)d_ws + WS_CTL, 0, CTL_ZERO_BYTES, stream) != hipSuccess) return;
#if MK_DEBUG
    (void)hipMemsetAsync((char*)d_ws + WS_MISC + 60, 0, 196, stream);
#endif
    Args a{};
    for (int i = 0; i < 24; ++i) a.in[i] = d_in[i];
    a.out = (float*)d_out; a.ws = (unsigned char*)d_ws;
    for (int i = 0; i < 32; ++i) a.invf[i] = (float)pow(10000.0, -(double)(2 * i) / 64.0);
    a.dbg = MK_DEBUG;
#if MK_N_LAUNCHES == 1
    a.ph_lo = 0; a.ph_hi = NPH;
    hipLaunchKernelGGL(mk_fwd, dim3(grid), dim3(NWAVES * 64), LDS_BYTES, stream, a);
#if MK_STAMP
    hipLaunchKernelGGL(probe_encode, dim3(1024), dim3(256), 0, stream, (float*)d_out, (unsigned char*)d_ws, (unsigned)MK_STAMP_A, (unsigned)MK_STAMP_B);
#endif
#else
    for (int p = 0; p < NPH; ++p) { a.ph_lo = p; a.ph_hi = p + 1;
        hipLaunchKernelGGL(mk_fwd, dim3(grid), dim3(NWAVES * 64), LDS_BYTES, stream, a);
#if MK_DEBUG
        dbg_check(p, a.in, a.out, a.ws, a.invf, stream);
#endif
    }
#if MK_DEBUG
    dbg_final(a.in, a.out, a.ws, stream);
#endif
#endif
}
```
